# Optimizing an MI355X kernel written in HIP

```python
import math
import jax
import jax.numpy as jnp
from jax import lax
import numpy as np

D_MODEL = 1024
BATCH = 4
SEQ = 4096
DEPTH = 4

GRID_W = 64
CTX_LEN = 256
N_MIXERS = 3
Q_BLOCK = 128
ROPE_THETA = 10000.0
EPS = 1e-6
NEG_INF = -1e30
CONV_WIDTH = 3
N_MOD = 6

A_HEADS = 8
A_KV_HEADS = 2
A_HEAD_DIM = D_MODEL // A_HEADS

FILTER_BANDS = 16
FILTER_EMB_DIM = 1 + 2 * FILTER_BANDS
FILTER_WIDTH = 64
FILTER_SIN_FREQ = 1.0
DECAY_TARGET = 1e-2
DECAY_FAST_PCT = 0.3
DECAY_SLOW_PCT = 1.5

C_HEADS = 16
C_KV_HEADS = 2
C_HEAD_DIM = D_MODEL // C_HEADS
WINDOW = 128

D_FF = 2816

N_A = (DEPTH + 2) // 3
N_B = (DEPTH + 1) // 3
N_C = DEPTH // 3

kernel_name = "hybrid_interleaved_dit_ctx_prefix"


def _rmsnorm(x, g):
    xf = x.astype(jnp.float32)
    y = xf * lax.rsqrt(jnp.mean(xf * xf, axis=-1, keepdims=True) + EPS)
    return (y * g.astype(jnp.float32)).astype(x.dtype)


def _modulate(x, shift, scale):
    return x * (1.0 + scale) + shift


def _dwconv(u, w, b):
    half = CONV_WIDTH // 2
    l = u.shape[1]
    up = jnp.pad(u, ((0, 0), (half, half), (0, 0)))
    out = b
    for j in range(CONV_WIDTH):
        out = out + up[:, j:j + l] * w[j]
    return out


def _axial_rope(seq_len, head_dim):
    rows = seq_len // GRID_W
    row = jnp.repeat(jnp.arange(rows), GRID_W).astype(jnp.float32)
    col = jnp.tile(jnp.arange(GRID_W), rows).astype(jnp.float32)
    axis_dim = head_dim // 2
    inv = jnp.power(ROPE_THETA, -jnp.arange(0, axis_dim, 2, dtype=jnp.float32) / axis_dim)
    ang = jnp.concatenate([row[:, None] * inv[None], col[:, None] * inv[None]], axis=-1)
    return jnp.cos(ang), jnp.sin(ang)


def _rope(x, cos, sin):
    half = x.shape[-1] // 2
    shape = (cos.shape[0],) + (1,) * (x.ndim - 3) + (half,)
    cos = cos.reshape(shape).astype(x.dtype)
    sin = sin.reshape(shape).astype(x.dtype)
    x1, x2 = x[..., :half], x[..., half:]
    return jnp.concatenate([x1 * cos - x2 * sin, x1 * sin + x2 * cos], axis=-1)


def _project(h, w, bias, n_heads, n_kv, head_dim, with_q):
    q_cols = n_heads * head_dim
    if not with_q:
        w = w[:, q_cols:]
        bias = None if bias is None else bias[q_cols:]
    out = h @ w
    if bias is not None:
        out = out + bias
    bsz, l, _ = h.shape
    q = None
    if with_q:
        q = out[..., :q_cols].reshape(bsz, l, n_kv, n_heads // n_kv, head_dim)
        out = out[..., q_cols:]
    k, v = jnp.split(out, 2, axis=-1)
    return q, k.reshape(bsz, l, n_kv, head_dim), v.reshape(bsz, l, n_kv, head_dim)


def _dense_block_attention(q, k, v, scale):
    b, l, nkv, g, dh = q.shape
    nb = l // Q_BLOCK
    qb = jnp.moveaxis(q.reshape(b, nb, Q_BLOCK, nkv, g, dh), 1, 0)

    def one_block(qi):
        s = jnp.einsum('bqkgd,bskd->bkgqs', qi, k).astype(jnp.float32) * scale
        p = jax.nn.softmax(s, axis=-1).astype(v.dtype)
        return jnp.einsum('bkgqs,bskd->bqkgd', p, v)

    ob = lax.map(one_block, qb)
    return jnp.moveaxis(ob, 0, 1).reshape(b, l, nkv, g, dh)


def _sink_attention(q, k, v, sink_logit, scale):
    s = jnp.einsum('bqkgd,bskd->bkgqs', q, k).astype(jnp.float32) * scale
    s0 = jnp.broadcast_to(sink_logit[None, :, :, None, None], s.shape[:-1] + (1,))
    p = jax.nn.softmax(jnp.concatenate([s0, s], axis=-1), axis=-1)[..., 1:].astype(v.dtype)
    return jnp.einsum('bkgqs,bskd->bqkgd', p, v)


def _window_attention(q, k, v, kc, vc, sink_logit, scale):
    b, l, nkv, g, dh = q.shape
    nb = l // Q_BLOCK
    n_ctx = kc.shape[1]

    def band(t):
        tp = jnp.pad(t, ((0, 0), (Q_BLOCK, Q_BLOCK), (0, 0), (0, 0))).reshape(b, nb + 2, Q_BLOCK, nkv, dh)
        return jnp.concatenate([tp[:, :-2], tp[:, 1:-1], tp[:, 2:]], axis=2)

    kb, vb = band(k), band(v)
    qb = q.reshape(b, nb, Q_BLOCK, nkv, g, dh)
    offs = jnp.arange(3 * Q_BLOCK)[None, :] - Q_BLOCK
    rel = offs - jnp.arange(Q_BLOCK)[:, None]
    key_pos = jnp.arange(nb)[:, None] * Q_BLOCK + offs
    valid = (jnp.abs(rel) <= WINDOW)[None] & ((key_pos >= 0) & (key_pos < l))[:, None, :]

    def one_block(args):
        qi, ki, vi, mi = args
        s_loc = jnp.einsum('bqkgd,bskd->bkgqs', qi, ki).astype(jnp.float32) * scale
        s_loc = jnp.where(mi, s_loc, NEG_INF)
        s_ctx = jnp.einsum('bqkgd,bskd->bkgqs', qi, kc).astype(jnp.float32) * scale
        s0 = jnp.broadcast_to(sink_logit[None, :, :, None, None], s_ctx.shape[:-1] + (1,))
        p = jax.nn.softmax(jnp.concatenate([s0, s_ctx, s_loc], axis=-1), axis=-1).astype(v.dtype)
        return (jnp.einsum('bkgqs,bskd->bqkgd', p[..., 1:1 + n_ctx], vc)
                + jnp.einsum('bkgqs,bskd->bqkgd', p[..., 1 + n_ctx:], vi))

    ob = lax.map(one_block, (jnp.moveaxis(qb, 1, 0), jnp.moveaxis(kb, 1, 0), jnp.moveaxis(vb, 1, 0), valid))
    return jnp.moveaxis(ob, 0, 1).reshape(b, l, nkv, g, dh)


def _mixer_a(h_lat, h_ctx, w_qkv, q_gain, k_gain, w_out, cos, sin, need_ctx):
    scale = A_HEAD_DIM ** -0.5
    b, l, _ = h_lat.shape
    q, k, v = _project(h_lat, w_qkv, None, A_HEADS, A_KV_HEADS, A_HEAD_DIM, True)
    q = _rope(_rmsnorm(q, q_gain), cos, sin)
    k = _rope(_rmsnorm(k, k_gain), cos, sin)
    qc, kc, vc = _project(h_ctx, w_qkv, None, A_HEADS, A_KV_HEADS, A_HEAD_DIM, need_ctx)
    kc = _rmsnorm(kc, k_gain)
    k_all = jnp.concatenate([kc, k], axis=1)
    v_all = jnp.concatenate([vc, v], axis=1)
    o_lat = _dense_block_attention(q, k_all, v_all, scale).reshape(b, l, A_HEADS * A_HEAD_DIM) @ w_out
    o_ctx = None
    if need_ctx:
        oc = _dense_block_attention(_rmsnorm(qc, q_gain), kc, vc, scale)
        o_ctx = oc.reshape(b, h_ctx.shape[1], A_HEADS * A_HEAD_DIM) @ w_out
    return o_lat, o_ctx


def _hyena_filter(seq_len, w1, b1, w2, b2, w3, b3, w4):
    t = jnp.linspace(0.0, 1.0, seq_len, dtype=jnp.float32)[:, None]
    omega = (2.0 * math.pi / seq_len) * jnp.arange(seq_len, dtype=jnp.float32)
    bands = jnp.linspace(1e-4, FILTER_BANDS - 1, FILTER_BANDS, dtype=jnp.float32)
    ang = omega[:, None] * bands[None, :]
    z = jnp.concatenate([t, jnp.cos(ang), -jnp.sin(ang)], axis=-1)
    f = jnp.sin(FILTER_SIN_FREQ * (z @ w1 + b1))
    f = jnp.sin(FILTER_SIN_FREQ * (f @ w2 + b2))
    f = jnp.sin(FILTER_SIN_FREQ * (f @ w3 + b3))
    f = (f @ w4).astype(jnp.float32)
    rates = jnp.abs(jnp.linspace(math.log(DECAY_TARGET) / DECAY_FAST_PCT,
                                 math.log(DECAY_TARGET) / DECAY_SLOW_PCT, D_MODEL, dtype=jnp.float32))
    decay = jnp.exp(-t * rates[None, :])
    return f[:, :D_MODEL] * decay, f[:, D_MODEL:] * decay


def _bidir_long_conv(u, h_fwd, h_bwd, skip):
    l = u.shape[1]
    n = 2 * l
    filt = jnp.concatenate([h_fwd, jnp.zeros_like(h_fwd[:1]), h_bwd[:0:-1]], axis=0)
    uf = jnp.fft.rfft(u.astype(jnp.float32), n=n, axis=1)
    ff = jnp.fft.rfft(filt, n=n, axis=0)
    y = jnp.fft.irfft(uf * ff[None], n=n, axis=1)[:, :l]
    return (y + u.astype(jnp.float32) * skip.astype(jnp.float32)).astype(u.dtype)


def _hyena_mixer(h, w_in, b_in, conv_w, conv_b, f_w1, f_b1, f_w2, f_b2, f_w3, f_b3, f_w4, skip, w_out, b_out):
    u = _dwconv(h @ w_in + b_in, conv_w, conv_b)
    x0, x1, v = jnp.split(u, 3, axis=-1)
    h_fwd, h_bwd = _hyena_filter(h.shape[1], f_w1, f_b1, f_w2, f_b2, f_w3, f_b3, f_w4)
    v = _bidir_long_conv(v * x1, h_fwd, h_bwd, skip)
    return (v * x0) @ w_out + b_out


def _mixer_c(h_lat, h_ctx, w_qkv, b_qkv, sink, w_out, b_out, cos, sin, need_ctx):
    scale = C_HEAD_DIM ** -0.5
    b, l, _ = h_lat.shape
    q, k, v = _project(h_lat, w_qkv, b_qkv, C_HEADS, C_KV_HEADS, C_HEAD_DIM, True)
    q, k = _rope(q, cos, sin), _rope(k, cos, sin)
    qc, kc, vc = _project(h_ctx, w_qkv, b_qkv, C_HEADS, C_KV_HEADS, C_HEAD_DIM, need_ctx)
    sink_logit = sink.reshape(C_KV_HEADS, C_HEADS // C_KV_HEADS).astype(jnp.float32)
    o = _window_attention(q, k, v, kc, vc, sink_logit, scale)
    o_lat = o.reshape(b, l, C_HEADS * C_HEAD_DIM) @ w_out + b_out
    o_ctx = None
    if need_ctx:
        oc = _sink_attention(qc, kc, vc, sink_logit, scale)
        o_ctx = oc.reshape(b, h_ctx.shape[1], C_HEADS * C_HEAD_DIM) @ w_out + b_out
    return o_lat, o_ctx


def _conv_ffn(h, w_up, conv_w, conv_b, w_down):
    gate, up = jnp.split(h @ w_up, 2, axis=-1)
    return (jax.nn.silu(_dwconv(gate, conv_w, conv_b)) * up) @ w_down


def setup_inputs(seed: int = 0) -> dict:
    key = jax.random.key(seed)
    ks = iter(jax.random.split(key, 40))

    def nrm(shape, scale=1.0):
        return jax.random.normal(next(ks), shape, jnp.float32) * scale

    d = D_MODEL
    a_cols = (A_HEADS + 2 * A_KV_HEADS) * A_HEAD_DIM
    c_cols = (C_HEADS + 2 * C_KV_HEADS) * C_HEAD_DIM
    return {
        'x': nrm((BATCH, SEQ, d)),
        'c': nrm((BATCH, d)),
        'ctx': nrm((BATCH, CTX_LEN, d)),
        'c_ctx': nrm((d,)),
        'mod_w': nrm((DEPTH, d, N_MOD * d), d ** -0.5),
        'mod_b': nrm((DEPTH, N_MOD * d), 0.02),
        'norm_g': 1.0 + nrm((DEPTH, 4, d), 0.05),
        'ffn_w_up': nrm((DEPTH, d, 2 * D_FF), d ** -0.5),
        'ffn_conv_w': nrm((DEPTH, CONV_WIDTH, D_FF), CONV_WIDTH ** -0.5),
        'ffn_conv_b': nrm((DEPTH, D_FF), 0.02),
        'ffn_w_down': nrm((DEPTH, D_FF, d), D_FF ** -0.5),
        'a_w_qkv': nrm((N_A, d, a_cols), d ** -0.5),
        'a_q_gain': 1.0 + nrm((N_A, A_HEAD_DIM), 0.05),
        'a_k_gain': 1.0 + nrm((N_A, A_HEAD_DIM), 0.05),
        'a_w_out': nrm((N_A, A_HEADS * A_HEAD_DIM, d), (A_HEADS * A_HEAD_DIM) ** -0.5),
        'b_w_in': nrm((N_B, d, 3 * d), d ** -0.5),
        'b_b_in': nrm((N_B, 3 * d), 0.02),
        'b_conv_w': nrm((N_B, CONV_WIDTH, 3 * d), CONV_WIDTH ** -0.5),
        'b_conv_b': nrm((N_B, 3 * d), 0.02),
        'b_f_w1': nrm((N_B, FILTER_EMB_DIM, FILTER_WIDTH), FILTER_EMB_DIM ** -0.5),
        'b_f_b1': nrm((N_B, FILTER_WIDTH), 0.1),
        'b_f_w2': nrm((N_B, FILTER_WIDTH, FILTER_WIDTH), FILTER_WIDTH ** -0.5),
        'b_f_b2': nrm((N_B, FILTER_WIDTH), 0.1),
        'b_f_w3': nrm((N_B, FILTER_WIDTH, FILTER_WIDTH), FILTER_WIDTH ** -0.5),
        'b_f_b3': nrm((N_B, FILTER_WIDTH), 0.1),
        'b_f_w4': nrm((N_B, FILTER_WIDTH, 2 * d), FILTER_WIDTH ** -0.5),
        'b_skip': nrm((N_B, d)),
        'b_w_out': nrm((N_B, d, d), d ** -0.5),
        'b_b_out': nrm((N_B, d), 0.02),
        'c_w_qkv': nrm((N_C, d, c_cols), d ** -0.5),
        'c_b_qkv': nrm((N_C, c_cols), 0.02),
        'c_sink': nrm((N_C, C_HEADS)),
        'c_w_out': nrm((N_C, C_HEADS * C_HEAD_DIM, d), (C_HEADS * C_HEAD_DIM) ** -0.5),
        'c_b_out': nrm((N_C, d), 0.02),
    }


def reference(x, c, ctx, c_ctx, mod_w, mod_b, norm_g, ffn_w_up, ffn_conv_w, ffn_conv_b, ffn_w_down,
              a_w_qkv, a_q_gain, a_k_gain, a_w_out,
              b_w_in, b_b_in, b_conv_w, b_conv_b, b_f_w1, b_f_b1, b_f_w2, b_f_b2, b_f_w3, b_f_b3, b_f_w4,
              b_skip, b_w_out, b_b_out,
              c_w_qkv, c_b_qkv, c_sink, c_w_out, c_b_out):
    seq_len = x.shape[1]
    cos_a, sin_a = _axial_rope(seq_len, A_HEAD_DIM)
    cos_c, sin_c = _axial_rope(seq_len, C_HEAD_DIM)
    s_lat = jax.nn.silu(c)
    s_ctx = jax.nn.silu(c_ctx)
    h_lat, h_ctx = x, ctx
    for i in range(DEPTH):
        need_ctx = i < DEPTH - 1
        kind, j = i % N_MIXERS, i // N_MIXERS
        g = norm_g[i]
        m_lat = jnp.split((s_lat @ mod_w[i] + mod_b[i])[:, None, :], N_MOD, axis=-1)
        m_ctx = jnp.split(s_ctx @ mod_w[i] + mod_b[i], N_MOD, axis=-1)
        u_lat = _modulate(_rmsnorm(h_lat, g[0]), m_lat[0], m_lat[1])
        if kind == 0:
            u_ctx = _modulate(_rmsnorm(h_ctx, g[0]), m_ctx[0], m_ctx[1])
            o_lat, o_ctx = _mixer_a(u_lat, u_ctx, a_w_qkv[j], a_q_gain[j], a_k_gain[j], a_w_out[j],
                                    cos_a, sin_a, need_ctx)
        elif kind == 1:
            hy = (b_w_in[j], b_b_in[j], b_conv_w[j], b_conv_b[j], b_f_w1[j], b_f_b1[j], b_f_w2[j], b_f_b2[j],
                  b_f_w3[j], b_f_b3[j], b_f_w4[j], b_skip[j], b_w_out[j], b_b_out[j])
            o_lat = _hyena_mixer(u_lat, *hy)
            o_ctx = None
            if need_ctx:
                u_ctx = _modulate(_rmsnorm(h_ctx, g[0]), m_ctx[0], m_ctx[1])
                o_ctx = _hyena_mixer(u_ctx, *hy)
        else:
            u_ctx = _modulate(_rmsnorm(h_ctx, g[0]), m_ctx[0], m_ctx[1])
            o_lat, o_ctx = _mixer_c(u_lat, u_ctx, c_w_qkv[j], c_b_qkv[j], c_sink[j], c_w_out[j], c_b_out[j],
                                    cos_c, sin_c, need_ctx)
        ffn = (ffn_w_up[i], ffn_conv_w[i], ffn_conv_b[i], ffn_w_down[i])
        h_lat = h_lat + m_lat[2] * _rmsnorm(o_lat, g[1])
        f_lat = _conv_ffn(_modulate(_rmsnorm(h_lat, g[2]), m_lat[3], m_lat[4]), *ffn)
        h_lat = h_lat + m_lat[5] * _rmsnorm(f_lat, g[3])
        if need_ctx:
            h_ctx = h_ctx + m_ctx[2] * _rmsnorm(o_ctx, g[1])
            f_ctx = _conv_ffn(_modulate(_rmsnorm(h_ctx, g[2]), m_ctx[3], m_ctx[4]), *ffn)
            h_ctx = h_ctx + m_ctx[5] * _rmsnorm(f_ctx, g[3])
    return h_lat
```

```cpp
#include <hip/hip_runtime.h>
#include <cstdio>
#include <cstdint>
#include <cmath>
namespace pg8 {
#define PG8_LAS __attribute__((address_space(3)))
typedef unsigned short bf16_t;
typedef short bf16x8 __attribute__((ext_vector_type(8)));
typedef float f32x4 __attribute__((ext_vector_type(4)));
typedef unsigned u32x4 __attribute__((ext_vector_type(4)));
constexpr int BM = 256, BK = 64, HALF = 128, HTB = HALF * BK * 2  , STAGE_BYTES = 8 * HTB, NXCD = 8, WGM = 8;

__host__ __device__ __forceinline__ int lds_byte(int r, int c) { const int st = (r >> 4) * 2 + (c >> 5), rr = r & 15, cc = c & 31, ob = rr * 64 + cc * 2; return st * 1024 + (ob ^ (((ob >> 9) & 1) << 5)); }
__host__ __device__ __forceinline__ void stage_rc(int b, int& R, int& C) { const int st = b / 1024, sb = b % 1024, swz = sb ^ (((sb >> 9) & 1) << 5); R = (st >> 1) * 16 + swz / 64; C = (st & 1) * 32 + (swz % 64) / 2; }
__host__ __device__ __forceinline__ int perm32(int rho) { const int n = rho >> 4, i = rho & 15; return 8 * (i >> 2) + 4 * n + (i & 3); }

struct Unit { int pm, pn; };
struct Gemm { const bf16_t* A; const bf16_t* Bt; int M, N, K, lda; };

struct StaticOrder {
    int nM, nN, nwg, G, c;
    __host__ __device__ void init(int M, int N, int G_, int c_) { nM = M / BM; nN = N / BM; nwg = nM * nN; G = G_; c = c_; }
    __host__ __device__ bool next(int i, Unit& u) const {
        const long L = (long)i * G + c; if (L >= nwg) return false;
        int wgid = (int)L; { const int q = nwg / NXCD, r = nwg % NXCD, xcd = wgid % NXCD, off = wgid / NXCD; wgid = (xcd < r ? xcd * (q + 1) : r * (q + 1) + (xcd - r) * q) + off; }
        const int nig = WGM * nN, gid = wgid / nig, fm = gid * WGM, gsz = (nM - fm) < WGM ? (nM - fm) : WGM;
        u.pm = fm + ((wgid % nig) % gsz); u.pn = (wgid % nig) / gsz; return true;
    }
    __device__ __forceinline__ void a_ready(const Unit&) const {}
    __device__ __forceinline__ void done(const Unit&) const {}
};

__device__ __forceinline__ unsigned cvt_pk_bf16(float lo, float hi) { unsigned r; asm volatile("v_cvt_pk_bf16_f32 %0, %1, %2" : "=v"(r) : "v"(lo), "v"(hi)); return r; }
struct EpiBf16 {
    static constexpr bool PERM = true, AFTER_DRAIN = false;
    bf16_t* O; int ldc; const float* bias;
    __device__ __forceinline__ void operator()(const f32x4 (&acc)[2][2][4][2], const Unit& u, int wr, int wc, int fr, int fq) const {
        const int row0 = u.pm * BM + wr * 64 + fr; const int col0 = u.pn * BM + wc * 32 + 8 * fq;
        f32x4 bv[2][2];
#pragma unroll
        for (int bj = 0; bj < 2; ++bj)
#pragma unroll
            for (int n = 0; n < 2; ++n) bv[bj][n] = bias ? *(const f32x4*)(bias + col0 + bj * HALF + 4 * n) : (f32x4){0.f, 0.f, 0.f, 0.f};
#pragma unroll
        for (int ai = 0; ai < 2; ++ai)
#pragma unroll
            for (int m = 0; m < 4; ++m) { bf16_t* rowp = O + (size_t)(row0 + ai * HALF + m * 16) * ldc + col0;
#pragma unroll
                for (int bj = 0; bj < 2; ++bj) { const f32x4 v0 = acc[ai][bj][m][0] + bv[bj][0], v1 = acc[ai][bj][m][1] + bv[bj][1];
                    u32x4 w; w.x = cvt_pk_bf16(v0[0], v0[1]); w.y = cvt_pk_bf16(v0[2], v0[3]); w.z = cvt_pk_bf16(v1[0], v1[1]); w.w = cvt_pk_bf16(v1[2], v1[3]);
                    *(u32x4*)(rowp + bj * HALF) = w; } }
    }
};

template <class Epi, class Sched, bool ALIGN_EPI = false, bool SP2 = false>
__device__ __forceinline__ void gemm_phase(PG8_LAS unsigned char* lds, const Gemm g, const Sched& S, const Epi& E, const int tid) {
    const int wid = __builtin_amdgcn_readfirstlane(tid >> 6), lane = tid & 63, wr = wid >> 2, wc = wid & 3, fr = lane & 15, fq = lane >> 4;
    const int K = g.K, nt = K / BK;
    unsigned voffA[2], voffB[2];
#pragma unroll
    for (int i = 0; i < 2; ++i) { int R, C; stage_rc(tid * 16 + i * 8192, R, C); const int Rb = Epi::PERM ? ((R & ~31) + perm32(R & 31)) : R;
        voffA[i] = (unsigned)(R * g.lda + C) * 2u; voffB[i] = (unsigned)(Rb * K + C) * 2u; }
    const size_t kstep = (size_t)(BK * 2);
    const size_t hstepA = (size_t)HALF * g.lda * 2, hstepB = (size_t)HALF * K * 2;
    const size_t tstepA = 2 * hstepA, tstepB = 2 * hstepB;
    const unsigned ldsw = (unsigned)wid * 1024u;
    const int aoff = lds_byte(wr * 64 + fr, fq * 8), boff = lds_byte(wc * 32 + fr, fq * 8);
#define PG8_SA(b, h) (((b) * 2 + (h)) * HTB)
#define PG8_SB(b, h) ((4 + (b) * 2 + (h)) * HTB)
#define PG8_STAGE(bufoff, gbase, voff) do { _Pragma("unroll") for (int _i = 0; _i < 2; ++_i) \
        __builtin_amdgcn_global_load_lds((const unsigned*)((const char*)(gbase) + (voff)[_i]), (PG8_LAS unsigned*)(lds + (bufoff) + ldsw + _i * 8192), 16, 0, 0); } while (0)
#define PG8_LDA(dst, b, h) do { _Pragma("unroll") for (int m = 0; m < 4; ++m) _Pragma("unroll") for (int k = 0; k < 2; ++k) dst[m][k] = *(const PG8_LAS bf16x8*)(lds + PG8_SA(b, h) + aoff + m * 2048 + k * 1024); } while (0)
#define PG8_LDB(dst, b, h) do { _Pragma("unroll") for (int n = 0; n < 2; ++n) _Pragma("unroll") for (int k = 0; k < 2; ++k) dst[n][k] = *(const PG8_LAS bf16x8*)(lds + PG8_SB(b, h) + boff + n * 2048 + k * 1024); } while (0)
#define PG8_MMA(ai, bj, At, Bt) do { __builtin_amdgcn_s_setprio(1); _Pragma("unroll") for (int m = 0; m < 4; ++m) _Pragma("unroll") for (int n = 0; n < 2; ++n) _Pragma("unroll") for (int k = 0; k < 2; ++k) \
        acc[ai][bj][m][n] = __builtin_amdgcn_mfma_f32_16x16x32_bf16(Bt[n][k], At[m][k], acc[ai][bj][m][n], 0, 0, 0); __builtin_amdgcn_s_setprio(0); } while (0)
#define PG8_WAIT_V(n) asm volatile("s_waitcnt vmcnt(" #n ")" ::: "memory")
#define PG8_WAIT_L(n) asm volatile("s_waitcnt lgkmcnt(" #n ")" ::: "memory")
#define PG8_BAR __builtin_amdgcn_s_barrier()
#define PG8_SCHED __builtin_amdgcn_sched_barrier(0)
    Unit cur, nxt; int ui = 0;
    if (!S.next(0, cur)) return;
    f32x4 acc[2][2][4][2];
#pragma unroll
    for (int a = 0; a < 2; ++a)
#pragma unroll
        for (int b = 0; b < 2; ++b)
#pragma unroll
            for (int m = 0; m < 4; ++m)
#pragma unroll
                for (int n = 0; n < 2; ++n) acc[a][b][m][n] = (f32x4){0.f, 0.f, 0.f, 0.f};
    bf16x8 At[4][2], B0[2][2], B1[2][2];
    const char* cA = (const char*)g.A + (size_t)cur.pm * tstepA; const char* cB = (const char*)g.Bt + (size_t)cur.pn * tstepB;
    S.a_ready(cur);
    if constexpr (SP2) {
        PG8_STAGE(PG8_SB(0, 0), cB, voffB); PG8_STAGE(PG8_SB(0, 1), cB + hstepB, voffB); PG8_STAGE(PG8_SA(0, 0), cA, voffA); PG8_STAGE(PG8_SA(0, 1), cA + hstepA, voffA);
        if (wr == 1) PG8_BAR;
        PG8_WAIT_V(2); PG8_BAR;
        PG8_STAGE(PG8_SB(1, 0), cB + kstep, voffB); PG8_STAGE(PG8_SA(1, 0), cA + kstep, voffA); PG8_STAGE(PG8_SB(1, 1), cB + hstepB + kstep, voffB);
        PG8_WAIT_V(6); PG8_BAR;
    } else {
        PG8_STAGE(PG8_SB(0, 0), cB, voffB); PG8_STAGE(PG8_SA(0, 0), cA, voffA); PG8_STAGE(PG8_SB(0, 1), cB + hstepB, voffB); PG8_STAGE(PG8_SA(0, 1), cA + hstepA, voffA);
        if (wr == 1) PG8_BAR;
        PG8_WAIT_V(4); PG8_BAR;
        PG8_STAGE(PG8_SB(1, 0), cB + kstep, voffB); PG8_STAGE(PG8_SA(1, 0), cA + kstep, voffA); PG8_STAGE(PG8_SB(1, 1), cB + hstepB + kstep, voffB);
        PG8_WAIT_V(6); PG8_BAR;
    }
    for (;;) {
        const bool has_next = S.next(ui + 1, nxt);
        const char* nA = has_next ? (const char*)g.A + (size_t)nxt.pm * tstepA : cA; const char* nB = has_next ? (const char*)g.Bt + (size_t)nxt.pn * tstepB : cB;
        for (int t = 0; t < nt; t += 2) {
            const bool last = (t == nt - 2);
            const char* a1 = cA + (size_t)(t + 1) * kstep;
            const char* a2 = last ? nA : cA + (size_t)(t + 2) * kstep; const char* b2 = last ? nB : cB + (size_t)(t + 2) * kstep;
            const char* a3 = a2 + kstep; const char* b3 = b2 + kstep;
            if (last && has_next) S.a_ready(nxt);
            if constexpr (SP2) {
            PG8_LDB(B0, 0, 0); PG8_LDB(B1, 0, 1); PG8_SCHED; PG8_LDA(At, 0, 0); PG8_STAGE(PG8_SA(1, 1), a1 + hstepA, voffA);
            PG8_WAIT_V(8); PG8_WAIT_L(0); PG8_BAR; PG8_MMA(0, 0, At, B0); PG8_MMA(0, 1, At, B1); PG8_BAR; PG8_SCHED;
            PG8_LDA(At, 0, 1); PG8_STAGE(PG8_SB(0, 0), b2, voffB); PG8_STAGE(PG8_SB(0, 1), b2 + hstepB, voffB); PG8_STAGE(PG8_SA(0, 0), a2, voffA);
            PG8_WAIT_V(8); PG8_WAIT_L(0); PG8_BAR; PG8_MMA(1, 0, At, B0); PG8_MMA(1, 1, At, B1); PG8_BAR; PG8_SCHED;
            PG8_LDB(B0, 1, 0); PG8_LDB(B1, 1, 1); PG8_SCHED; PG8_LDA(At, 1, 0); PG8_STAGE(PG8_SA(0, 1), a2 + hstepA, voffA);
            PG8_WAIT_V(8); PG8_WAIT_L(0); PG8_BAR; PG8_MMA(0, 0, At, B0); PG8_MMA(0, 1, At, B1); PG8_BAR; PG8_SCHED;
            PG8_LDA(At, 1, 1); PG8_STAGE(PG8_SB(1, 0), b3, voffB); PG8_STAGE(PG8_SB(1, 1), b3 + hstepB, voffB); PG8_STAGE(PG8_SA(1, 0), a3, voffA);
            PG8_WAIT_V(8); PG8_WAIT_L(0); PG8_BAR; PG8_MMA(1, 0, At, B0); PG8_MMA(1, 1, At, B1); PG8_BAR; PG8_SCHED;
            } else {
            PG8_LDB(B0, 0, 0); PG8_SCHED; PG8_LDA(At, 0, 0); PG8_STAGE(PG8_SA(1, 1), a1 + hstepA, voffA);
            PG8_WAIT_L(8); PG8_BAR; PG8_WAIT_L(0); PG8_MMA(0, 0, At, B0); PG8_BAR; PG8_SCHED;
            PG8_LDB(B1, 0, 1); PG8_STAGE(PG8_SB(0, 0), b2, voffB);
            PG8_BAR; PG8_WAIT_L(0); PG8_MMA(0, 1, At, B1); PG8_BAR;
            PG8_LDA(At, 0, 1); PG8_STAGE(PG8_SA(0, 0), a2, voffA);
            PG8_BAR; PG8_WAIT_L(0); PG8_MMA(1, 0, At, B0); PG8_BAR; PG8_SCHED;
            PG8_STAGE(PG8_SB(0, 1), b2 + hstepB, voffB);
            PG8_WAIT_V(6); PG8_BAR; PG8_MMA(1, 1, At, B1); PG8_BAR;
            PG8_LDB(B0, 1, 0); PG8_SCHED; PG8_LDA(At, 1, 0); PG8_STAGE(PG8_SA(0, 1), a2 + hstepA, voffA);
            PG8_WAIT_L(8); PG8_BAR; PG8_WAIT_L(0); PG8_MMA(0, 0, At, B0); PG8_BAR; PG8_SCHED;
            PG8_LDB(B1, 1, 1); PG8_STAGE(PG8_SB(1, 0), b3, voffB);
            PG8_BAR; PG8_WAIT_L(0); PG8_MMA(0, 1, At, B1); PG8_BAR;
            PG8_LDA(At, 1, 1); PG8_STAGE(PG8_SA(1, 0), a3, voffA);
            PG8_BAR; PG8_WAIT_L(0); PG8_MMA(1, 0, At, B0); PG8_BAR; PG8_SCHED;
            PG8_STAGE(PG8_SB(1, 1), b3 + hstepB, voffB);
            PG8_WAIT_V(6); PG8_BAR; PG8_MMA(1, 1, At, B1); PG8_BAR;
            }
        }
        if constexpr (ALIGN_EPI) { if (wr == 0) PG8_BAR; }
        if constexpr (!Epi::AFTER_DRAIN) { E(acc, cur, wr, wc, fr, fq); S.done(cur); }
        if (!has_next) break;
#pragma unroll
        for (int a = 0; a < 2; ++a)
#pragma unroll
            for (int b = 0; b < 2; ++b)
#pragma unroll
                for (int m = 0; m < 4; ++m)
#pragma unroll
                    for (int n = 0; n < 2; ++n) acc[a][b][m][n] = (f32x4){0.f, 0.f, 0.f, 0.f};
        cur = nxt; cA = nA; cB = nB; ++ui;
        if constexpr (ALIGN_EPI) { if (wr == 1) PG8_BAR; }
    }
    PG8_WAIT_V(0);
    if constexpr (!ALIGN_EPI) { if (wr == 0) PG8_BAR; }
    PG8_BAR;
    if constexpr (Epi::AFTER_DRAIN) { E.fused(acc, cur, wr, wc, fr, fq, lds, wid, lane); S.done(cur); }
#undef PG8_SA
#undef PG8_SB
#undef PG8_STAGE
#undef PG8_LDA
#undef PG8_LDB
#undef PG8_MMA
#undef PG8_WAIT_V
#undef PG8_WAIT_L
#undef PG8_BAR
#undef PG8_SCHED
}
}

constexpr int NWAVES = 8, NTHREADS = 512;
constexpr int DM = 1024, BATCH = 4, SEQ = 4096, CTXL = 256, DEPTH = 4, DFF = 2816, NMOD = 6;
constexpr int MLAT = BATCH * SEQ, MCTX = BATCH * CTXL, MT = MLAT + MCTX;
constexpr int NKEY = CTXL + SEQ;
constexpr int A_HEADS = 8, A_KV = 2, A_DH = 128, A_COLS = (A_HEADS + 2 * A_KV) * A_DH;
constexpr int C_HEADS = 16, C_KV = 2, C_DH = 64, C_COLS = (C_HEADS + 2 * C_KV) * C_DH;
constexpr int WINDOW = 128, GRID_W = 64;
constexpr float EPS = 1e-6f;
constexpr int N_IN = 34;
enum { I_X = 0, I_C, I_CTX, I_CCTX, I_MODW, I_MODB, I_NORMG, I_WUP, I_FCW, I_FCB, I_WDOWN, I_AQKV, I_AQG, I_AKG, I_AOUT,
       I_BIN, I_BBIN, I_BCW, I_BCB, I_FW1, I_FB1, I_FW2, I_FB2, I_FW3, I_FB3, I_FW4, I_BSKIP, I_BOUT, I_BBOUT, I_CQKV, I_CBQKV, I_CSINK, I_COUT, I_CBOUT };

constexpr size_t MiB = 1u << 20;
constexpr size_t WS_CTL = 0, CTL_ZERO_BYTES = 1 * MiB;
constexpr size_t WS_W_AQKV = 1 * MiB, WS_W_AOUT = 7 * MiB, WS_W_BIN = 11 * MiB, WS_W_BOUT = 17 * MiB, WS_W_CQKV = 19 * MiB, WS_W_COUT = 22 * MiB;
constexpr size_t WS_W_UP = 24 * MiB, WS_W_DOWN = 68 * MiB;
constexpr size_t WS_MOD = 90 * MiB, WS_HCLAT = 91 * MiB, WS_HCCTX = 123 * MiB, WS_HCTX = 125 * MiB, WS_U = 129 * MiB, WS_R = 163 * MiB, WS_END = 350 * MiB;
constexpr size_t R_QKV = 0, R_QN = 102 * MiB, R_KB = 136 * MiB, R_VB = 145 * MiB, R_VP = 102 * MiB, R_O = 0, R_G = 0;
static_assert(WS_W_AQKV + 2ull * A_COLS * DM * 2 <= WS_W_AOUT && WS_W_CQKV + (size_t)C_COLS * DM * 2 <= WS_W_COUT && WS_W_UP + 4ull * 2 * DFF * DM * 2 <= WS_W_DOWN && WS_W_DOWN + 4ull * DM * DFF * 2 <= WS_MOD, "weights map");
static_assert(WS_HCLAT + (size_t)(2 * SEQ - 1) * DM * 4 <= WS_HCCTX && WS_HCCTX + (size_t)(2 * CTXL - 1) * DM * 4 <= WS_HCTX && WS_U + (size_t)MT * DM * 2 <= WS_R && WS_R + (size_t)MT * 2 * DFF * 2 <= WS_END, "ws map");
static_assert(R_VB + (size_t)BATCH * NKEY * 256 * 2 <= 187 * MiB && R_VP + (size_t)MT * DM * 4 <= 187 * MiB && (size_t)MT * 3 * DM * 2 <= R_QN, "R overlay");
constexpr int CW_BAR = 4096;

constexpr int LDS_BYTES = 147456;
constexpr int MISC_OFF = LDS_BYTES - 1024;
constexpr int INTAB_OFF = MISC_OFF + 256;

#define GAS __attribute__((address_space(1)))
#define LAS __attribute__((address_space(3)))
typedef unsigned short bf16;
typedef unsigned v4u __attribute__((ext_vector_type(4)));
typedef float f32x4 __attribute__((ext_vector_type(4)));
typedef short bf16x8 __attribute__((ext_vector_type(8)));
typedef GAS unsigned gu32;
typedef GAS unsigned long long gu64;
#define RLX_AGENT __ATOMIC_RELAXED, __HIP_MEMORY_SCOPE_AGENT
#define LDS_WAIT() asm volatile("s_waitcnt lgkmcnt(0)" ::: "memory")
#define VM_WAIT() asm volatile("s_waitcnt vmcnt(0)" ::: "memory")
__device__ __forceinline__ unsigned long long rt() { return __builtin_amdgcn_s_memrealtime(); }
__device__ __forceinline__ unsigned f2bf(float f) { unsigned u = __builtin_bit_cast(unsigned, f); return (u + 0x7fffu + ((u >> 16) & 1u)) >> 16; }
__device__ __forceinline__ unsigned pk2(float lo, float hi) { return f2bf(lo) | (f2bf(hi) << 16); }

#define XB_TMO      128
#define XB_XCNT(j)  (256  + 64 * (j))
#define XB_XSUB(j)  (1280 + 64 * (j))
#define XB_XGEN(j)  (2304 + 64 * (j))
#define XB_TOP      3328
#define XB_TOPGEN   3392
#define XCD_BAR_WORDS 3456
#define XB_SPIN_CAP (1u << 18)

__device__ __forceinline__ unsigned xb_ld(unsigned* p)              { return __hip_atomic_load(p, __ATOMIC_RELAXED, __HIP_MEMORY_SCOPE_AGENT); }
__device__ __forceinline__ unsigned xb_add(unsigned* p, unsigned v) { return __hip_atomic_fetch_add(p, v, __ATOMIC_RELAXED, __HIP_MEMORY_SCOPE_AGENT); }
__device__ __forceinline__ unsigned xb_xcc_id() { return (unsigned)__builtin_amdgcn_s_getreg((3 << 11) | 20) & 0xFu; }
#define XB_SPIN(cond, bar) do { unsigned _sp = 0; while (cond) { __builtin_amdgcn_s_sleep(1); \
    if ((++_sp & 255u) == 0u) { if (xb_ld(&(bar)[XB_TMO])) break; if (_sp > XB_SPIN_CAP) { atomicAdd(&(bar)[XB_TMO], 1u); break; } } } } while (0)

struct XcdBarrier {
    unsigned* bar; unsigned x;
    volatile LAS unsigned* st;
};

__device__ __forceinline__ XcdBarrier xcd_barrier_post(unsigned* bar, volatile LAS unsigned* st) {
    XcdBarrier b; b.bar = bar; b.x = xb_xcc_id(); b.st = st;
    if (threadIdx.x == 0) (void)xb_add(&bar[XB_XCNT(b.x)], 1u);
    return b;
}
__device__ __forceinline__ void xcd_barrier_complete(unsigned* bar, unsigned x, unsigned& nloc, unsigned& nx) {
    const unsigned G = gridDim.x * gridDim.y * gridDim.z;
    unsigned sum, cnt, mine, sp = 0u;
    for (;;) {
        sum = 0u; cnt = 0u; mine = 0u;
#pragma unroll
        for (unsigned j = 0; j < 16; ++j) { const unsigned c = xb_ld(&bar[XB_XCNT(j)]); sum += c; cnt += (c > 0u) ? 1u : 0u; mine = (j == x) ? c : mine; }
        if (sum == G) break;
        __builtin_amdgcn_s_sleep(1);
        if ((++sp & 255u) == 0u) { if (xb_ld(&bar[XB_TMO])) break; if (sp > XB_SPIN_CAP) { atomicAdd(&bar[XB_TMO], 1u); break; } }
    }
    nloc = mine > 0u ? mine : 1u; nx = cnt > 0u ? cnt : 1u;
}

__device__ __forceinline__ void xcd_barrier(const XcdBarrier& b) {
    asm volatile("s_waitcnt vmcnt(0)" ::: "memory");
    __syncthreads();
    if (threadIdx.x == 0) {
        unsigned* bar = b.bar;
        __builtin_amdgcn_s_waitcnt(0);
        unsigned nloc = b.st[0], nx = b.st[1];
        if (nloc == 0u) { xcd_barrier_complete(bar, b.x, nloc, nx); b.st[0] = nloc; b.st[1] = nx; }
        const unsigned old = xb_add(&bar[XB_XSUB(b.x)], 1u);
        const unsigned gen = old / nloc;
        if (old + 1u == (gen + 1u) * nloc) {
            __builtin_amdgcn_fence(__ATOMIC_RELEASE, "agent");
            asm volatile("s_waitcnt vmcnt(0)" ::: "memory");
            const unsigned og = xb_add(&bar[XB_TOP], 1u);
            const unsigned tg = og / nx;
            if (og + 1u == (tg + 1u) * nx) xb_add(&bar[XB_TOPGEN], 1u);
            else XB_SPIN(xb_ld(&bar[XB_TOPGEN]) == tg, bar);
            __builtin_amdgcn_fence(__ATOMIC_ACQUIRE, "agent");
            xb_add(&bar[XB_XGEN(b.x)], 1u);
            asm volatile("s_waitcnt vmcnt(0)" ::: "memory");
        } else {
            XB_SPIN(xb_ld(&bar[XB_XGEN(b.x)]) == gen, bar);
            __builtin_amdgcn_fence(__ATOMIC_ACQUIRE, "agent");
            asm volatile("s_waitcnt vmcnt(0)" ::: "memory");
        }
    }
    __syncthreads();
}

struct Args { const float* in[N_IN]; float* out; unsigned char* ws; int ph_lo, ph_hi, single, pad; };
struct Frame {
    LAS unsigned char* lds;
    unsigned char* ldsg;
    volatile LAS unsigned* MISC;
    gu32* ctl;
    int tid, lane, wave, vcu, G, bx;
    LAS unsigned long long* intab;
    float* out; unsigned char* ws;
    __device__ __forceinline__ const float* inp(int i) const { const unsigned long long v = intab[i];
        const unsigned lo = __builtin_amdgcn_readfirstlane((unsigned)v), hi = __builtin_amdgcn_readfirstlane((unsigned)(v >> 32));
        return (const float*)(((unsigned long long)hi << 32) | lo); }
};
__device__ __forceinline__ float bf2f(unsigned h) { return __uint_as_float(h << 16); }
#define SWZ_XOR(v, o) __int_as_float(__builtin_amdgcn_ds_swizzle(__float_as_int(v), ((o) << 10) | 0x1f))
__device__ __forceinline__ float wave_sum(float v) {
    v += SWZ_XOR(v, 1); v += SWZ_XOR(v, 2); v += SWZ_XOR(v, 4); v += SWZ_XOR(v, 8); v += SWZ_XOR(v, 16);
    const auto rr = __builtin_amdgcn_permlane32_swap(__float_as_uint(v), __float_as_uint(v), false, false);
    return __uint_as_float(rr[0]) + __uint_as_float(rr[1]);
}
__device__ __forceinline__ float wave_max(float v) {
    v = fmaxf(v, SWZ_XOR(v, 1)); v = fmaxf(v, SWZ_XOR(v, 2)); v = fmaxf(v, SWZ_XOR(v, 4)); v = fmaxf(v, SWZ_XOR(v, 8)); v = fmaxf(v, SWZ_XOR(v, 16));
    const auto rr = __builtin_amdgcn_permlane32_swap(__float_as_uint(v), __float_as_uint(v), false, false);
    return fmaxf(__uint_as_float(rr[0]), __uint_as_float(rr[1]));
}
__device__ __forceinline__ float lane_bcast(float v, int k) { return __int_as_float(__builtin_amdgcn_readlane(__float_as_int(v), k)); }
__device__ __forceinline__ float silu_f(float x) { return x / (1.0f + expf(-x)); }
__device__ __forceinline__ float* hrow(const Frame& F, int r) { return r < MLAT ? F.out + (size_t)r * DM : (float*)(F.ws + WS_HCTX) + (size_t)(r - MLAT) * DM; }
__device__ __forceinline__ const float* modvec(const Frame& F, int layer, int r) { const int idx = r < MLAT ? layer * 4 + r / SEQ : 16 + layer; return (const float*)(F.ws + WS_MOD) + (size_t)idx * (NMOD * DM); }

__device__ __forceinline__ void p0_transpose_item(const float* W, int K, int N, bf16* WT, LAS float* scr, int item, int lane) {
    const int nblk = N / 32, kb = item / nblk, nb = item % nblk, k0 = 64 * kb, n0 = 32 * nb;
#pragma unroll 8
    for (int i = 0; i < 32; ++i) { const int kk = 2 * i + (lane >> 5); scr[kk * 33 + (lane & 31)] = W[(size_t)(k0 + kk) * N + n0 + (lane & 31)]; }
    LDS_WAIT(); asm volatile("" ::: "memory");
    const int c = lane & 7;
#pragma unroll
    for (int j = 0; j < 4; ++j) { const int n = (lane >> 3) + 8 * j; const LAS float* s = scr + (8 * c) * 33 + n;
        v4u o; o.x = pk2(s[0 * 33], s[1 * 33]); o.y = pk2(s[2 * 33], s[3 * 33]); o.z = pk2(s[4 * 33], s[5 * 33]); o.w = pk2(s[6 * 33], s[7 * 33]);
        *(GAS v4u*)(WT + (size_t)(n0 + n) * K + k0 + 8 * c) = o; }
    LDS_WAIT(); asm volatile("" ::: "memory");
}
__device__ __forceinline__ void p0_prologue(Frame& F) {
    const int gw = F.vcu * NWAVES + F.wave, NGW = F.G * NWAVES;
    LAS float* S = (LAS float*)F.lds;
    LAS float* RED = (LAS float*)(F.lds + 32768);
    for (int e = F.tid; e < 5 * DM; e += NTHREADS) { const int v = e / DM, k = e % DM; const float x = v < 4 ? F.inp(I_C)[v * DM + k] : F.inp(I_CCTX)[k]; S[e] = silu_f(x); }
    __syncthreads();
    for (int it = F.bx; it < DEPTH * (NMOD * DM / 64); it += F.G) {
        const int layer = it / (NMOD * DM / 64), cb = it % (NMOD * DM / 64), n = cb * 64 + F.lane;
        const float* W = F.inp(I_MODW) + (size_t)layer * DM * (NMOD * DM) + n;
        float a0 = 0.f, a1 = 0.f, a2 = 0.f, a3 = 0.f, a4 = 0.f;
        const int k0 = F.wave * 128;
#pragma unroll 8
        for (int k = k0; k < k0 + 128; ++k) { const float w = W[(size_t)k * (NMOD * DM)]; a0 += S[k] * w; a1 += S[DM + k] * w; a2 += S[2 * DM + k] * w; a3 += S[3 * DM + k] * w; a4 += S[4 * DM + k] * w; }
        RED[(F.wave * 5 + 0) * 64 + F.lane] = a0; RED[(F.wave * 5 + 1) * 64 + F.lane] = a1; RED[(F.wave * 5 + 2) * 64 + F.lane] = a2; RED[(F.wave * 5 + 3) * 64 + F.lane] = a3; RED[(F.wave * 5 + 4) * 64 + F.lane] = a4;
        __syncthreads();
        if (F.tid < 320) { const int v = F.tid / 64, l = F.tid % 64; float s = 0.f;
#pragma unroll
            for (int w = 0; w < 8; ++w) s += RED[(w * 5 + v) * 64 + l];
            s += F.inp(I_MODB)[layer * (NMOD * DM) + cb * 64 + l];
            const int idx = v < 4 ? layer * 4 + v : 16 + layer;
            ((float*)(F.ws + WS_MOD))[(size_t)idx * (NMOD * DM) + cb * 64 + l] = s; }
        __syncthreads();
    }
    __syncthreads();
    LAS float* scr = (LAS float*)(F.lds + F.wave * 16384);
    for (int mat = 0; mat < 16; ++mat) {
        const float* src; bf16* dst; int K, N;
        if (mat < 2)       { src = F.inp(I_AQKV) + (size_t)mat * DM * A_COLS; dst = (bf16*)(F.ws + WS_W_AQKV) + (size_t)mat * A_COLS * DM; K = DM; N = A_COLS; }
        else if (mat < 4)  { src = F.inp(I_AOUT) + (size_t)(mat - 2) * DM * DM; dst = (bf16*)(F.ws + WS_W_AOUT) + (size_t)(mat - 2) * DM * DM; K = DM; N = DM; }
        else if (mat == 4) { src = F.inp(I_BIN); dst = (bf16*)(F.ws + WS_W_BIN); K = DM; N = 3 * DM; }
        else if (mat == 5) { src = F.inp(I_BOUT); dst = (bf16*)(F.ws + WS_W_BOUT); K = DM; N = DM; }
        else if (mat == 6) { src = F.inp(I_CQKV); dst = (bf16*)(F.ws + WS_W_CQKV); K = DM; N = C_COLS; }
        else if (mat == 7) { src = F.inp(I_COUT); dst = (bf16*)(F.ws + WS_W_COUT); K = DM; N = DM; }
        else if (mat < 12) { src = F.inp(I_WUP) + (size_t)(mat - 8) * DM * 2 * DFF; dst = (bf16*)(F.ws + WS_W_UP) + (size_t)(mat - 8) * 2 * DFF * DM; K = DM; N = 2 * DFF; }
        else               { src = F.inp(I_WDOWN) + (size_t)(mat - 12) * DFF * DM; dst = (bf16*)(F.ws + WS_W_DOWN) + (size_t)(mat - 12) * DM * DFF; K = DFF; N = DM; }
        const int items = (K / 64) * (N / 32);
        for (int it = gw; it < items; it += NGW) p0_transpose_item(src, K, N, dst, scr, it, F.lane);
    }
    for (int r = gw; r < MT; r += NGW) {
        const f32x4* s = (const f32x4*)(r < MLAT ? F.inp(I_X) + (size_t)r * DM : F.inp(I_CTX) + (size_t)(r - MLAT) * DM) + F.lane;
        f32x4* d = (f32x4*)hrow(F, r) + F.lane;
#pragma unroll
        for (int j = 0; j < 4; ++j) d[64 * j] = s[64 * j];
    }
    for (int pos = gw; pos < SEQ + CTXL; pos += NGW) {
        const bool lat = pos < SEQ; const int L = lat ? SEQ : CTXL, t = lat ? pos : pos - SEQ;
        float* Hc = (float*)(F.ws + (lat ? WS_HCLAT : WS_HCCTX));
        const float tn = (float)t / (float)(L - 1);
        const float omega = (6.283185307179586f / (float)L) * (float)t;
        float zv = 0.f;
        { const int k = F.lane;
          if (k == 0) zv = tn;
          else if (k <= 32) { const int kb = (k - 1) & 15; const float band = 1e-4f + (float)kb * ((15.0f - 1e-4f) / 15.0f); const float ang = omega * band; zv = (k <= 16) ? cosf(ang) : -sinf(ang); } }
        const float* w1 = F.inp(I_FW1); const float* w2 = F.inp(I_FW2); const float* w3 = F.inp(I_FW3); const float* w4 = F.inp(I_FW4);
        float a = F.inp(I_FB1)[F.lane];
        for (int k = 0; k < 33; ++k) a += lane_bcast(zv, k) * w1[k * 64 + F.lane];
        float f = sinf(a);
        a = F.inp(I_FB2)[F.lane];
        for (int k = 0; k < 64; ++k) a += lane_bcast(f, k) * w2[k * 64 + F.lane];
        f = sinf(a);
        a = F.inp(I_FB3)[F.lane];
        for (int k = 0; k < 64; ++k) a += lane_bcast(f, k) * w3[k * 64 + F.lane];
        f = sinf(a);
        float acc[32];
#pragma unroll
        for (int j = 0; j < 32; ++j) acc[j] = 0.f;
        for (int k = 0; k < 64; ++k) { const float fk = lane_bcast(f, k); const float* wr = w4 + (size_t)k * (2 * DM) + F.lane;
#pragma unroll
            for (int j = 0; j < 32; ++j) acc[j] += fk * wr[64 * j]; }
        const float r0 = -15.350567286626973f, r1 = -3.0701134573253945f;
#pragma unroll
        for (int j = 0; j < 32; ++j) { const int n2 = F.lane + 64 * j, d = n2 & (DM - 1);
            const float rate = fabsf(r0 + (float)d * ((r1 - r0) / (float)(DM - 1)));
            const float dec = expf(-tn * rate), val = acc[j] * dec;
            if (n2 < DM) Hc[(size_t)(t + L - 1) * DM + d] = val;
            else if (t >= 1) Hc[(size_t)(L - 1 - t) * DM + d] = val; }
    }
}

__device__ __forceinline__ void row_phase(Frame& F, int nrows, const bf16* src, int l_res, int g_res, int gate_idx, bool do_norm, int l_n, int g_n, int shift_idx, int scale_idx) {
    const int gw = F.vcu * NWAVES + F.wave, NGW = F.G * NWAVES;
    const float* NG = F.inp(I_NORMG);
    bf16* U = (bf16*)(F.ws + WS_U);
    for (int r = gw; r < nrows; r += NGW) {
        float* h = hrow(F, r);
        f32x4 v[4];
#pragma unroll
        for (int j = 0; j < 4; ++j) v[j] = *((const f32x4*)h + F.lane + 64 * j);
        if (src) {
            const float* mv = modvec(F, l_res, r) + gate_idx * DM; const float* g = NG + (size_t)(l_res * 4 + g_res) * DM;
            f32x4 o[4]; float ss = 0.f;
#pragma unroll
            for (int j = 0; j < 4; ++j) { const uint2 w = *((const uint2*)(src + (size_t)r * DM) + F.lane + 64 * j);
                o[j] = (f32x4){bf2f(w.x & 0xffffu), bf2f(w.x >> 16), bf2f(w.y & 0xffffu), bf2f(w.y >> 16)};
                ss += (o[j].x * o[j].x + o[j].y * o[j].y) + (o[j].z * o[j].z + o[j].w * o[j].w); }
            const float rs = 1.0f / sqrtf(wave_sum(ss) * (1.0f / DM) + EPS);
#pragma unroll
            for (int j = 0; j < 4; ++j) { const f32x4 gg = *((const f32x4*)g + F.lane + 64 * j), mm = *((const f32x4*)mv + F.lane + 64 * j);
                v[j] = v[j] + mm * (o[j] * rs * gg);
                *((f32x4*)h + F.lane + 64 * j) = v[j]; }
        }
        if (do_norm) {
            const float* mv = modvec(F, l_n, r); const float* g = NG + (size_t)(l_n * 4 + g_n) * DM;
            float ss = 0.f;
#pragma unroll
            for (int j = 0; j < 4; ++j) ss += (v[j].x * v[j].x + v[j].y * v[j].y) + (v[j].z * v[j].z + v[j].w * v[j].w);
            const float rs = 1.0f / sqrtf(wave_sum(ss) * (1.0f / DM) + EPS);
#pragma unroll
            for (int j = 0; j < 4; ++j) { const f32x4 gg = *((const f32x4*)g + F.lane + 64 * j), sh = *((const f32x4*)(mv + shift_idx * DM) + F.lane + 64 * j), sc = *((const f32x4*)(mv + scale_idx * DM) + F.lane + 64 * j);
                const f32x4 y = (v[j] * rs * gg) * (sc + 1.0f) + sh;
                uint2 w; w.x = pk2(y.x, y.y); w.y = pk2(y.z, y.w);
                *((uint2*)(U + (size_t)r * DM) + F.lane + 64 * j) = w; }
        }
    }
}

__device__ __forceinline__ void prep_a(Frame& F, int j) {
    const int gw = F.vcu * NWAVES + F.wave, NGW = F.G * NWAVES, lane = F.lane;
    const bf16* QKV = (const bf16*)(F.ws + WS_R + R_QKV);
    bf16* QN = (bf16*)(F.ws + WS_R + R_QN); bf16* KB = (bf16*)(F.ws + WS_R + R_KB); bf16* VB = (bf16*)(F.ws + WS_R + R_VB);
    const float* qg = F.inp(I_AQG) + j * A_DH; const float* kg = F.inp(I_AKG) + j * A_DH;
    const float inv = expf(-(float)(2 * (lane & 31)) * (9.210340371976184f / 64.0f));
    for (int r = gw; r < MT; r += NGW) {
        const bool lat = r < MLAT; const int b = lat ? r / SEQ : (r - MLAT) / CTXL, t = lat ? r % SEQ : (r - MLAT) % CTXL, key = lat ? CTXL + t : t;
        const float pos = (float)(lane < 32 ? t / GRID_W : t % GRID_W), ang = pos * inv;
        const float cs = lat ? cosf(ang) : 1.f, sn = lat ? sinf(ang) : 0.f;
        const bf16* s = QKV + (size_t)r * A_COLS;
        const size_t kvrow = ((size_t)b * NKEY + key) * 256;
        for (int hh = 0; hh < A_HEADS + A_KV; ++hh) {
            const float x1 = bf2f(s[hh * A_DH + lane]), x2 = bf2f(s[hh * A_DH + 64 + lane]);
            const float rs = 1.0f / sqrtf(wave_sum(x1 * x1 + x2 * x2) * (1.0f / A_DH) + EPS);
            const float* g = hh < A_HEADS ? qg : kg;
            const float y1 = x1 * rs * g[lane], y2 = x2 * rs * g[64 + lane];
            const float o1 = y1 * cs - y2 * sn, o2 = y1 * sn + y2 * cs;
            bf16* d = hh < A_HEADS ? QN + (size_t)r * DM + hh * A_DH : KB + kvrow + (hh - A_HEADS) * A_DH;
            d[lane] = (bf16)f2bf(o1); d[64 + lane] = (bf16)f2bf(o2);
        }
#pragma unroll
        for (int jj = 0; jj < 4; ++jj) VB[kvrow + lane + 64 * jj] = s[(A_HEADS + A_KV) * A_DH + lane + 64 * jj];
    }
}
__device__ __forceinline__ void prep_c(Frame& F) {
    const int gw = F.vcu * NWAVES + F.wave, NGW = F.G * NWAVES, lane = F.lane;
    const bf16* QKV = (const bf16*)(F.ws + WS_R + R_QKV);
    bf16* QN = (bf16*)(F.ws + WS_R + R_QN); bf16* KB = (bf16*)(F.ws + WS_R + R_KB); bf16* VB = (bf16*)(F.ws + WS_R + R_VB);
    const int i = lane & 31, hsel = lane >> 5;
    const float inv = expf(-(float)(2 * (i & 15)) * (9.210340371976184f / 32.0f));
    for (int r = gw; r < MT; r += NGW) {
        const bool lat = r < MLAT; const int b = lat ? r / SEQ : (r - MLAT) / CTXL, t = lat ? r % SEQ : (r - MLAT) % CTXL, key = lat ? CTXL + t : t;
        const float pos = (float)(i < 16 ? t / GRID_W : t % GRID_W), ang = pos * inv;
        const float cs = lat ? cosf(ang) : 1.f, sn = lat ? sinf(ang) : 0.f;
        const bf16* s = QKV + (size_t)r * C_COLS;
        const size_t kvrow = ((size_t)b * NKEY + key) * 128;
        for (int it = 0; it < (C_HEADS + C_KV) / 2; ++it) {
            const int hh = 2 * it + hsel;
            const float x1 = bf2f(s[hh * C_DH + i]), x2 = bf2f(s[hh * C_DH + 32 + i]);
            const float o1 = x1 * cs - x2 * sn, o2 = x1 * sn + x2 * cs;
            bf16* d = hh < C_HEADS ? QN + (size_t)r * DM + hh * C_DH : KB + kvrow + (hh - C_HEADS) * C_DH;
            d[i] = (bf16)f2bf(o1); d[32 + i] = (bf16)f2bf(o2);
        }
#pragma unroll
        for (int jj = 0; jj < 2; ++jj) VB[kvrow + lane + 64 * jj] = s[(C_HEADS + C_KV) * C_DH + lane + 64 * jj];
    }
}

template <int MODE>
__device__ __forceinline__ void attn_naive(Frame& F, int nrows, const float* sink) {
    constexpr int DH = MODE == 0 ? A_DH : C_DH, KVW = MODE == 0 ? 256 : 128, NH = MODE == 0 ? A_HEADS : C_HEADS, GQ = MODE == 0 ? 4 : 8;
    const float scale = MODE == 0 ? 0.08838834764831845f : 0.125f;
    const int gw = F.vcu * NWAVES + F.wave, NGW = F.G * NWAVES, lane = F.lane;
    const bf16* QN = (const bf16*)(F.ws + WS_R + R_QN); const bf16* KB = (const bf16*)(F.ws + WS_R + R_KB); const bf16* VB = (const bf16*)(F.ws + WS_R + R_VB);
    bf16* OP = (bf16*)(F.ws + WS_U);
    LAS float* sc = (LAS float*)(F.lds + F.wave * ((NKEY + 128) * 4));
    LAS float* qs = sc + NKEY;
    for (int u = gw; u < nrows * NH; u += NGW) {
        const int r = u / NH, h = u % NH, kvh = h / GQ;
        const bool lat = r < MLAT; const int b = lat ? r / SEQ : (r - MLAT) / CTXL, t = lat ? r % SEQ : (r - MLAT) % CTXL;
        int lo = 0, nloc = 0;
        if (lat) { if (MODE == 0) { lo = 0; nloc = SEQ; } else { lo = t - WINDOW < 0 ? 0 : t - WINDOW; const int hi = t + WINDOW > SEQ - 1 ? SEQ - 1 : t + WINDOW; nloc = hi - lo + 1; } }
        const int nk = CTXL + nloc;
        const bf16* q = QN + (size_t)r * DM + h * DH;
        if (DH == 128) { qs[lane] = bf2f(q[lane]); qs[64 + lane] = bf2f(q[64 + lane]); } else { qs[lane] = bf2f(q[lane]); }
        LDS_WAIT(); asm volatile("" ::: "memory");
        const bf16* Kb = KB + (size_t)b * NKEY * KVW + kvh * DH; const bf16* Vb = VB + (size_t)b * NKEY * KVW + kvh * DH;
        float mx = -1e30f;
        for (int kk = lane; kk < nk; kk += 64) {
            const int key = kk < CTXL ? kk : CTXL + lo + (kk - CTXL);
            const bf16* kr = Kb + (size_t)key * KVW;
            float dot = 0.f;
#pragma unroll 4
            for (int d = 0; d < DH; d += 8) { const v4u w = *(const v4u*)(kr + d);
                dot += qs[d] * bf2f(w.x & 0xffffu) + qs[d + 1] * bf2f(w.x >> 16) + qs[d + 2] * bf2f(w.y & 0xffffu) + qs[d + 3] * bf2f(w.y >> 16)
                     + qs[d + 4] * bf2f(w.z & 0xffffu) + qs[d + 5] * bf2f(w.z >> 16) + qs[d + 6] * bf2f(w.w & 0xffffu) + qs[d + 7] * bf2f(w.w >> 16); }
            dot *= scale; sc[kk] = dot; mx = fmaxf(mx, dot);
        }
        mx = wave_max(mx);
        float sl = 0.f;
        if (MODE == 1) { sl = sink[h]; mx = fmaxf(mx, sl); }
        float sum = 0.f;
        for (int kk = lane; kk < nk; kk += 64) { const float p = expf(sc[kk] - mx); sc[kk] = p; sum += p; }
        sum = wave_sum(sum);
        if (MODE == 1) sum += expf(sl - mx);
        LDS_WAIT(); asm volatile("" ::: "memory");
        const float rinv = 1.0f / sum;
        if (DH == 128) {
            float o0 = 0.f, o1 = 0.f;
            for (int kk = 0; kk < nk; ++kk) { const int key = kk < CTXL ? kk : CTXL + lo + (kk - CTXL); const float p = sc[kk];
                const unsigned w = *(const unsigned*)(Vb + (size_t)key * KVW + 2 * lane); o0 += p * bf2f(w & 0xffffu); o1 += p * bf2f(w >> 16); }
            *(unsigned*)(OP + (size_t)r * DM + h * DH + 2 * lane) = pk2(o0 * rinv, o1 * rinv);
        } else {
            float o0 = 0.f;
            for (int kk = 0; kk < nk; ++kk) { const int key = kk < CTXL ? kk : CTXL + lo + (kk - CTXL); const float p = sc[kk];
                o0 += p * bf2f(Vb[(size_t)key * KVW + lane]); }
            OP[(size_t)r * DM + h * DH + lane] = (bf16)f2bf(o0 * rinv);
        }
        LDS_WAIT(); asm volatile("" ::: "memory");
    }
}

__device__ __forceinline__ float hy_dwconv(const bf16* u3, int r, int col, bool has_prev, bool has_next, const float* cw, const float* cb) {
    float a = cb[col] + cw[3 * DM + col] * bf2f(u3[(size_t)r * (3 * DM) + col]);
    if (has_prev) a += cw[col] * bf2f(u3[(size_t)(r - 1) * (3 * DM) + col]);
    if (has_next) a += cw[2 * 3 * DM + col] * bf2f(u3[(size_t)(r + 1) * (3 * DM) + col]);
    return a;
}
__device__ __forceinline__ void hy1(Frame& F) {
    const bf16* u3 = (const bf16*)(F.ws + WS_R + R_QKV); float* VP = (float*)(F.ws + WS_R + R_VP);
    const float* cw = F.inp(I_BCW); const float* cb = F.inp(I_BCB);
    const size_t total = (size_t)MT * DM, stride = (size_t)F.G * NTHREADS;
    for (size_t e = (size_t)F.vcu * NTHREADS + F.tid; e < total; e += stride) {
        const int r = (int)(e / DM), d = (int)(e % DM);
        const bool lat = r < MLAT; const int t = lat ? r % SEQ : (r - MLAT) % CTXL, L = lat ? SEQ : CTXL;
        const bool hp = t > 0, hn = t < L - 1;
        VP[e] = hy_dwconv(u3, r, 2 * DM + d, hp, hn, cw, cb) * hy_dwconv(u3, r, DM + d, hp, hn, cw, cb);
    }
}
__device__ __forceinline__ void hyconv_naive(Frame& F, bool with_ctx) {
    const bf16* u3 = (const bf16*)(F.ws + WS_R + R_QKV); const float* VP = (const float*)(F.ws + WS_R + R_VP);
    bf16* OP = (bf16*)(F.ws + WS_U);
    const float* cw = F.inp(I_BCW); const float* cb = F.inp(I_BCB); const float* skip = F.inp(I_BSKIP);
    const int n_lat = BATCH * (SEQ / 8) * DM, n_ctx = with_ctx ? BATCH * (CTXL / 8) * DM : 0;
    const int stride = F.G * NTHREADS;
    for (int it = F.vcu * NTHREADS + F.tid; it < n_lat + n_ctx; it += stride) {
        const bool lat = it < n_lat; const int q = lat ? it : it - n_lat;
        const int L = lat ? SEQ : CTXL, d = q % DM, tb = (q / DM) % (L / 8), b = q / (DM * (L / 8));
        const int rbase = lat ? b * SEQ : MLAT + b * CTXL, t0 = tb * 8;
        const float* Hc = (const float*)(F.ws + (lat ? WS_HCLAT : WS_HCCTX)) + d;
        const float* vp = VP + (size_t)rbase * DM + d;
        float y[8];
#pragma unroll
        for (int k = 0; k < 8; ++k) y[k] = 0.f;
        for (int s0 = 0; s0 < L; s0 += 8) {
            const int base = t0 - s0 + L - 1 - 7;
            float f[15];
#pragma unroll
            for (int i = 0; i < 15; ++i) { const int idx = base + i; f[i] = (idx >= 0 && idx <= 2 * L - 2) ? Hc[(size_t)idx * DM] : 0.f; }
#pragma unroll
            for (int j = 0; j < 8; ++j) { const float v = vp[(size_t)(s0 + j) * DM];
#pragma unroll
                for (int k = 0; k < 8; ++k) y[k] += f[k - j + 7] * v; }
        }
        const float sk = skip[d];
#pragma unroll
        for (int k = 0; k < 8; ++k) { const int t = t0 + k, r = rbase + t;
            const float x0 = hy_dwconv(u3, r, d, t > 0, t < L - 1, cw, cb);
            OP[(size_t)r * DM + d] = (bf16)f2bf((y[k] + sk * vp[(size_t)t * DM]) * x0); }
    }
}

__device__ __forceinline__ void ffn_act(Frame& F, int layer, int nrows) {
    bf16* G = (bf16*)(F.ws + WS_R + R_G);
    const float* cw = F.inp(I_FCW) + (size_t)layer * 3 * DFF; const float* cb = F.inp(I_FCB) + (size_t)layer * DFF;
    const int per_row = DFF / 8, total = nrows * per_row, stride = F.G * NTHREADS;
    for (int it = F.vcu * NTHREADS + F.tid; it < total; it += stride) {
        const int r = it / per_row, c = (it % per_row) * 8;
        const bool lat = r < MLAT; const int t = lat ? r % SEQ : (r - MLAT) % CTXL, L = lat ? SEQ : CTXL;
        const bf16* g = G + (size_t)r * (2 * DFF) + c;
        const v4u z = {0u, 0u, 0u, 0u};
        const v4u g0 = t > 0 ? *(const v4u*)(g - 2 * DFF) : z, g1 = *(const v4u*)g, g2 = t < L - 1 ? *(const v4u*)(g + 2 * DFF) : z, up = *(const v4u*)(g + DFF);
        const unsigned a0[4] = {g0.x, g0.y, g0.z, g0.w}, a1[4] = {g1.x, g1.y, g1.z, g1.w}, a2[4] = {g2.x, g2.y, g2.z, g2.w}, au[4] = {up.x, up.y, up.z, up.w};
        unsigned o[4];
#pragma unroll
        for (int p = 0; p < 4; ++p) {
            float res[2];
#pragma unroll
            for (int hlf = 0; hlf < 2; ++hlf) { const int cc = c + 2 * p + hlf;
                const float e0 = hlf ? bf2f(a0[p] >> 16) : bf2f(a0[p] & 0xffffu), e1 = hlf ? bf2f(a1[p] >> 16) : bf2f(a1[p] & 0xffffu), e2 = hlf ? bf2f(a2[p] >> 16) : bf2f(a2[p] & 0xffffu);
                const float uu = hlf ? bf2f(au[p] >> 16) : bf2f(au[p] & 0xffffu);
                const float gc = cb[cc] + cw[cc] * e0 + cw[DFF + cc] * e1 + cw[2 * DFF + cc] * e2;
                res[hlf] = silu_f(gc) * uu; }
            o[p] = pk2(res[0], res[1]); }
        *(v4u*)(G + (size_t)r * (2 * DFF) + DFF + c) = (v4u){o[0], o[1], o[2], o[3]};
    }
}

constexpr int N_PHASES = 2 + 9 * DEPTH;
__global__ void __launch_bounds__(NTHREADS, 2) fwd_kernel(Args args) {
    extern __shared__ __attribute__((aligned(16))) unsigned char lds[];
    Frame F;
    F.lds = (LAS unsigned char*)lds; F.ldsg = lds;
    F.MISC = (volatile LAS unsigned*)(F.lds + MISC_OFF);
    F.tid = threadIdx.x; F.lane = F.tid & 63; F.wave = __builtin_amdgcn_readfirstlane(F.tid >> 6);
    F.G = gridDim.x; { const int bx = blockIdx.x; F.vcu = (F.G % 8 == 0) ? (bx % 8) * (F.G / 8) + bx / 8 : bx; }
    F.out = args.out; F.ws = args.ws; F.ctl = (gu32*)(args.ws + WS_CTL);
    F.intab = (LAS unsigned long long*)(F.lds + INTAB_OFF);
    for (int u = F.tid; u < 64; u += NTHREADS) ((LAS unsigned*)(F.lds + MISC_OFF))[u] = 0u;
    if (F.tid < N_IN) F.intab[F.tid] = (unsigned long long)args.in[F.tid];
    __syncthreads();
    XcdBarrier bar; bar.bar = (unsigned*)(F.ctl + CW_BAR); bar.x = 0; bar.st = nullptr;
    if (args.single) bar = xcd_barrier_post((unsigned*)(F.ctl + CW_BAR), F.MISC + 8);

    for (int p = args.ph_lo; p < args.ph_hi; ++p) {
        { unsigned char* ws_ = args.ws; float* out_ = args.out; asm volatile("" : "+s"(ws_), "+s"(out_)); F.ws = ws_; F.out = out_;
          int tid_ = threadIdx.x, G_ = gridDim.x, bx_ = blockIdx.x; asm volatile("" : "+v"(tid_), "+s"(G_), "+s"(bx_));
          F.tid = tid_; F.lane = tid_ & 63; F.wave = __builtin_amdgcn_readfirstlane(tid_ >> 6); F.G = G_; F.bx = bx_; F.vcu = (G_ % 8 == 0) ? (bx_ % 8) * (G_ / 8) + bx_ / 8 : bx_; }
        if (p == 0) { p0_prologue(F); }
        else if (p == 1) { row_phase(F, MT, nullptr, 0, 0, 0, true, 0, 0, 0, 1); }
        else {
            const int q = p - 2, layer = q / 9, s = q % 9, kind = layer % 3, j = layer / 3;
            const bool need_ctx = layer < DEPTH - 1;
            const int nrows = need_ctx ? MT : MLAT;
            if (s == 0 || s == 3 || s == 5 || s == 7) {
                pg8::Gemm g; pg8::EpiBf16 E;
                if (s == 0) {
                    g.A = (const bf16*)(F.ws + WS_U); g.lda = DM; g.K = DM; g.M = MT;
                    E.O = (bf16*)(F.ws + WS_R + R_QKV);
                    if (kind == 0)      { g.Bt = (const bf16*)(F.ws + WS_W_AQKV) + (size_t)j * A_COLS * DM; g.N = A_COLS; E.bias = nullptr; }
                    else if (kind == 1) { g.Bt = (const bf16*)(F.ws + WS_W_BIN); g.N = 3 * DM; E.bias = F.inp(I_BBIN); if (!need_ctx) g.M = MLAT; }
                    else                { g.Bt = (const bf16*)(F.ws + WS_W_CQKV); g.N = C_COLS; E.bias = F.inp(I_CBQKV); }
                    E.ldc = g.N;
                } else if (s == 3) {
                    g.A = (const bf16*)(F.ws + WS_U); g.lda = DM; g.K = DM; g.M = nrows; g.N = DM;
                    if (kind == 0)      { g.Bt = (const bf16*)(F.ws + WS_W_AOUT) + (size_t)j * DM * DM; E.bias = nullptr; }
                    else if (kind == 1) { g.Bt = (const bf16*)(F.ws + WS_W_BOUT); E.bias = F.inp(I_BBOUT); }
                    else                { g.Bt = (const bf16*)(F.ws + WS_W_COUT); E.bias = F.inp(I_CBOUT); }
                    E.O = (bf16*)(F.ws + WS_R + R_O); E.ldc = DM;
                } else if (s == 5) {
                    g.A = (const bf16*)(F.ws + WS_U); g.lda = DM; g.K = DM; g.M = nrows; g.N = 2 * DFF;
                    g.Bt = (const bf16*)(F.ws + WS_W_UP) + (size_t)layer * 2 * DFF * DM; E.bias = nullptr;
                    E.O = (bf16*)(F.ws + WS_R + R_G); E.ldc = 2 * DFF;
                } else {
                    g.A = (const bf16*)(F.ws + WS_R + R_G) + DFF; g.lda = 2 * DFF; g.K = DFF; g.M = nrows; g.N = DM;
                    g.Bt = (const bf16*)(F.ws + WS_W_DOWN) + (size_t)layer * DM * DFF; E.bias = nullptr;
                    E.O = (bf16*)(F.ws + WS_U); E.ldc = DM;
                }
                pg8::StaticOrder S; S.init(g.M, g.N, F.G, F.bx);
                pg8::gemm_phase<pg8::EpiBf16, pg8::StaticOrder, true, true>(F.lds, g, S, E, F.tid);
            } else if (s == 1) {
                if (kind == 0) prep_a(F, j); else if (kind == 1) hy1(F); else prep_c(F);
            } else if (s == 2) {
                if (kind == 0) attn_naive<0>(F, nrows, nullptr); else if (kind == 1) hyconv_naive(F, need_ctx); else attn_naive<1>(F, nrows, F.inp(I_CSINK));
            } else if (s == 4) {
                row_phase(F, nrows, (const bf16*)(F.ws + WS_R + R_O), layer, 1, 2, true, layer, 2, 3, 4);
            } else if (s == 6) {
                ffn_act(F, layer, nrows);
            } else {
                const bool more = layer + 1 < DEPTH;
                row_phase(F, nrows, (const bf16*)(F.ws + WS_U), layer, 3, 5, more, layer + 1, 0, 0, 1);
            }
        }
        if (p + 1 < args.ph_hi) { asm volatile("" : "+s"(bar.bar), "+s"(bar.x)); xcd_barrier(bar); }
    }
}

#ifndef SINGLE_LAUNCH
#define SINGLE_LAUNCH 0
#endif
extern "C" void kernel_launch(void* const* d_in, const int* in_sizes, int n_in, void* d_out, int out_size, void* d_ws, size_t ws_size, hipStream_t stream) {
    static int grid = 0;
    if (grid == 0) {
        if (n_in != N_IN || out_size != MLAT * DM || ws_size < WS_END) { fprintf(stderr, "kernel_launch: unexpected shapes: n_in %d out %d ws %zu (need %zu)\n", n_in, out_size, ws_size, (size_t)WS_END); grid = -1; return; }
        int dev = 0, cus = 0;
        if (hipGetDevice(&dev) != hipSuccess || hipDeviceGetAttribute(&cus, hipDeviceAttributeMultiprocessorCount, dev) != hipSuccess) { grid = -1; return; }
        if (hipFuncSetAttribute((const void*)fwd_kernel, hipFuncAttributeMaxDynamicSharedMemorySize, LDS_BYTES) != hipSuccess) { fprintf(stderr, "kernel_launch: hipFuncSetAttribute failed\n"); grid = -1; return; }
        int per_cu = 0;
        if (hipOccupancyMaxActiveBlocksPerMultiprocessor(&per_cu, (const void*)fwd_kernel, NTHREADS, LDS_BYTES) != hipSuccess || per_cu < 1) fprintf(stderr, "kernel_launch: occupancy query reports %d\n", per_cu);
        (void)hipGetLastError();
        grid = cus;
    }
    if (grid < 0) return;
    if (hipMemsetAsync((char*)d_ws + WS_CTL, 0, CTL_ZERO_BYTES, stream) != hipSuccess) return;
    Args a{};
    for (int i = 0; i < N_IN; ++i) a.in[i] = (const float*)d_in[i];
    a.out = (float*)d_out; a.ws = (unsigned char*)d_ws;
#if SINGLE_LAUNCH
    a.ph_lo = 0; a.ph_hi = N_PHASES; a.single = 1;
    hipLaunchKernelGGL(fwd_kernel, dim3(grid), dim3(NTHREADS), LDS_BYTES, stream, a);
#else
    for (int p = 0; p < N_PHASES; ++p) { a.ph_lo = p; a.ph_hi = p + 1; a.single = 0;
        hipLaunchKernelGGL(fwd_kernel, dim3(grid), dim3(NTHREADS), LDS_BYTES, stream, a); }
#endif
    const hipError_t le = hipPeekAtLastError();
    if (le != hipSuccess) fprintf(stderr, "kernel_launch: launch failed: %s\n", hipGetErrorName(le));
}
```

```cpp
#include <hip/hip_runtime.h>
#include <cstdio>
#include <cstdint>
#include <cmath>
namespace pg8 {
#define PG8_LAS __attribute__((address_space(3)))
typedef unsigned short bf16_t;
typedef short bf16x8 __attribute__((ext_vector_type(8)));
typedef float f32x4 __attribute__((ext_vector_type(4)));
typedef unsigned u32x4 __attribute__((ext_vector_type(4)));
constexpr int BM = 256, BK = 64, HALF = 128, HTB = HALF * BK * 2  , STAGE_BYTES = 8 * HTB, NXCD = 8, WGM = 8;

__host__ __device__ __forceinline__ int lds_byte(int r, int c) { const int st = (r >> 4) * 2 + (c >> 5), rr = r & 15, cc = c & 31, ob = rr * 64 + cc * 2; return st * 1024 + (ob ^ (((ob >> 9) & 1) << 5)); }
__host__ __device__ __forceinline__ void stage_rc(int b, int& R, int& C) { const int st = b / 1024, sb = b % 1024, swz = sb ^ (((sb >> 9) & 1) << 5); R = (st >> 1) * 16 + swz / 64; C = (st & 1) * 32 + (swz % 64) / 2; }
__host__ __device__ __forceinline__ int perm32(int rho) { const int n = rho >> 4, i = rho & 15; return 8 * (i >> 2) + 4 * n + (i & 3); }

struct Unit { int pm, pn, kt0, nt, split; };
struct Gemm { const bf16_t* A; const bf16_t* Bt; int M, N, K, lda, rowstep; };

struct StaticOrder {
    int nM, nN, nwg, G, c, ntK;
    __host__ __device__ __forceinline__ void init(int M, int N, int G_, int c_, int K_) { nM = M / BM; nN = N / BM; nwg = nM * nN; G = G_; c = c_; ntK = K_ / BK; }
    __host__ __device__ __forceinline__ bool next(int i, Unit& u) const {
        const long L = (long)i * G + c; if (L >= nwg) return false;
        u.kt0 = 0; u.nt = ntK; u.split = -1;
        int wgid = (int)L; { const int q = nwg / NXCD, r = nwg % NXCD, xcd = wgid % NXCD, off = wgid / NXCD; wgid = (xcd < r ? xcd * (q + 1) : r * (q + 1) + (xcd - r) * q) + off; }
        const int nig = WGM * nN, gid = wgid / nig, fm = gid * WGM, gsz = (nM - fm) < WGM ? (nM - fm) : WGM;
        u.pm = fm + ((wgid % nig) % gsz); u.pn = (wgid % nig) / gsz; return true;
    }
    __device__ __forceinline__ void a_ready(const Unit&) const {}
    __device__ __forceinline__ void done(const Unit&) const {}
};

__device__ __forceinline__ unsigned cvt_pk_bf16(float lo, float hi) { unsigned r; asm volatile("v_cvt_pk_bf16_f32 %0, %1, %2" : "=v"(r) : "v"(lo), "v"(hi)); return r; }
__device__ __forceinline__ int fresh_lane() { unsigned m = ~0u; asm volatile("" : "+s"(m)); return (int)__builtin_amdgcn_mbcnt_hi(m, __builtin_amdgcn_mbcnt_lo(m, 0u)); }
struct EpiBf16 {
    static constexpr bool PERM = true, AFTER_DRAIN = false;
    bf16_t* O; int ldc; const float* bias;
    __device__ __forceinline__ void operator()(const f32x4 (&acc)[2][2][4][2], const Unit& u, int wr, int wc, int fr, int fq) const {
        const int row0 = u.pm * BM + wr * 64 + fr; const int col0 = u.pn * BM + wc * 32 + 8 * fq;
        f32x4 bv[2][2];
#pragma unroll
        for (int bj = 0; bj < 2; ++bj)
#pragma unroll
            for (int n = 0; n < 2; ++n) bv[bj][n] = bias ? *(const f32x4*)(bias + col0 + bj * HALF + 4 * n) : (f32x4){0.f, 0.f, 0.f, 0.f};
#pragma unroll
        for (int ai = 0; ai < 2; ++ai)
#pragma unroll
            for (int m = 0; m < 4; ++m) { bf16_t* rowp = O + (size_t)(row0 + ai * HALF + m * 16) * ldc + col0;
#pragma unroll
                for (int bj = 0; bj < 2; ++bj) { const f32x4 v0 = acc[ai][bj][m][0] + bv[bj][0], v1 = acc[ai][bj][m][1] + bv[bj][1];
                    u32x4 w; w.x = cvt_pk_bf16(v0[0], v0[1]); w.y = cvt_pk_bf16(v0[2], v0[3]); w.z = cvt_pk_bf16(v1[0], v1[1]); w.w = cvt_pk_bf16(v1[2], v1[3]);
                    *(u32x4*)(rowp + bj * HALF) = w; } }
    }
};

struct RowStats {
    unsigned* xbuf;
    unsigned* cnt;
    unsigned* tmo;
    float eps;
    __device__ __forceinline__ bool run(const f32x4 (&v)[2][2][4][2], const Unit& u, int wr, int wc, int fr, int fq, PG8_LAS unsigned char* lds, int wid, int lane) const {
        PG8_LAS float* P = (PG8_LAS float*)lds;
        PG8_LAS float* S = (PG8_LAS float*)(lds + 8192);
        PG8_LAS unsigned* flag = (PG8_LAS unsigned*)(lds + 8192 + 2048);
#pragma unroll
        for (int ai = 0; ai < 2; ++ai)
#pragma unroll
            for (int m = 0; m < 4; ++m) {
                float s = 0.f;
#pragma unroll
                for (int bj = 0; bj < 2; ++bj)
#pragma unroll
                    for (int n = 0; n < 2; ++n) { const f32x4 x = v[ai][bj][m][n]; s += (x[0] * x[0] + x[1] * x[1]) + (x[2] * x[2] + x[3] * x[3]); }
                s += __int_as_float(__builtin_amdgcn_ds_swizzle(__float_as_int(s), (16 << 10) | 0x1f));
                { const auto rr = __builtin_amdgcn_permlane32_swap(__float_as_uint(s), __float_as_uint(s), false, false); s = __uint_as_float(rr[0]) + __uint_as_float(rr[1]); }
                if (fq == 0) P[(ai * HALF + wr * 64 + m * 16 + fr) * 4 + wc] = s;
            }
        asm volatile("s_waitcnt lgkmcnt(0)" ::: "memory"); __builtin_amdgcn_s_barrier(); asm volatile("" ::: "memory");
        const int row = wid * 32 + (lane & 31);
        if (lane < 32) {
            const float t = (P[row * 4 + 0] + P[row * 4 + 1]) + (P[row * 4 + 2] + P[row * 4 + 3]);
            unsigned long long* slot = (unsigned long long*)xbuf + ((size_t)(u.pm * BM + row) * 4 + u.pn);
            __hip_atomic_store(slot, (unsigned long long)__float_as_uint(t), __ATOMIC_RELAXED, __HIP_MEMORY_SCOPE_AGENT);
        }
        asm volatile("s_waitcnt vmcnt(0)" ::: "memory");
        if (lane == 0) __hip_atomic_fetch_add(cnt + 64 * u.pm, 1u, __ATOMIC_RELAXED, __HIP_MEMORY_SCOPE_AGENT);
        if (wid == 0) {
            bool dead = false; const unsigned long long t0 = __builtin_amdgcn_s_memrealtime(); const unsigned want = 32u;
            for (;;) {
                if ((unsigned)__builtin_amdgcn_readfirstlane(__hip_atomic_load(cnt + 64 * u.pm, __ATOMIC_RELAXED, __HIP_MEMORY_SCOPE_AGENT)) >= want) break;
                if (__builtin_amdgcn_s_memrealtime() - t0 > 2000000ull) { if (lane == 0) __hip_atomic_store(tmo, 1u, __ATOMIC_RELAXED, __HIP_MEMORY_SCOPE_AGENT); dead = true; break; }
                __builtin_amdgcn_s_sleep(2);
            }
            __builtin_amdgcn_fence(__ATOMIC_ACQUIRE, "agent");
            if (lane == 0) flag[0] = dead ? 1u : 0u;
        }
        asm volatile("s_waitcnt vmcnt(0) lgkmcnt(0)" ::: "memory"); __builtin_amdgcn_s_barrier(); asm volatile("" ::: "memory");
        const bool bad = flag[0] != 0u;
        if (lane < 32) {
            const unsigned long long* slot = (const unsigned long long*)xbuf + (size_t)(u.pm * BM + row) * 4; float tot = 0.f;
#pragma unroll
            for (int t = 0; t < 4; ++t) tot += __uint_as_float((unsigned)__hip_atomic_load(slot + t, __ATOMIC_RELAXED, __HIP_MEMORY_SCOPE_AGENT));
            S[row] = 1.0f / sqrtf(tot * (1.0f / 1024.0f) + eps);
        }
        asm volatile("s_waitcnt lgkmcnt(0)" ::: "memory"); __builtin_amdgcn_s_barrier(); asm volatile("" ::: "memory");
        return bad;
    }
};
struct EpiBf16Slab {
    static constexpr bool PERM = true, AFTER_DRAIN = false;
    bf16_t* O; int ldc; const float* bias; float* slab;
    int act; const float* cw; const float* cb; PG8_LAS float* ex; int nrows;
    unsigned* sig;
    int fuse, do_norm; const float* h_in; float* h_out; bf16_t* Uo; const float* g_res; const float* g_n; const float* mod_res; const float* mod_n; int gate_idx, shift_idx, scale_idx; RowStats st1, st2;
    __device__ __forceinline__ void fused(f32x4 (&acc)[2][2][4][2], const Unit& u, int wr, int wc, int fr, int fq, PG8_LAS unsigned char* lds, int wid, int lane) const {
        const PG8_LAS float* S = (const PG8_LAS float*)(lds + 8192);
        const int col0 = u.pn * BM + wc * 32 + 8 * fq, b = u.pm >> 4;
        const float qnan = __builtin_nanf("");
#pragma unroll
        for (int bj = 0; bj < 2; ++bj)
#pragma unroll
            for (int n = 0; n < 2; ++n) { const f32x4 bv = bias ? *(const f32x4*)(bias + col0 + bj * HALF + 4 * n) : (f32x4){0.f, 0.f, 0.f, 0.f};
#pragma unroll
                for (int ai = 0; ai < 2; ++ai)
#pragma unroll
                    for (int m = 0; m < 4; ++m) acc[ai][bj][m][n] += bv; }
        bool bad = st1.run(acc, u, wr, wc, fr, fq, lds, wid, lane);
        {
            const float* gt = mod_res + (size_t)b * 6144 + gate_idx * 1024;
            f32x4 gg[2][2], mm[2][2];
#pragma unroll
            for (int bj = 0; bj < 2; ++bj)
#pragma unroll
                for (int n = 0; n < 2; ++n) { gg[bj][n] = *(const f32x4*)(g_res + col0 + bj * HALF + 4 * n); mm[bj][n] = *(const f32x4*)(gt + col0 + bj * HALF + 4 * n); gg[bj][n] = gg[bj][n] * mm[bj][n]; }
#pragma unroll
            for (int ai = 0; ai < 2; ++ai)
#pragma unroll
                for (int m = 0; m < 4; ++m) { const int r = ai * HALF + wr * 64 + m * 16 + fr; const float rs = S[r]; const size_t off = (size_t)(u.pm * BM + r) * 1024 + col0;
#pragma unroll
                    for (int bj = 0; bj < 2; ++bj)
#pragma unroll
                        for (int n = 0; n < 2; ++n) { const f32x4 hb = *(const f32x4*)(h_in + off + bj * HALF + 4 * n); f32x4 o = hb + (acc[ai][bj][m][n] * rs) * gg[bj][n];
                            if (bad) o = (f32x4){qnan, qnan, qnan, qnan};
                            acc[ai][bj][m][n] = o; *(f32x4*)(h_out + off + bj * HALF + 4 * n) = o; }
                    if (m & 1) asm volatile("" ::: "memory"); }
        }
        if (!do_norm) return;
        bad = st2.run(acc, u, wr, wc, fr, fq, lds, wid, lane) || bad;
        {
            const float* mv = mod_n + (size_t)b * 6144;
            f32x4 gg[2][2], sh[2][2], sc[2][2];
#pragma unroll
            for (int bj = 0; bj < 2; ++bj)
#pragma unroll
                for (int n = 0; n < 2; ++n) { const int c = col0 + bj * HALF + 4 * n; gg[bj][n] = *(const f32x4*)(g_n + c); sh[bj][n] = *(const f32x4*)(mv + shift_idx * 1024 + c); sc[bj][n] = *(const f32x4*)(mv + scale_idx * 1024 + c) + 1.0f; gg[bj][n] = gg[bj][n] * sc[bj][n]; }
#pragma unroll
            for (int ai = 0; ai < 2; ++ai)
#pragma unroll
                for (int m = 0; m < 4; ++m) { const int r = ai * HALF + wr * 64 + m * 16 + fr; const float rs = S[r]; bf16_t* rowp = Uo + (size_t)(u.pm * BM + r) * 1024 + col0;
#pragma unroll
                    for (int bj = 0; bj < 2; ++bj) { const f32x4 y0 = (acc[ai][bj][m][0] * rs) * gg[bj][0] + sh[bj][0], y1 = (acc[ai][bj][m][1] * rs) * gg[bj][1] + sh[bj][1];
                        u32x4 w; w.x = cvt_pk_bf16(y0[0], y0[1]); w.y = cvt_pk_bf16(y0[2], y0[3]); w.z = cvt_pk_bf16(y1[0], y1[1]); w.w = cvt_pk_bf16(y1[2], y1[3]);
                        if (bad) { w.x = 0x7fc07fc0u; w.y = 0x7fc07fc0u; w.z = 0x7fc07fc0u; w.w = 0x7fc07fc0u; }
                        *(u32x4*)(rowp + bj * HALF) = w; } }
        }
    }
    __device__ __forceinline__ void prefetch(const Unit& u, int slot, int wid, PG8_LAS unsigned char* lds) const {
        if (wid != 0) return;
        const int lane = fresh_lane();
        PG8_LAS unsigned char* dst = lds + 131072 + 4096 + 2048 * slot;
        if (act) {
            const int arr = lane >> 5, col = 4 * (lane & 31);
            const float* s0 = (arr == 0 ? cw : cw + 2816) + u.pn * 128 + col; const float* s1 = (arr == 0 ? cw + 2 * 2816 : cb) + u.pn * 128 + col;
            __builtin_amdgcn_global_load_lds((const unsigned*)s0, (PG8_LAS unsigned*)dst, 16, 0, 0);
            __builtin_amdgcn_global_load_lds((const unsigned*)s1, (PG8_LAS unsigned*)(dst + 1024), 16, 0, 0);
        } else if (bias) {
            __builtin_amdgcn_global_load_lds((const unsigned*)(bias + u.pn * 256 + 4 * lane), (PG8_LAS unsigned*)dst, 16, 0, 0);
        }
    }
    __device__ __forceinline__ static float dpp_ror1(float v) { return __int_as_float(__builtin_amdgcn_mov_dpp(__float_as_int(v), 0x121, 0xf, 0xf, false)); }
    __device__ __forceinline__ static float dpp_ror15(float v) { return __int_as_float(__builtin_amdgcn_mov_dpp(__float_as_int(v), 0x12f, 0xf, 0xf, false)); }
    __device__ __forceinline__ void act_epilogue(const f32x4 (&acc)[2][2][4][2], const Unit& u, int wr, int wc, int fr, int fq, const PG8_LAS float* P) const {
        const int cl = wc * 32 + 8 * fq;
#pragma unroll
        for (int ai = 0; ai < 2; ++ai) { const int g = 2 * ai + wr;
            f32x4 e0, e1;
#pragma unroll
            for (int e = 0; e < 4; ++e) { e0[e] = fr == 0 ? acc[ai][0][0][0][e] : acc[ai][0][3][0][e]; e1[e] = fr == 0 ? acc[ai][0][0][1][e] : acc[ai][0][3][1][e]; }
            if (fr == 0 || fr == 15) { PG8_LAS float* dst = ex + (g * 2 + (fr == 0 ? 0 : 1)) * 128 + cl; *(PG8_LAS f32x4*)dst = e0; *(PG8_LAS f32x4*)(dst + 4) = e1; } }
        asm volatile("s_waitcnt lgkmcnt(0)" ::: "memory"); __builtin_amdgcn_s_barrier(); asm volatile("" ::: "memory");
        const int c0 = u.pn * 128 + cl;
        f32x4 w0[2], w1[2], w2[2], bb[2];
#pragma unroll
        for (int n = 0; n < 2; ++n) { w0[n] = *(const PG8_LAS f32x4*)(P + cl + 4 * n); w1[n] = *(const PG8_LAS f32x4*)(P + 128 + cl + 4 * n); w2[n] = *(const PG8_LAS f32x4*)(P + 256 + cl + 4 * n); bb[n] = *(const PG8_LAS f32x4*)(P + 384 + cl + 4 * n); }
        const int rbase = 254 * u.pm - 1;
#pragma unroll
        for (int ai = 0; ai < 2; ++ai) { const int g = 2 * ai + wr;
            f32x4 pb[2], nb[2];
#pragma unroll
            for (int n = 0; n < 2; ++n) { pb[n] = g > 0 ? *(const PG8_LAS f32x4*)(ex + ((g - 1) * 2 + 1) * 128 + cl + 4 * n) : (f32x4){0.f, 0.f, 0.f, 0.f};
                                          nb[n] = g < 3 ? *(const PG8_LAS f32x4*)(ex + ((g + 1) * 2 + 0) * 128 + cl + 4 * n) : (f32x4){0.f, 0.f, 0.f, 0.f}; }
            float fmk[4], lmk[4]; unsigned owp[4][4];
#pragma unroll
            for (int m = 0; m < 4; ++m) { const int R = rbase + 64 * g + 16 * m + fr, tq = R < 16384 ? (R & 4095) : ((R - 16384) & 255);
                fmk[m] = tq == 0 ? 0.f : 1.f; lmk[m] = (R < 16384 ? tq == 4095 : tq == 255) ? 0.f : 1.f; }
#pragma unroll
            for (int n = 0; n < 2; ++n) {
                f32x4 pv[4], nv[4];
#pragma unroll
                for (int e = 0; e < 4; ++e) { float rr[4], rl[4];
#pragma unroll
                    for (int m = 0; m < 4; ++m) { rr[m] = dpp_ror1(acc[ai][0][m][n][e]); rl[m] = dpp_ror15(acc[ai][0][m][n][e]); }
#pragma unroll
                    for (int m = 0; m < 4; ++m) { pv[m][e] = fr == 0 ? (m > 0 ? rr[m > 0 ? m - 1 : 0] : pb[n][e]) : rr[m]; nv[m][e] = fr == 15 ? (m < 3 ? rl[m < 3 ? m + 1 : 3] : nb[n][e]) : rl[m]; } }
#pragma unroll
                for (int m = 0; m < 4; ++m) {
                    const f32x4 gc = bb[n] + (w0[n] * fmk[m]) * pv[m] + w1[n] * acc[ai][0][m][n] + (w2[n] * lmk[m]) * nv[m];
                    f32x4 a;
#pragma unroll
                    for (int e = 0; e < 4; ++e) a[e] = gc[e] * __builtin_amdgcn_rcpf(1.0f + __builtin_amdgcn_exp2f(-1.4426950408889634f * gc[e])) * acc[ai][1][m][n][e];
                    owp[m][2 * n] = cvt_pk_bf16(a[0], a[1]); owp[m][2 * n + 1] = cvt_pk_bf16(a[2], a[3]); } }
#pragma unroll
            for (int m = 0; m < 4; ++m) { const int rho = 64 * g + 16 * m + fr, R = rbase + rho;
                if (rho >= 1 && rho <= 254 && R < nrows) *(u32x4*)(O + (size_t)R * ldc + c0) = (u32x4){owp[m][0], owp[m][1], owp[m][2], owp[m][3]}; }
        }
    }
    __device__ __forceinline__ void operator()(const f32x4 (&acc)[2][2][4][2], const Unit& u, int wr, int wc, int fr, int fq, int slot, PG8_LAS unsigned char* lds) const {
        const PG8_LAS float* P = (const PG8_LAS float*)(lds + 131072 + 4096 + 2048 * slot);
        if (act) { act_epilogue(acc, u, wr, wc, fr, fq, P); return; }
        const int row0 = u.pm * BM + wr * 64 + fr; const int col0 = u.pn * BM + wc * 32 + 8 * fq;
        f32x4 bv[2][2];
#pragma unroll
        for (int bj = 0; bj < 2; ++bj)
#pragma unroll
            for (int n = 0; n < 2; ++n) bv[bj][n] = (bias && u.split <= 0) ? *(const PG8_LAS f32x4*)(P + wc * 32 + 8 * fq + bj * HALF + 4 * n) : (f32x4){0.f, 0.f, 0.f, 0.f};
        const bool pub = sig != nullptr && u.pn == 4 && u.split < 0;
        float* sb = slab + ((size_t)(u.split < 0 ? 0 : u.split) * 1024 + (row0 - 64 * BM)) * 1024 + col0;
#pragma unroll
        for (int ai = 0; ai < 2; ++ai)
#pragma unroll
            for (int m = 0; m < 4; ++m) {
                const f32x4 v00 = acc[ai][0][m][0] + bv[0][0], v01 = acc[ai][0][m][1] + bv[0][1], v10 = acc[ai][1][m][0] + bv[1][0], v11 = acc[ai][1][m][1] + bv[1][1];
                if (u.split < 0) { bf16_t* rowp = O + (size_t)(row0 + ai * HALF + m * 16) * ldc + col0;
                    u32x4 w; w.x = cvt_pk_bf16(v00[0], v00[1]); w.y = cvt_pk_bf16(v00[2], v00[3]); w.z = cvt_pk_bf16(v01[0], v01[1]); w.w = cvt_pk_bf16(v01[2], v01[3]);
                    u32x4 w2; w2.x = cvt_pk_bf16(v10[0], v10[1]); w2.y = cvt_pk_bf16(v10[2], v10[3]); w2.z = cvt_pk_bf16(v11[0], v11[1]); w2.w = cvt_pk_bf16(v11[2], v11[3]);
                    if (pub) {
                        typedef __attribute__((address_space(1))) unsigned long long pg8_gu64;
                        pg8_gu64* q0 = (pg8_gu64*)rowp; pg8_gu64* q1 = (pg8_gu64*)(rowp + HALF);
                        __hip_atomic_store(q0, ((unsigned long long)w.y << 32) | w.x, __ATOMIC_RELAXED, __HIP_MEMORY_SCOPE_AGENT); __hip_atomic_store(q0 + 1, ((unsigned long long)w.w << 32) | w.z, __ATOMIC_RELAXED, __HIP_MEMORY_SCOPE_AGENT);
                        __hip_atomic_store(q1, ((unsigned long long)w2.y << 32) | w2.x, __ATOMIC_RELAXED, __HIP_MEMORY_SCOPE_AGENT); __hip_atomic_store(q1 + 1, ((unsigned long long)w2.w << 32) | w2.z, __ATOMIC_RELAXED, __HIP_MEMORY_SCOPE_AGENT);
                    } else { *(u32x4*)rowp = w; *(u32x4*)(rowp + HALF) = w2; }
                } else { float* rowp = sb + (size_t)(ai * HALF + m * 16) * 1024;
                    *(f32x4*)rowp = v00; *(f32x4*)(rowp + 4) = v01; *(f32x4*)(rowp + HALF) = v10; *(f32x4*)(rowp + HALF + 4) = v11; }
                asm volatile("" ::: "memory");
            }
        if (pub) {
            asm volatile("s_waitcnt vmcnt(0)" ::: "memory");
            __builtin_amdgcn_s_barrier(); asm volatile("" ::: "memory");
            if (wr == 0 && wc == 0 && fr == 0 && fq == 0) __hip_atomic_fetch_add((__attribute__((address_space(1))) unsigned*)sig, 1u, __ATOMIC_RELAXED, __HIP_MEMORY_SCOPE_AGENT);
        }
    }
};

struct Order2 {
    int nM, nN, G, c, ntK, mode, SK, split_first, kfirst;
    __host__ __device__ __forceinline__ void init(int M, int N, int G_, int c_, int K_, int SK_, int split_first_ = 0, int kfirst_ = 0) { mode = SK_ > 0 || split_first_; SK = SK_; split_first = split_first_; kfirst = kfirst_; nM = mode ? 64 : M / BM; nN = N / BM; G = G_; c = c_; ntK = K_ / BK; }
    __host__ __device__ __forceinline__ bool next(int i, Unit& u) const {
        const int L = i * G + c, nwg = nM * nN, ns = 16 * SK;
        int pm = 0, pn = 0, kt0 = 0, nt = ntK, split = -1; bool ok = true;
        int Lt = -1, xs = -1;
        if (mode && split_first) { if (i == 0) { if (c < ns) xs = c; else Lt = c; } else if (i == 1 && c < ns) Lt = c; else ok = false; }
        else if (L < nwg) Lt = L;
        else if (mode && L - nwg < ns) xs = L - nwg;
        else ok = false;
        if (Lt >= 0 && kfirst && Lt < nM) { pm = Lt; pn = 4; }
        else if (Lt >= 0) {
            const int nNe = kfirst ? nN - 1 : nN, nwge = nM * nNe;
            int wgid = kfirst ? Lt - nM : Lt; { const int q = nwge / NXCD, r = nwge % NXCD, xcd = wgid % NXCD, off = wgid / NXCD; wgid = (xcd < r ? xcd * (q + 1) : r * (q + 1) + (xcd - r) * q) + off; }
            const int nig = WGM * nNe, gid = wgid / nig, fm = gid * WGM, gsz = (nM - fm) < WGM ? (nM - fm) : WGM;
            pm = fm + ((wgid % nig) % gsz); pn = (wgid % nig) / gsz; if (kfirst && pn >= 4) ++pn;
        } else if (xs >= 0) {
            const int tile = xs / SK, sp = xs % SK, pairs = ntK / 2, q = pairs / SK, r = pairs % SK;
            pm = 64 + (tile >> 2); pn = tile & 3; split = sp;
            if (sp < r) { kt0 = 2 * sp * (q + 1); nt = 2 * (q + 1); } else { kt0 = 2 * (r * (q + 1) + (sp - r) * q); nt = 2 * q; }
        }
#if defined(__HIP_DEVICE_COMPILE__)
        u.pm = __builtin_amdgcn_readfirstlane(pm); u.pn = __builtin_amdgcn_readfirstlane(pn); u.kt0 = __builtin_amdgcn_readfirstlane(kt0); u.nt = __builtin_amdgcn_readfirstlane(nt); u.split = __builtin_amdgcn_readfirstlane(split);
        return __builtin_amdgcn_readfirstlane((int)ok) != 0;
#else
        u.pm = pm; u.pn = pn; u.kt0 = kt0; u.nt = nt; u.split = split;
        return ok;
#endif
    }
    __device__ __forceinline__ void a_ready(const Unit&) const {}
    __device__ __forceinline__ void done(const Unit&) const {}
};

template <class Epi, class Sched, bool ALIGN_EPI = false, bool SP2 = false>
__device__ __forceinline__ void gemm_phase(PG8_LAS unsigned char* lds, const Gemm g, const Sched& S, const Epi& E, const int wid) {
    const int lane = fresh_lane(), tid = wid * 64 + lane, wr = wid >> 2, wc = wid & 3, fr = lane & 15, fq = lane >> 4;
    const int K = g.K;
    unsigned voffA[2], voffB[2];
#pragma unroll
    for (int i = 0; i < 2; ++i) { int R, C; stage_rc(tid * 16 + i * 8192, R, C); const int Rb = Epi::PERM ? ((R & ~31) + perm32(R & 31)) : R;
        voffA[i] = (unsigned)(R * g.lda + C) * 2u; voffB[i] = (unsigned)(Rb * K + C) * 2u; }
    const size_t kstep = (size_t)(BK * 2);
    const size_t hstepA = (size_t)HALF * g.lda * 2, hstepB = (size_t)HALF * K * 2;
    const size_t tstepA = (size_t)g.rowstep * g.lda * 2, tstepB = 2 * hstepB;
    const unsigned ldsw = (unsigned)wid * 1024u;
    const int aoff = lds_byte(wr * 64 + fr, fq * 8), boff = lds_byte(wc * 32 + fr, fq * 8);
#define PG8_SA(b, h) (((b) * 2 + (h)) * HTB)
#define PG8_SB(b, h) ((4 + (b) * 2 + (h)) * HTB)
#define PG8_STAGE(bufoff, gbase, voff) do { _Pragma("unroll") for (int _i = 0; _i < 2; ++_i) \
        __builtin_amdgcn_global_load_lds((const unsigned*)((const char*)(gbase) + (voff)[_i]), (PG8_LAS unsigned*)(lds + (bufoff) + ldsw + _i * 8192), 16, 0, 0); } while (0)
#define PG8_LDA(dst, b, h) do { _Pragma("unroll") for (int m = 0; m < 4; ++m) _Pragma("unroll") for (int k = 0; k < 2; ++k) dst[m][k] = *(const PG8_LAS bf16x8*)(lds + PG8_SA(b, h) + aoff + m * 2048 + k * 1024); } while (0)
#define PG8_LDB(dst, b, h) do { _Pragma("unroll") for (int n = 0; n < 2; ++n) _Pragma("unroll") for (int k = 0; k < 2; ++k) dst[n][k] = *(const PG8_LAS bf16x8*)(lds + PG8_SB(b, h) + boff + n * 2048 + k * 1024); } while (0)
#define PG8_MMA(ai, bj, At, Bt) do { __builtin_amdgcn_s_setprio(1); _Pragma("unroll") for (int m = 0; m < 4; ++m) _Pragma("unroll") for (int n = 0; n < 2; ++n) _Pragma("unroll") for (int k = 0; k < 2; ++k) \
        acc[ai][bj][m][n] = __builtin_amdgcn_mfma_f32_16x16x32_bf16(Bt[n][k], At[m][k], acc[ai][bj][m][n], 0, 0, 0); __builtin_amdgcn_s_setprio(0); } while (0)
#define PG8_WAIT_V(n) asm volatile("s_waitcnt vmcnt(" #n ")" ::: "memory")
#define PG8_WAIT_L(n) asm volatile("s_waitcnt lgkmcnt(" #n ")" ::: "memory")
#define PG8_BAR __builtin_amdgcn_s_barrier()
#define PG8_SCHED __builtin_amdgcn_sched_barrier(0)
    Unit cur, nxt; int ui = 0;
    if (!S.next(0, cur)) return;
    f32x4 acc[2][2][4][2];
#pragma unroll
    for (int a = 0; a < 2; ++a)
#pragma unroll
        for (int b = 0; b < 2; ++b)
#pragma unroll
            for (int m = 0; m < 4; ++m)
#pragma unroll
                for (int n = 0; n < 2; ++n) acc[a][b][m][n] = (f32x4){0.f, 0.f, 0.f, 0.f};
    bf16x8 At[4][2], B0[2][2], B1[2][2];
    const char* cA = (const char*)g.A + (size_t)cur.pm * tstepA + (size_t)cur.kt0 * kstep; const char* cB = (const char*)g.Bt + (size_t)cur.pn * tstepB + (size_t)cur.kt0 * kstep;
    S.a_ready(cur);
    E.prefetch(cur, 0, wid, lds);
    if constexpr (SP2) {
        PG8_STAGE(PG8_SB(0, 0), cB, voffB); PG8_STAGE(PG8_SB(0, 1), cB + hstepB, voffB); PG8_STAGE(PG8_SA(0, 0), cA, voffA); PG8_STAGE(PG8_SA(0, 1), cA + hstepA, voffA);
        if (wr == 1) PG8_BAR;
        PG8_WAIT_V(2); PG8_BAR;
        PG8_STAGE(PG8_SB(1, 0), cB + kstep, voffB); PG8_STAGE(PG8_SA(1, 0), cA + kstep, voffA); PG8_STAGE(PG8_SB(1, 1), cB + hstepB + kstep, voffB);
        PG8_WAIT_V(6); PG8_BAR;
    } else {
        PG8_STAGE(PG8_SB(0, 0), cB, voffB); PG8_STAGE(PG8_SA(0, 0), cA, voffA); PG8_STAGE(PG8_SB(0, 1), cB + hstepB, voffB); PG8_STAGE(PG8_SA(0, 1), cA + hstepA, voffA);
        if (wr == 1) PG8_BAR;
        PG8_WAIT_V(4); PG8_BAR;
        PG8_STAGE(PG8_SB(1, 0), cB + kstep, voffB); PG8_STAGE(PG8_SA(1, 0), cA + kstep, voffA); PG8_STAGE(PG8_SB(1, 1), cB + hstepB + kstep, voffB);
        PG8_WAIT_V(6); PG8_BAR;
    }
    for (;;) {
        const bool has_next = S.next(ui + 1, nxt);
        if (has_next) E.prefetch(nxt, (ui + 1) % 3, wid, lds);
        const char* nA = has_next ? (const char*)g.A + (size_t)nxt.pm * tstepA + (size_t)nxt.kt0 * kstep : cA; const char* nB = has_next ? (const char*)g.Bt + (size_t)nxt.pn * tstepB + (size_t)nxt.kt0 * kstep : cB;
        const int nt = cur.nt;
        for (int t = 0; t < nt; t += 2) {
            const bool last = (t == nt - 2);
            const char* a1 = cA + (size_t)(t + 1) * kstep;
            const char* a2 = last ? nA : cA + (size_t)(t + 2) * kstep; const char* b2 = last ? nB : cB + (size_t)(t + 2) * kstep;
            const char* a3 = a2 + kstep; const char* b3 = b2 + kstep;
            if (last && has_next) S.a_ready(nxt);
            if constexpr (SP2) {
            PG8_LDB(B0, 0, 0); PG8_LDB(B1, 0, 1); PG8_SCHED; PG8_LDA(At, 0, 0); PG8_STAGE(PG8_SA(1, 1), a1 + hstepA, voffA);
            PG8_WAIT_V(8); PG8_WAIT_L(0); PG8_BAR; PG8_MMA(0, 0, At, B0); PG8_MMA(0, 1, At, B1); PG8_BAR; PG8_SCHED;
            PG8_LDA(At, 0, 1); PG8_STAGE(PG8_SB(0, 0), b2, voffB); PG8_STAGE(PG8_SB(0, 1), b2 + hstepB, voffB); PG8_STAGE(PG8_SA(0, 0), a2, voffA);
            PG8_WAIT_V(8); PG8_WAIT_L(0); PG8_BAR; PG8_MMA(1, 0, At, B0); PG8_MMA(1, 1, At, B1); PG8_BAR; PG8_SCHED;
            PG8_LDB(B0, 1, 0); PG8_LDB(B1, 1, 1); PG8_SCHED; PG8_LDA(At, 1, 0); PG8_STAGE(PG8_SA(0, 1), a2 + hstepA, voffA);
            PG8_WAIT_V(8); PG8_WAIT_L(0); PG8_BAR; PG8_MMA(0, 0, At, B0); PG8_MMA(0, 1, At, B1); PG8_BAR; PG8_SCHED;
            PG8_LDA(At, 1, 1); PG8_STAGE(PG8_SB(1, 0), b3, voffB); PG8_STAGE(PG8_SB(1, 1), b3 + hstepB, voffB); PG8_STAGE(PG8_SA(1, 0), a3, voffA);
            PG8_WAIT_V(8); PG8_WAIT_L(0); PG8_BAR; PG8_MMA(1, 0, At, B0); PG8_MMA(1, 1, At, B1); PG8_BAR; PG8_SCHED;
            } else {
            PG8_LDB(B0, 0, 0); PG8_SCHED; PG8_LDA(At, 0, 0); PG8_STAGE(PG8_SA(1, 1), a1 + hstepA, voffA);
            PG8_WAIT_L(8); PG8_BAR; PG8_WAIT_L(0); PG8_MMA(0, 0, At, B0); PG8_BAR; PG8_SCHED;
            PG8_LDB(B1, 0, 1); PG8_STAGE(PG8_SB(0, 0), b2, voffB);
            PG8_BAR; PG8_WAIT_L(0); PG8_MMA(0, 1, At, B1); PG8_BAR;
            PG8_LDA(At, 0, 1); PG8_STAGE(PG8_SA(0, 0), a2, voffA);
            PG8_BAR; PG8_WAIT_L(0); PG8_MMA(1, 0, At, B0); PG8_BAR; PG8_SCHED;
            PG8_STAGE(PG8_SB(0, 1), b2 + hstepB, voffB);
            PG8_WAIT_V(6); PG8_BAR; PG8_MMA(1, 1, At, B1); PG8_BAR;
            PG8_LDB(B0, 1, 0); PG8_SCHED; PG8_LDA(At, 1, 0); PG8_STAGE(PG8_SA(0, 1), a2 + hstepA, voffA);
            PG8_WAIT_L(8); PG8_BAR; PG8_WAIT_L(0); PG8_MMA(0, 0, At, B0); PG8_BAR; PG8_SCHED;
            PG8_LDB(B1, 1, 1); PG8_STAGE(PG8_SB(1, 0), b3, voffB);
            PG8_BAR; PG8_WAIT_L(0); PG8_MMA(0, 1, At, B1); PG8_BAR;
            PG8_LDA(At, 1, 1); PG8_STAGE(PG8_SA(1, 0), a3, voffA);
            PG8_BAR; PG8_WAIT_L(0); PG8_MMA(1, 0, At, B0); PG8_BAR; PG8_SCHED;
            PG8_STAGE(PG8_SB(1, 1), b3 + hstepB, voffB);
            PG8_WAIT_V(6); PG8_BAR; PG8_MMA(1, 1, At, B1); PG8_BAR;
            }
        }
        if constexpr (ALIGN_EPI) { if (wr == 0) PG8_BAR; }
        if (!(E.fuse && !has_next)) { const int le = fresh_lane(); E(acc, cur, wr, wc, le & 15, le >> 4, ui % 3, lds); S.done(cur); }
        if (!has_next) break;
#pragma unroll
        for (int a = 0; a < 2; ++a)
#pragma unroll
            for (int b = 0; b < 2; ++b)
#pragma unroll
                for (int m = 0; m < 4; ++m)
#pragma unroll
                    for (int n = 0; n < 2; ++n) acc[a][b][m][n] = (f32x4){0.f, 0.f, 0.f, 0.f};
        cur = nxt; cA = nA; cB = nB; ++ui;
        if constexpr (ALIGN_EPI) { if (wr == 1) PG8_BAR; }
    }
    PG8_WAIT_V(0);
    if constexpr (!ALIGN_EPI) { if (wr == 0) PG8_BAR; }
    PG8_BAR;
    if (E.fuse) { const int le = fresh_lane(); E.fused(acc, cur, wr, wc, le & 15, le >> 4, lds, wid, le); S.done(cur); }
#undef PG8_SA
#undef PG8_SB
#undef PG8_STAGE
#undef PG8_LDA
#undef PG8_LDB
#undef PG8_MMA
#undef PG8_WAIT_V
#undef PG8_WAIT_L
#undef PG8_BAR
#undef PG8_SCHED
}
}

constexpr int NWAVES = 8, NTHREADS = 512;
constexpr int DM = 1024, BATCH = 4, SEQ = 4096, CTXL = 256, DEPTH = 4, DFF = 2816, NMOD = 6;
constexpr int MLAT = BATCH * SEQ, MCTX = BATCH * CTXL, MT = MLAT + MCTX;
constexpr int NKEY = CTXL + SEQ;
constexpr int A_HEADS = 8, A_KV = 2, A_DH = 128, A_COLS = (A_HEADS + 2 * A_KV) * A_DH;
constexpr int C_HEADS = 16, C_KV = 2, C_DH = 64, C_COLS = (C_HEADS + 2 * C_KV) * C_DH;
constexpr int WINDOW = 128, GRID_W = 64;
constexpr float EPS = 1e-6f;
constexpr int N_IN = 34;
enum { I_X = 0, I_C, I_CTX, I_CCTX, I_MODW, I_MODB, I_NORMG, I_WUP, I_FCW, I_FCB, I_WDOWN, I_AQKV, I_AQG, I_AKG, I_AOUT,
       I_BIN, I_BBIN, I_BCW, I_BCB, I_FW1, I_FB1, I_FW2, I_FB2, I_FW3, I_FB3, I_FW4, I_BSKIP, I_BOUT, I_BBOUT, I_CQKV, I_CBQKV, I_CSINK, I_COUT, I_CBOUT };

constexpr size_t MiB = 1u << 20;
constexpr size_t WS_CTL = 0, CTL_ZERO_BYTES = 1 * MiB;
constexpr size_t WS_W_AQKV = 1 * MiB, WS_W_AOUT = 7 * MiB, WS_W_BIN = 11 * MiB, WS_W_BOUT = 17 * MiB, WS_W_CQKV = 19 * MiB, WS_W_COUT = 22 * MiB;
constexpr size_t WS_W_UP = 24 * MiB, WS_W_DOWN = 68 * MiB;
constexpr size_t WS_MOD = 90 * MiB, WS_HCLAT = 91 * MiB, WS_HCCTX = 123 * MiB, WS_HCTX = 125 * MiB, WS_U = 130 * MiB, WS_R = 164 * MiB, WS_HB = 351 * MiB, WS_END = 383 * MiB;
constexpr size_t R_QKV = 0, R_QN = 102 * MiB, R_KB = 136 * MiB, R_VB = 145 * MiB, R_VPT = 102 * MiB, R_VPC = 166 * MiB, R_O = 0, R_G = 0;
static_assert(WS_W_AQKV + 2ull * A_COLS * DM * 2 <= WS_W_AOUT && WS_W_CQKV + (size_t)C_COLS * DM * 2 <= WS_W_COUT && WS_W_UP + 4ull * 2 * DFF * DM * 2 <= WS_W_DOWN && WS_W_DOWN + 4ull * DM * DFF * 2 <= WS_MOD, "weights map");
static_assert(WS_HCLAT + (size_t)(2 * SEQ - 1) * DM * 4 <= WS_HCCTX && WS_HCCTX + (size_t)(2 * CTXL - 1) * DM * 4 <= WS_HCTX && WS_U + (size_t)MT * DM * 2 <= WS_R && WS_R + (size_t)MT * 2 * DFF * 2 <= WS_HB && WS_HB + (size_t)MLAT * DM * 2 <= WS_END, "ws map");
static_assert(R_VB + (size_t)BATCH * NKEY * 256 * 2 <= 187 * MiB && R_VPT + (size_t)MLAT * DM * 4 <= R_VPC && R_VPC + (size_t)MCTX * DM * 4 <= 187 * MiB && (size_t)MT * 3 * DM * 2 <= R_QN, "R overlay");
constexpr size_t WS_CSA = WS_MOD + 512 * 1024, WS_CSC = WS_CSA + 64 * 32 * 8;
constexpr size_t WS_W4T = WS_MOD + 640 * 1024;
static_assert(WS_CSC + 64 * 16 * 8 <= WS_W4T && WS_W4T + 2048 * 64 * 2 <= WS_HCLAT, "mod page map");
constexpr size_t R_SLAB = 40 * MiB;
constexpr size_t R_SLAB2 = 100 * MiB;
constexpr int SK_OUT = 8, SK_DOWN = 7;
static_assert(R_SLAB >= (size_t)MLAT * DM * 2 && R_SLAB + (size_t)SK_OUT * MCTX * DM * 4 <= R_QN && R_SLAB2 >= (size_t)MT * DFF * 2 && R_SLAB2 + (size_t)SK_DOWN * MCTX * DM * 4 <= 187 * MiB, "slab map");
constexpr size_t R_XBUF = 100 * MiB;
constexpr int CW_SEAM = 16384;
constexpr int CW_BAR = 4096;

constexpr int LDS_BYTES = 147456;
constexpr int MISC_OFF = LDS_BYTES - 1024;
constexpr int INTAB_OFF = MISC_OFF + 256;

#define GAS __attribute__((address_space(1)))
#define LAS __attribute__((address_space(3)))
typedef unsigned short bf16;
typedef unsigned v4u __attribute__((ext_vector_type(4)));
typedef float f32x4 __attribute__((ext_vector_type(4)));
typedef short bf16x8 __attribute__((ext_vector_type(8)));
typedef GAS unsigned gu32;
typedef GAS unsigned long long gu64;
#define RLX_AGENT __ATOMIC_RELAXED, __HIP_MEMORY_SCOPE_AGENT
#define LDS_WAIT() asm volatile("s_waitcnt lgkmcnt(0)" ::: "memory")
#define VM_WAIT() asm volatile("s_waitcnt vmcnt(0)" ::: "memory")
__device__ __forceinline__ unsigned long long rt() { return __builtin_amdgcn_s_memrealtime(); }
__device__ __forceinline__ unsigned pk2(float lo, float hi) { unsigned r; asm("v_cvt_pk_bf16_f32 %0, %1, %2" : "=v"(r) : "v"(lo), "v"(hi)); return r; }
__device__ __forceinline__ unsigned f2bf(float f) { return pk2(f, 0.f) & 0xffffu; }

#define XB_TMO      128
#define XB_XCNT(j)  (256  + 64 * (j))
#define XB_XSUB(j)  (1280 + 64 * (j))
#define XB_XGEN(j)  (2304 + 64 * (j))
#define XB_TOP      3328
#define XB_TOPGEN   3392
#define XCD_BAR_WORDS 3456
#define XB_SPIN_CAP (1u << 18)

__device__ __forceinline__ unsigned xb_ld(unsigned* p)              { return __hip_atomic_load(p, __ATOMIC_RELAXED, __HIP_MEMORY_SCOPE_AGENT); }
__device__ __forceinline__ unsigned xb_add(unsigned* p, unsigned v) { return __hip_atomic_fetch_add(p, v, __ATOMIC_RELAXED, __HIP_MEMORY_SCOPE_AGENT); }
__device__ __forceinline__ unsigned xb_xcc_id() { return (unsigned)__builtin_amdgcn_s_getreg((3 << 11) | 20) & 0xFu; }
#define XB_SPIN(cond, bar) do { unsigned _sp = 0; while (cond) { __builtin_amdgcn_s_sleep(1); \
    if ((++_sp & 255u) == 0u) { if (xb_ld(&(bar)[XB_TMO])) break; if (_sp > XB_SPIN_CAP) { atomicAdd(&(bar)[XB_TMO], 1u); break; } } } } while (0)

struct XcdBarrier {
    unsigned* bar; unsigned x;
    volatile LAS unsigned* st;
};

__device__ __forceinline__ XcdBarrier xcd_barrier_post(unsigned* bar, volatile LAS unsigned* st, int tid) {
    XcdBarrier b; b.bar = bar; b.x = xb_xcc_id(); b.st = st;
    if (tid == 0) (void)xb_add(&bar[XB_XCNT(b.x)], 1u);
    return b;
}
__device__ __forceinline__ void xcd_barrier_complete(unsigned* bar, unsigned x, unsigned& nloc, unsigned& nx) {
    const unsigned G = gridDim.x * gridDim.y * gridDim.z;
    unsigned sum, cnt, mine, sp = 0u;
    for (;;) {
        sum = 0u; cnt = 0u; mine = 0u;
#pragma unroll
        for (unsigned j = 0; j < 16; ++j) { const unsigned c = xb_ld(&bar[XB_XCNT(j)]); sum += c; cnt += (c > 0u) ? 1u : 0u; mine = (j == x) ? c : mine; }
        if (sum == G) break;
        __builtin_amdgcn_s_sleep(1);
        if ((++sp & 255u) == 0u) { if (xb_ld(&bar[XB_TMO])) break; if (sp > XB_SPIN_CAP) { atomicAdd(&bar[XB_TMO], 1u); break; } }
    }
    nloc = mine > 0u ? mine : 1u; nx = cnt > 0u ? cnt : 1u;
}

__device__ __forceinline__ void xcd_barrier(const XcdBarrier& b, int tid) {
    asm volatile("s_waitcnt vmcnt(0)" ::: "memory");
    __syncthreads();
    if (tid == 0) {
        unsigned* bar = b.bar;
        __builtin_amdgcn_s_waitcnt(0);
        unsigned nloc = b.st[0], nx = b.st[1];
        if (nloc == 0u) { xcd_barrier_complete(bar, b.x, nloc, nx); b.st[0] = nloc; b.st[1] = nx; }
        const unsigned old = xb_add(&bar[XB_XSUB(b.x)], 1u);
        const unsigned gen = old / nloc;
        if (old + 1u == (gen + 1u) * nloc) {
            __builtin_amdgcn_fence(__ATOMIC_RELEASE, "agent");
            asm volatile("s_waitcnt vmcnt(0)" ::: "memory");
            const unsigned og = xb_add(&bar[XB_TOP], 1u);
            const unsigned tg = og / nx;
            if (og + 1u == (tg + 1u) * nx) xb_add(&bar[XB_TOPGEN], 1u);
            else XB_SPIN(xb_ld(&bar[XB_TOPGEN]) == tg, bar);
            __builtin_amdgcn_fence(__ATOMIC_ACQUIRE, "agent");
            asm volatile("s_waitcnt vmcnt(0)" ::: "memory");
        } else {
            XB_SPIN(xb_ld(&bar[XB_TOPGEN]) == gen, bar);
            __builtin_amdgcn_fence(__ATOMIC_ACQUIRE, "agent");
            asm volatile("s_waitcnt vmcnt(0)" ::: "memory");
        }
    }
    __syncthreads();
}
namespace aa {
typedef unsigned short bf16;
constexpr int D = 128, NW = 8, QBLK = 32, KVBLK = 64, SDEPTH = 1;
constexpr float SCALE = 0.088388347648318440f, THR = 8.f;
constexpr int LDQ = 1536, LDK = 256, LDV = 1536, LDO = 1024;
constexpr size_t SHM_V = KVBLK * D * 2, SHM_K = KVBLK * D * 2, SHM_ATTN = 2 * SHM_V + 2 * SHM_K + NW * 64 * 4;
using bf16x8 = __attribute__((ext_vector_type(8))) short;
using s16x4  = __attribute__((ext_vector_type(4))) short;
using f32x16 = __attribute__((ext_vector_type(16))) float;
using f32x8  = __attribute__((ext_vector_type(8))) float;
using u32x4  = __attribute__((ext_vector_type(4))) unsigned;
#define KSWZ(row, colB) ((row) * 256 + ((colB) ^ (((row) & 7) << 4)))
#define SBAR() __builtin_amdgcn_sched_barrier(0)
__device__ __forceinline__ int crow(int r, int hi) { return (r & 3) + 8 * (r >> 2) + 4 * hi; }
__device__ __forceinline__ unsigned cvtpk(float lo, float hi) {
  unsigned r; asm volatile("v_cvt_pk_bf16_f32 %0, %1, %2" : "=v"(r) : "v"(lo), "v"(hi)); return r;
}
struct St { using T = bf16x8; __device__ static __forceinline__ T ld8(const bf16* p) { return *reinterpret_cast<const bf16x8*>(p); } __device__ static __forceinline__ bf16x8 tobf(T x) { return x; } };
__device__ __forceinline__ void partialSM(f32x16& p0, f32x16& p1, float& m_reg, float& mn, float& alpha) {
  constexpr float C = SCALE * 1.4426950408889634f;
  float pmax = p0[0]; for (int r = 1; r < 16; ++r) pmax = fmaxf(pmax, p0[r]); for (int r = 0; r < 16; ++r) pmax = fmaxf(pmax, p1[r]);
  { auto rr = __builtin_amdgcn_permlane32_swap(__float_as_uint(pmax), __float_as_uint(pmax), false, false);
    pmax = fmaxf(__uint_as_float(rr[0]), __uint_as_float(rr[1])); }
  if (__builtin_expect(__all(pmax - m_reg <= THR / SCALE), 1)) { mn = m_reg; alpha = 1.f; }
  else { mn = fmaxf(m_reg, pmax); alpha = __builtin_amdgcn_exp2f((m_reg - mn) * C); m_reg = mn; }
  float mnC = -mn * C;
  for (int r = 0; r < 16; ++r) p0[r] = fmaf(p0[r], C, mnC); for (int r = 0; r < 16; ++r) p1[r] = fmaf(p1[r], C, mnC);
  for (int r = 0; r < 16; ++r) p0[r] = __builtin_amdgcn_exp2f(p0[r]);
}
__device__ __forceinline__ void finishSM(f32x16& p0, f32x16& p1, float alpha, float& l_reg, bf16x8& pa0, bf16x8& pa1, bf16x8& pa2, bf16x8& pa3) {
  for (int r = 0; r < 16; ++r) p1[r] = __builtin_amdgcn_exp2f(p1[r]);
  float ps = 0; for (int r = 0; r < 16; ++r) ps += p0[r]; for (int r = 0; r < 16; ++r) ps += p1[r];
  { auto rr = __builtin_amdgcn_permlane32_swap(__float_as_uint(ps), __float_as_uint(ps), false, false);
    ps = __uint_as_float(rr[0]) + __uint_as_float(rr[1]); }
  l_reg = l_reg * alpha + ps;
#define PK4(P, BASE, OUT) do { unsigned a0 = cvtpk(P[BASE + 0], P[BASE + 1]), a1 = cvtpk(P[BASE + 2], P[BASE + 3]);   \
    unsigned b0 = cvtpk(P[BASE + 4], P[BASE + 5]), b1 = cvtpk(P[BASE + 6], P[BASE + 7]);                              \
    auto r0 = __builtin_amdgcn_permlane32_swap(a0, b0, false, false); auto r1 = __builtin_amdgcn_permlane32_swap(a1, b1, false, false); \
    u32x4 w = {r0[0], r1[0], r0[1], r1[1]}; OUT = *reinterpret_cast<bf16x8*>(&w); } while (0)
  PK4(p0, 0, pa0); PK4(p0, 8, pa1); PK4(p1, 0, pa2); PK4(p1, 8, pa3);
#undef PK4
}
__device__ __forceinline__ void qkt(f32x16& p0, f32x16& p1, const bf16* Ks, const bf16x8* qr, int r32, int hi) {
  p0 = f32x16{}; p1 = f32x16{};
  for (int d0 = 0; d0 < 8; ++d0) { int cb = (d0 * 16 + hi * 8) * 2;
    bf16x8 b0 = *reinterpret_cast<const bf16x8*>((const char*)Ks + KSWZ(r32, cb));
    bf16x8 b1 = *reinterpret_cast<const bf16x8*>((const char*)Ks + KSWZ(32 + r32, cb));
    p0 = __builtin_amdgcn_mfma_f32_32x32x16_bf16(b0, qr[d0], p0, 0, 0, 0);
    p1 = __builtin_amdgcn_mfma_f32_32x32x16_bf16(b1, qr[d0], p1, 0, 0, 0); }
}
__device__ __forceinline__ int v_st(int k, int c) { const int kk = (k & ~0xC) | ((k & 4) << 1) | ((k & 8) >> 1); return ((kk >> 3) * 4 + (c >> 5)) * 512 + ((kk & 7) * 32 + (c & 31)) * 2; }
__device__ __forceinline__ int v_rd_base(int lane) { return ((lane & 3) << 3) | (((lane >> 2) & 3) << 6) | (((lane >> 4) & 1) << 5) | (((lane >> 5) & 1) << 8); }
constexpr int v_rd_off(int d0, int ks, int half) { return d0 * 512 + ks * 4096 + half * 2048; }
template <int OFF> __device__ __forceinline__ s16x4 tr_read(int vb) {
  s16x4 r; asm volatile("ds_read_b64_tr_b16 %0, %1 offset:%2" : "=&v"(r) : "v"(vb), "i"(OFF) : "memory"); return r;
}
template <int D0> __device__ __forceinline__ void pv_one(f32x16& od, int vb, bf16x8 pa0, bf16x8 pa1, bf16x8 pa2, bf16x8 pa3) {
  const s16x4 l0 = tr_read<v_rd_off(D0, 0, 0)>(vb), h0 = tr_read<v_rd_off(D0, 0, 1)>(vb), l1 = tr_read<v_rd_off(D0, 1, 0)>(vb), h1 = tr_read<v_rd_off(D0, 1, 1)>(vb);
  const s16x4 l2 = tr_read<v_rd_off(D0, 2, 0)>(vb), h2 = tr_read<v_rd_off(D0, 2, 1)>(vb), l3 = tr_read<v_rd_off(D0, 3, 0)>(vb), h3 = tr_read<v_rd_off(D0, 3, 1)>(vb);
  asm volatile("s_waitcnt lgkmcnt(0)" ::: "memory"); SBAR();
#define PK(L, H) (bf16x8){L[0], L[1], L[2], L[3], H[0], H[1], H[2], H[3]}
  od = __builtin_amdgcn_mfma_f32_32x32x16_bf16(pa0, PK(l0, h0), od, 0, 0, 0);
  od = __builtin_amdgcn_mfma_f32_32x32x16_bf16(pa1, PK(l1, h1), od, 0, 0, 0);
  od = __builtin_amdgcn_mfma_f32_32x32x16_bf16(pa2, PK(l2, h2), od, 0, 0, 0);
  od = __builtin_amdgcn_mfma_f32_32x32x16_bf16(pa3, PK(l3, h3), od, 0, 0, 0);
#undef PK
}
__device__ __forceinline__ void pv_d0(f32x16* o, int vb, bf16x8 pa0, bf16x8 pa1, bf16x8 pa2, bf16x8 pa3) {
  pv_one<0>(o[0], vb, pa0, pa1, pa2, pa3); pv_one<1>(o[1], vb, pa0, pa1, pa2, pa3); pv_one<2>(o[2], vb, pa0, pa1, pa2, pa3); pv_one<3>(o[3], vb, pa0, pa1, pa2, pa3);
}

__device__ __forceinline__ void attn_dense_body(const bf16* __restrict__ Qb, const bf16* __restrict__ Kh, const bf16* __restrict__ Vb, int rc, int rl, bf16* __restrict__ Ob, int seq, char* lds, const int tid,
                                                const float* __restrict__ qgain, const float* __restrict__ cs, int t_first) {
  using SQ = St;
  const int wid = __builtin_amdgcn_readfirstlane(tid >> 6), lane = tid & 63, r32 = lane & 31, hi = lane >> 5;
  bf16* V_lds = (bf16*)lds; bf16* K_lds = (bf16*)(lds + 2 * SHM_V);
  float* ws = (float*)(lds + 2 * SHM_V + 2 * SHM_K) + wid * 64; float* li_l = ws; float* al_l = ws + 32;
  float m_reg = -1e30f, l_reg = 0; f32x16 o[4] = {}; bf16x8 qr[8];
  const bf16* Qw = Qb + (long)(wid * QBLK + r32) * LDQ + hi * 8;
#pragma unroll
  for (int d0 = 0; d0 < 8; ++d0) qr[d0] = SQ::tobf(SQ::ld8(Qw + d0 * 16));
  {
    float xf[8][8]; float ss = 0.f;
#pragma unroll
    for (int d0 = 0; d0 < 8; ++d0)
#pragma unroll
      for (int j = 0; j < 8; ++j) { xf[d0][j] = __uint_as_float(((unsigned)(unsigned short)qr[d0][j]) << 16); ss += xf[d0][j] * xf[d0][j]; }
    { auto rr = __builtin_amdgcn_permlane32_swap(__float_as_uint(ss), __float_as_uint(ss), false, false); ss = __uint_as_float(rr[0]) + __uint_as_float(rr[1]); }
    const float rs = __builtin_amdgcn_rsqf(ss * (1.0f / 128.0f) + 1e-6f);
#pragma unroll
    for (int d0 = 0; d0 < 8; ++d0) { const float4 g0 = *(const float4*)(qgain + d0 * 16 + hi * 8), g1 = *(const float4*)(qgain + d0 * 16 + hi * 8 + 4);
      xf[d0][0] *= rs * g0.x; xf[d0][1] *= rs * g0.y; xf[d0][2] *= rs * g0.z; xf[d0][3] *= rs * g0.w; xf[d0][4] *= rs * g1.x; xf[d0][5] *= rs * g1.y; xf[d0][6] *= rs * g1.z; xf[d0][7] *= rs * g1.w; }
    if (cs) { const int t = t_first + wid * QBLK + r32, prow = t >> 6, pcol = t & 63;
#pragma unroll
      for (int d0 = 0; d0 < 4; ++d0) { const float* c8 = cs + ((d0 < 2 ? prow : pcol) * 32 + ((d0 & 1) * 16 + hi * 8)) * 2;
#pragma unroll
        for (int j4 = 0; j4 < 4; ++j4) { const float4 v = *(const float4*)(c8 + 4 * j4);
          { const float y1 = xf[d0][2 * j4], y2 = xf[d0 + 4][2 * j4]; xf[d0][2 * j4] = y1 * v.x - y2 * v.y; xf[d0 + 4][2 * j4] = y1 * v.y + y2 * v.x; }
          { const float y1 = xf[d0][2 * j4 + 1], y2 = xf[d0 + 4][2 * j4 + 1]; xf[d0][2 * j4 + 1] = y1 * v.z - y2 * v.w; xf[d0 + 4][2 * j4 + 1] = y1 * v.w + y2 * v.z; } } } }
#pragma unroll
    for (int d0 = 0; d0 < 8; ++d0) { u32x4 w = {cvtpk(xf[d0][0], xf[d0][1]), cvtpk(xf[d0][2], xf[d0][3]), cvtpk(xf[d0][4], xf[d0][5]), cvtpk(xf[d0][6], xf[d0][7])}; qr[d0] = *reinterpret_cast<bf16x8*>(&w); }
  }
  const int sr = tid >> 4, sc = (tid & 15) * 8, vst0 = v_st(sr, sc), vst1 = v_st(32 + sr, sc);
  const unsigned vthr = (unsigned)(sr * LDV + sc), kthr = (unsigned)(sr * LDK + sc);
  const int vb0 = (int)(uintptr_t)V_lds + v_rd_base(lane);
  struct { typename St::T vs0, vs1, ks0, ks1; } sr_[SDEPTH];
#define SLOAD(i, k0) do { const unsigned vro_ = (unsigned)((k0) < 256 ? rc + (k0) : rl + (k0) - 256) * LDV + vthr; sr_[i].vs0 = St::ld8(Vb + vro_); sr_[i].vs1 = St::ld8(Vb + (vro_ + 32u * LDV)); \
    const unsigned kro_ = (unsigned)(k0) * LDK + kthr; sr_[i].ks0 = St::ld8(Kh + kro_); sr_[i].ks1 = St::ld8(Kh + (kro_ + 32u * LDK)); } while (0)
#define SWRITE(b, i) do { *(bf16x8*)((char*)V_lds + (b) * SHM_V + vst0) = St::tobf(sr_[i].vs0);          \
    *(bf16x8*)((char*)V_lds + (b) * SHM_V + vst1) = St::tobf(sr_[i].vs1); int kc = sc * 2;               \
    *(bf16x8*)((char*)K_lds + (b) * SHM_K + KSWZ(sr, kc)) = St::tobf(sr_[i].ks0);                       \
    *(bf16x8*)((char*)K_lds + (b) * SHM_K + KSWZ(32 + sr, kc)) = St::tobf(sr_[i].ks1); } while (0)
#define SWAIT() do { if constexpr (SDEPTH == 2) asm volatile("s_waitcnt vmcnt(4)" ::: "memory"); else asm volatile("s_waitcnt vmcnt(0)" ::: "memory"); } while (0)
#define RESC(a) do { if (__any((a) < 1.f)) { if (hi == 0) al_l[r32] = (a); asm volatile("s_waitcnt lgkmcnt(0)" ::: "memory"); \
    for (int d = 0; d < 4; ++d) for (int r = 0; r < 16; ++r) o[d][r] *= al_l[crow(r, hi)]; } } while (0)
  f32x16 pA0, pA1, pB0, pB1; float mnA, mnB, alA, alB; bf16x8 pa0, pa1, pa2, pa3; const int NT = seq / KVBLK;
  constexpr int SE = 0, SO = SDEPTH - 1;
  SLOAD(SE, 0); asm volatile("s_waitcnt vmcnt(0)" ::: "memory"); SWRITE(0, SE); __syncthreads();
  qkt(pA0, pA1, K_lds, qr, r32, hi); partialSM(pA0, pA1, m_reg, mnA, alA);
  SLOAD(SO, KVBLK); if constexpr (SDEPTH == 2) { if (2 < NT) SLOAD(SE, 2 * KVBLK); }
  SWAIT(); SWRITE(1, SO); __syncthreads();
  for (int j = 1; j + 1 < NT; j += 2) {
    SBAR(); qkt(pB0, pB1, (bf16*)((char*)K_lds + SHM_K), qr, r32, hi);
    finishSM(pA0, pA1, alA, l_reg, pa0, pa1, pa2, pa3); SBAR();
    SLOAD(SO, (j + SDEPTH) * KVBLK); SBAR();
    pv_d0(o, vb0, pa0, pa1, pa2, pa3); partialSM(pB0, pB1, m_reg, mnB, alB);
    __syncthreads(); SWAIT(); SWRITE(0, SE);
    RESC(alB); __syncthreads();
    SBAR(); qkt(pA0, pA1, K_lds, qr, r32, hi);
    finishSM(pB0, pB1, alB, l_reg, pa0, pa1, pa2, pa3); SBAR();
    if (SDEPTH == 1 || j + 3 < NT) SLOAD(SE, (j + 1 + SDEPTH) * KVBLK); SBAR();
    pv_d0(o, vb0 + (int)SHM_V, pa0, pa1, pa2, pa3); partialSM(pA0, pA1, m_reg, mnA, alA);
    __syncthreads(); SWAIT(); SWRITE(1, SO);
    RESC(alA); __syncthreads();
  }
  SBAR(); qkt(pB0, pB1, (bf16*)((char*)K_lds + SHM_K), qr, r32, hi);
  finishSM(pA0, pA1, alA, l_reg, pa0, pa1, pa2, pa3); SBAR();
  pv_d0(o, vb0, pa0, pa1, pa2, pa3); partialSM(pB0, pB1, m_reg, mnB, alB);
  __syncthreads(); RESC(alB);
  finishSM(pB0, pB1, alB, l_reg, pa0, pa1, pa2, pa3); SBAR();
  pv_d0(o, vb0 + (int)SHM_V, pa0, pa1, pa2, pa3);
  if (hi == 0) li_l[r32] = l_reg; asm volatile("s_waitcnt lgkmcnt(0)" ::: "memory");
  float rli[16];
#pragma unroll
  for (int r = 0; r < 16; ++r) rli[r] = __builtin_amdgcn_rcpf(li_l[crow(r, hi)]);
  __syncthreads();
  int lane_e = lane; asm volatile("" : "+v"(lane_e));
  bf16* stg = (bf16*)lds + wid * (QBLK * D);
#pragma unroll
  for (int r = 0; r < 16; ++r) { const int orow = crow(r, hi);
#pragma unroll
    for (int d0 = 0; d0 < 4; ++d0) stg[orow * D + d0 * 32 + r32] = (bf16)(cvtpk(o[d0][r] * rli[r], 0.f) & 0xffffu); }
  asm volatile("s_waitcnt lgkmcnt(0)" ::: "memory");
  bf16* Ow = Ob + (long)(wid * QBLK) * LDO;
#pragma unroll
  for (int i = 0; i < 8; ++i) { const int row = i * 4 + (lane_e >> 4), ch = lane_e & 15; const u32x4 v = *(const u32x4*)(stg + row * D + ch * 8); *(u32x4*)(Ow + (long)row * LDO + ch * 8) = v; }
  __syncthreads();
#undef SLOAD
#undef SWRITE
#undef SWAIT
#undef RESC
}
#undef KSWZ
#undef SBAR
}
namespace ac {
using aa::bf16; using aa::bf16x8; using aa::s16x4; using aa::f32x16; using aa::u32x4; using aa::crow; using aa::cvtpk; using aa::tr_read; using aa::v_rd_base;
constexpr int D = 64, KVBLK = 64, KVW = 128, LDQ = 1280;
constexpr float SCALE = 0.125f, THR = 8.f, NEG = -1e30f;
constexpr int SHM_K = KVBLK * D * 2, SHM_V = KVBLK * D * 2;
constexpr int LDS_K = 0, LDS_V = 2 * SHM_K, LDS_WS = 2 * SHM_K + 2 * SHM_V, LDS_OST = 0;
#define CSBAR() __builtin_amdgcn_sched_barrier(0)
__device__ __forceinline__ int kswz(int row, int chunk) { return row * 128 + ((chunk ^ ((row >> 1) & 7)) << 4); }
__device__ __forceinline__ int v_st64(int k, int c) { const int kk = (k & ~0xC) | ((k & 4) << 1) | ((k & 8) >> 1); return ((kk >> 3) * 2 + (c >> 5)) * 512 + ((kk & 7) * 32 + (c & 31)) * 2; }
constexpr int v_rd_off64(int d0, int ks, int half) { return d0 * 512 + ks * 2048 + half * 1024; }
__device__ __forceinline__ void partialSM(f32x16& p0, f32x16& p1, float& m_reg, float& alpha) {
  constexpr float C = SCALE * 1.4426950408889634f;
  float pmax = p0[0]; for (int r = 1; r < 16; ++r) pmax = fmaxf(pmax, p0[r]); for (int r = 0; r < 16; ++r) pmax = fmaxf(pmax, p1[r]);
  { auto rr = __builtin_amdgcn_permlane32_swap(__float_as_uint(pmax), __float_as_uint(pmax), false, false);
    pmax = fmaxf(__uint_as_float(rr[0]), __uint_as_float(rr[1])); }
  float mn;
  if (__builtin_expect(__all(pmax - m_reg <= THR / SCALE), 1)) { mn = m_reg; alpha = 1.f; }
  else { mn = fmaxf(m_reg, pmax); alpha = __builtin_amdgcn_exp2f((m_reg - mn) * C); m_reg = mn; }
  const float mnC = -mn * C;
  for (int r = 0; r < 16; ++r) p0[r] = fmaf(p0[r], C, mnC); for (int r = 0; r < 16; ++r) p1[r] = fmaf(p1[r], C, mnC);
  for (int r = 0; r < 16; ++r) p0[r] = __builtin_amdgcn_exp2f(p0[r]); for (int r = 0; r < 16; ++r) p1[r] = __builtin_amdgcn_exp2f(p1[r]);
}
__device__ __forceinline__ void finishSM(f32x16& p0, f32x16& p1, float alpha, float& l_reg, bf16x8& pa0, bf16x8& pa1, bf16x8& pa2, bf16x8& pa3) {
  float ps = 0; for (int r = 0; r < 16; ++r) ps += p0[r]; for (int r = 0; r < 16; ++r) ps += p1[r];
  { auto rr = __builtin_amdgcn_permlane32_swap(__float_as_uint(ps), __float_as_uint(ps), false, false);
    ps = __uint_as_float(rr[0]) + __uint_as_float(rr[1]); }
  l_reg = l_reg * alpha + ps;
#define PK4(P, BASE, OUT) do { unsigned a0 = cvtpk(P[BASE + 0], P[BASE + 1]), a1 = cvtpk(P[BASE + 2], P[BASE + 3]);   \
    unsigned b0 = cvtpk(P[BASE + 4], P[BASE + 5]), b1 = cvtpk(P[BASE + 6], P[BASE + 7]);                              \
    auto r0 = __builtin_amdgcn_permlane32_swap(a0, b0, false, false); auto r1 = __builtin_amdgcn_permlane32_swap(a1, b1, false, false); \
    u32x4 w = {r0[0], r1[0], r0[1], r1[1]}; OUT = *reinterpret_cast<bf16x8*>(&w); } while (0)
  PK4(p0, 0, pa0); PK4(p0, 8, pa1); PK4(p1, 0, pa2); PK4(p1, 8, pa3);
#undef PK4
}
__device__ __forceinline__ void qkt(f32x16& p0, f32x16& p1, const char* Ks, const bf16x8* qr, int r32, int hi) {
  p0 = f32x16{}; p1 = f32x16{};
#pragma unroll
  for (int d0 = 0; d0 < 4; ++d0) { const int ch = d0 * 2 + hi;
    const bf16x8 b0 = *reinterpret_cast<const bf16x8*>(Ks + kswz(r32, ch));
    const bf16x8 b1 = *reinterpret_cast<const bf16x8*>(Ks + kswz(32 + r32, ch));
    p0 = __builtin_amdgcn_mfma_f32_32x32x16_bf16(b0, qr[d0], p0, 0, 0, 0);
    p1 = __builtin_amdgcn_mfma_f32_32x32x16_bf16(b1, qr[d0], p1, 0, 0, 0); }
}
template <int D0> __device__ __forceinline__ void pv_one(f32x16& od, int vb, bf16x8 pa0, bf16x8 pa1, bf16x8 pa2, bf16x8 pa3) {
  const s16x4 l0 = tr_read<v_rd_off64(D0, 0, 0)>(vb), h0 = tr_read<v_rd_off64(D0, 0, 1)>(vb), l1 = tr_read<v_rd_off64(D0, 1, 0)>(vb), h1 = tr_read<v_rd_off64(D0, 1, 1)>(vb);
  const s16x4 l2 = tr_read<v_rd_off64(D0, 2, 0)>(vb), h2 = tr_read<v_rd_off64(D0, 2, 1)>(vb), l3 = tr_read<v_rd_off64(D0, 3, 0)>(vb), h3 = tr_read<v_rd_off64(D0, 3, 1)>(vb);
  asm volatile("s_waitcnt lgkmcnt(0)" ::: "memory"); CSBAR();
#define PK(L, H) (bf16x8){L[0], L[1], L[2], L[3], H[0], H[1], H[2], H[3]}
  od = __builtin_amdgcn_mfma_f32_32x32x16_bf16(pa0, PK(l0, h0), od, 0, 0, 0);
  od = __builtin_amdgcn_mfma_f32_32x32x16_bf16(pa1, PK(l1, h1), od, 0, 0, 0);
  od = __builtin_amdgcn_mfma_f32_32x32x16_bf16(pa2, PK(l2, h2), od, 0, 0, 0);
  od = __builtin_amdgcn_mfma_f32_32x32x16_bf16(pa3, PK(l3, h3), od, 0, 0, 0);
#undef PK
}
__device__ __forceinline__ void unit(const bf16* __restrict__ Qh, const bf16* __restrict__ Kb, const bf16* __restrict__ Vb, int rc, int rl, bf16* __restrict__ Oh, int t0, float sink_l2, char* lds, const int tid, const float* __restrict__ cs) {
  const int wid = __builtin_amdgcn_readfirstlane(tid >> 6), lane = tid & 63, r32 = lane & 31, hi = lane >> 5;
  char* K_lds = lds + LDS_K; char* V_lds = lds + LDS_V;
  float* wsf = (float*)(lds + LDS_WS) + wid * 64; float* li_l = wsf; float* al_l = wsf + 32;
  float m_reg = -1e30f, l_reg = 0.f; f32x16 o[2] = {}; bf16x8 qr[4];
#pragma unroll
  for (int d0 = 0; d0 < 4; ++d0) qr[d0] = *reinterpret_cast<const bf16x8*>(Qh + (long)r32 * LDQ + d0 * 16 + hi * 8);
  if (t0 >= 0) {
    const int t = t0 + r32, prow = t >> 6, pcol = t & 63;
#pragma unroll
    for (int d0 = 0; d0 < 2; ++d0) { const float* c8 = cs + ((d0 == 0 ? prow : pcol) * 16 + hi * 8) * 2;
      float a[8], b[8];
#pragma unroll
      for (int j = 0; j < 8; ++j) { a[j] = __uint_as_float(((unsigned)(unsigned short)qr[d0][j]) << 16); b[j] = __uint_as_float(((unsigned)(unsigned short)qr[d0 + 2][j]) << 16); }
#pragma unroll
      for (int j4 = 0; j4 < 4; ++j4) { const float4 v = *(const float4*)(c8 + 4 * j4);
        { const float y1 = a[2 * j4], y2 = b[2 * j4]; a[2 * j4] = y1 * v.x - y2 * v.y; b[2 * j4] = y1 * v.y + y2 * v.x; }
        { const float y1 = a[2 * j4 + 1], y2 = b[2 * j4 + 1]; a[2 * j4 + 1] = y1 * v.z - y2 * v.w; b[2 * j4 + 1] = y1 * v.w + y2 * v.z; } }
      u32x4 wa = {cvtpk(a[0], a[1]), cvtpk(a[2], a[3]), cvtpk(a[4], a[5]), cvtpk(a[6], a[7])}, wb = {cvtpk(b[0], b[1]), cvtpk(b[2], b[3]), cvtpk(b[4], b[5]), cvtpk(b[6], b[7])};
      qr[d0] = *reinterpret_cast<bf16x8*>(&wa); qr[d0 + 2] = *reinterpret_cast<bf16x8*>(&wb); }
  }
  const int skey = tid >> 3, sch = tid & 7;
  const int kst = kswz(skey, sch), vst = v_st64(skey, sch * 8);
  const int vb0 = (int)(uintptr_t)V_lds + v_rd_base(lane);
  const int lo = t0 - WINDOW < 0 ? 0 : t0 - WINDOW, hiq = t0 + 31 + WINDOW > SEQ - 1 ? SEQ - 1 : t0 + 31 + WINDOW;
  const int NT = t0 < 0 ? 4 : 9;
#define TILE_S0(j) (t0 - WINDOW + 64 * ((j) - 4))
#define TILE_OK(j) ((j) < 4 || (TILE_S0(j) + 63 >= lo && TILE_S0(j) <= hiq))
#define KVROW(j) ((j) < 4 ? 64 * (j) + skey : CTXL + min(max(TILE_S0(j) + skey, 0), SEQ - 1))
  bf16x8 sk, sv, sk2, sv2;
#define SLOAD(j) do { const long row_ = KVROW(j); sk = *reinterpret_cast<const bf16x8*>(Kb + row_ * KVW + sch * 8); sv = *reinterpret_cast<const bf16x8*>(Vb + (row_ < CTXL ? rc + row_ : rl + row_ - CTXL) * LDQ + sch * 8); } while (0)
#define SLOAD2(j) do { const long row_ = KVROW(j); sk2 = *reinterpret_cast<const bf16x8*>(Kb + row_ * KVW + sch * 8); sv2 = *reinterpret_cast<const bf16x8*>(Vb + (row_ < CTXL ? rc + row_ : rl + row_ - CTXL) * LDQ + sch * 8); } while (0)
#define SWRITE(b) do { *(bf16x8*)(K_lds + (b) * SHM_K + kst) = sk; *(bf16x8*)(V_lds + (b) * SHM_V + vst) = sv; } while (0)
  SLOAD(0); SWRITE(0); __syncthreads();
  { int j1 = 1; while (j1 < NT && !TILE_OK(j1)) ++j1; if (j1 < NT) SLOAD(j1); }
  int buf = 0;
  for (int j = 0; j < NT; ++j) {
    if (!TILE_OK(j)) continue;
    int jn = j + 1; while (jn < NT && !TILE_OK(jn)) ++jn;
    int j2 = jn + 1; while (j2 < NT && !TILE_OK(j2)) ++j2;
    if (j2 < NT) SLOAD2(j2);
    f32x16 p0, p1; float alpha; bf16x8 pa0, pa1, pa2, pa3;
    qkt(p0, p1, K_lds + buf * SHM_K, qr, r32, hi);
    if (j >= 4 && (TILE_S0(j) < 0 || TILE_S0(j) + 63 >= SEQ || TILE_S0(j) < t0 + 31 - WINDOW || TILE_S0(j) + 63 > t0 + WINDOW)) {
      const int s0 = TILE_S0(j), t = t0 + r32;
#pragma unroll
      for (int r = 0; r < 16; ++r) { const int sA = s0 + crow(r, hi), sB = sA + 32;
        if (sA < 0 || sA >= SEQ || sA - t > WINDOW || t - sA > WINDOW) p0[r] = NEG;
        if (sB < 0 || sB >= SEQ || sB - t > WINDOW || t - sB > WINDOW) p1[r] = NEG; }
    }
    partialSM(p0, p1, m_reg, alpha);
    if (__any(alpha < 1.f)) { if (hi == 0) al_l[r32] = alpha; asm volatile("s_waitcnt lgkmcnt(0)" ::: "memory");
#pragma unroll
      for (int d = 0; d < 2; ++d)
#pragma unroll
        for (int r = 0; r < 16; ++r) o[d][r] *= al_l[crow(r, hi)]; }
    finishSM(p0, p1, alpha, l_reg, pa0, pa1, pa2, pa3); CSBAR();
    pv_one<0>(o[0], vb0 + buf * SHM_V, pa0, pa1, pa2, pa3); pv_one<1>(o[1], vb0 + buf * SHM_V, pa0, pa1, pa2, pa3);
    if (jn < NT) { SWRITE(buf ^ 1); }
    __syncthreads();
    sk = sk2; sv = sv2;
    buf ^= 1;
  }
  l_reg += __builtin_amdgcn_exp2f(sink_l2 - m_reg * (SCALE * 1.4426950408889634f));
  if (hi == 0) li_l[r32] = l_reg; asm volatile("s_waitcnt lgkmcnt(0)" ::: "memory");
  float rli[16];
#pragma unroll
  for (int r = 0; r < 16; ++r) rli[r] = __builtin_amdgcn_rcpf(li_l[crow(r, hi)]);
  bf16* stg = (bf16*)(lds + LDS_OST) + wid * (32 * D);
#pragma unroll
  for (int r = 0; r < 16; ++r) { const int orow = crow(r, hi);
#pragma unroll
    for (int d0 = 0; d0 < 2; ++d0) stg[orow * D + d0 * 32 + r32] = (bf16)(cvtpk(o[d0][r] * rli[r], 0.f) & 0xffffu); }
  asm volatile("s_waitcnt lgkmcnt(0)" ::: "memory");
#pragma unroll
  for (int i = 0; i < 4; ++i) { const int row = i * 8 + (lane >> 3), ch = lane & 7; const u32x4 v = *(const u32x4*)(stg + row * D + ch * 8); *(u32x4*)(Oh + (long)row * 1024 + ch * 8) = v; }
  __syncthreads();
#undef TILE_S0
#undef TILE_OK
#undef KVROW
#undef SLOAD
#undef SLOAD2
#undef SWRITE
}
#undef CSBAR
}

struct Args { const float* in[N_IN]; float* out; unsigned char* ws; int ph_lo, ph_hi, single, pad; };
struct Frame {
    LAS unsigned char* lds;
    unsigned char* ldsg;
    volatile LAS unsigned* MISC;
    gu32* ctl;
    int tid, lane, wave, vcu, G, bx;
    LAS unsigned long long* intab;
    float* out; unsigned char* ws;
    __device__ __forceinline__ const float* inp(int i) const { const unsigned long long v = intab[i];
        const unsigned lo = __builtin_amdgcn_readfirstlane((unsigned)v), hi = __builtin_amdgcn_readfirstlane((unsigned)(v >> 32));
        return (const float*)(GAS const float*)(((unsigned long long)hi << 32) | lo); }
};
__device__ __forceinline__ float bf2f(unsigned h) { return __uint_as_float(h << 16); }
#define SWZ_XOR(v, o) __int_as_float(__builtin_amdgcn_ds_swizzle(__float_as_int(v), ((o) << 10) | 0x1f))
#define DPP_F(v, ctrl) __int_as_float(__builtin_amdgcn_mov_dpp(__float_as_int(v), (ctrl), 0xf, 0xf, false))
__device__ __forceinline__ float wave_sum(float v) {
    v += DPP_F(v, 0xB1); v += DPP_F(v, 0x4E); v += DPP_F(v, 0x124); v += DPP_F(v, 0x128); v += SWZ_XOR(v, 16);
    const auto rr = __builtin_amdgcn_permlane32_swap(__float_as_uint(v), __float_as_uint(v), false, false);
    return __uint_as_float(rr[0]) + __uint_as_float(rr[1]);
}
__device__ __forceinline__ float wave_max(float v) {
    v = fmaxf(v, SWZ_XOR(v, 1)); v = fmaxf(v, SWZ_XOR(v, 2)); v = fmaxf(v, SWZ_XOR(v, 4)); v = fmaxf(v, SWZ_XOR(v, 8)); v = fmaxf(v, SWZ_XOR(v, 16));
    const auto rr = __builtin_amdgcn_permlane32_swap(__float_as_uint(v), __float_as_uint(v), false, false);
    return fmaxf(__uint_as_float(rr[0]), __uint_as_float(rr[1]));
}
typedef float f32x2 __attribute__((ext_vector_type(2)));
__device__ __forceinline__ float lane_bcast(float v, int k) { return __int_as_float(__builtin_amdgcn_readlane(__float_as_int(v), k)); }
__device__ __forceinline__ float silu_f(float x) { return x / (1.0f + expf(-x)); }
__device__ __forceinline__ float* hrow_ctx(const Frame& F, int r) { return (float*)(F.ws + WS_HCTX) + (size_t)(r - MLAT) * DM; }
__device__ __forceinline__ bf16* hrow_lat(const Frame& F, int r) { return (bf16*)(F.ws + WS_HB) + (size_t)r * DM; }
__device__ __forceinline__ const float* modvec(const Frame& F, int layer, int r) { const int idx = r < MLAT ? layer * 4 + r / SEQ : 16 + layer; return (const float*)(F.ws + WS_MOD) + (size_t)idx * (NMOD * DM); }

__device__ __forceinline__ void p0_transpose_item(const float* W, int K, int N, bf16* WT, LAS float* scr, int item, int lane, bool gate_up) {
    const int nblk = N / 64, kb = item / nblk, nb = item % nblk, k0 = 64 * kb, n0 = 64 * nb;
    const int n0d = gate_up ? (n0 < DFF ? (n0 / 128) * 256 + (n0 % 128) : ((n0 - DFF) / 128) * 256 + 128 + ((n0 - DFF) % 128)) : n0;
    const float* src = W + (size_t)k0 * N + n0 + lane;
    float ld_[64];
#pragma unroll
    for (int i = 0; i < 64; ++i) ld_[i] = __builtin_nontemporal_load(src + (size_t)i * N);
#pragma unroll
    for (int i = 0; i < 64; ++i) scr[i * 65 + lane] = ld_[i];
    LDS_WAIT(); asm volatile("" ::: "memory");
    const int c = lane & 7;
#pragma unroll
    for (int j = 0; j < 8; ++j) { const int n = (lane >> 3) + 8 * j; const LAS float* s = scr + (8 * c) * 65 + n;
        v4u o; o.x = pk2(s[0 * 65], s[1 * 65]); o.y = pk2(s[2 * 65], s[3 * 65]); o.z = pk2(s[4 * 65], s[5 * 65]); o.w = pk2(s[6 * 65], s[7 * 65]);
        *(GAS v4u*)(WT + (size_t)(n0d + n) * K + k0 + 8 * c) = o; }
    LDS_WAIT(); asm volatile("" ::: "memory");
}
__device__ __forceinline__ void p0_filters(Frame& F, int slot, int nslots) {
    LAS float* WB = (LAS float*)F.lds;
    const float* w1 = F.inp(I_FW1); const float* w2 = F.inp(I_FW2); const float* w3 = F.inp(I_FW3); const float* w4 = F.inp(I_FW4);
    const float bb1 = F.inp(I_FB1)[F.lane], bb2 = F.inp(I_FB2)[F.lane], bb3 = F.inp(I_FB3)[F.lane];
    const float r0 = -15.350567286626973f, r1 = -3.0701134573253945f;
    for (int it = slot; it < (SEQ + CTXL) / 32; it += nslots) {
        const int pos0 = it * 32 + F.wave * 4; const bool lat = pos0 < SEQ; const int L = lat ? SEQ : CTXL, t0 = lat ? pos0 : pos0 - SEQ;
        float* Hc = (float*)(F.ws + WS_HCCTX);
        f32x4 stg[8];
#define W4_LOAD(c_) do { _Pragma("unroll") for (int e_ = 0; e_ < 8; ++e_) { const int q_ = F.tid + e_ * NTHREADS, k_ = q_ >> 6, c4_ = q_ & 63; stg[e_] = *((const f32x4*)(w4 + (size_t)k_ * (2 * DM) + (c_) * 256) + c4_); } } while (0)
#define W4_STORE(buf_) do { _Pragma("unroll") for (int e_ = 0; e_ < 8; ++e_) *((LAS f32x4*)(WB + (buf_) * 16384) + F.tid + e_ * NTHREADS) = stg[e_]; } while (0)
        float f[4], tn[4], zv[4];
#pragma unroll
        for (int q = 0; q < 4; ++q) {
            const int t = t0 + q;
            tn[q] = (float)t / (float)(L - 1);
            const float omega = (6.283185307179586f / (float)L) * (float)t;
            zv[q] = 0.f;
            { const int k = F.lane;
              if (k == 0) zv[q] = tn[q];
              else if (k <= 32) { const int kb = (k - 1) & 15; const float band = 1e-4f + (float)kb * ((15.0f - 1e-4f) / 15.0f); const float ang = omega * band; zv[q] = (k <= 16) ? cosf(ang) : -sinf(ang); } }
        }
        {
            float wr_[16], a_[4];
#define MLP_PART(W_, k0_, n_, in_) do { GAS const float* wb_ = (GAS const float*)((W_) + (k0_) * 64); asm volatile("" : "+s"(wb_)); \
                _Pragma("unroll") for (int k = 0; k < (n_); ++k) wr_[k] = wb_[k * 64 + F.lane]; \
                _Pragma("unroll") for (int q = 0; q < 4; ++q) { _Pragma("unroll") for (int k = 0; k < (n_); ++k) a_[q] += lane_bcast((in_)[q], (k0_) + k) * wr_[k]; } } while (0)
#pragma unroll
            for (int q = 0; q < 4; ++q) a_[q] = bb1;
            MLP_PART(w1, 0, 16, zv); MLP_PART(w1, 16, 16, zv); MLP_PART(w1, 32, 1, zv);
#pragma unroll
            for (int q = 0; q < 4; ++q) { f[q] = sinf(a_[q]); a_[q] = bb2; }
            MLP_PART(w2, 0, 16, f); MLP_PART(w2, 16, 16, f); MLP_PART(w2, 32, 16, f); MLP_PART(w2, 48, 16, f);
#pragma unroll
            for (int q = 0; q < 4; ++q) { zv[q] = sinf(a_[q]); a_[q] = bb3; }
            MLP_PART(w3, 0, 16, zv); MLP_PART(w3, 16, 16, zv); MLP_PART(w3, 32, 16, zv); MLP_PART(w3, 48, 16, zv);
#pragma unroll
            for (int q = 0; q < 4; ++q) f[q] = sinf(a_[q]);
#undef MLP_PART
        }
        W4_LOAD(0);
        W4_STORE(0);
        __syncthreads();
        for (int c = 0; c < 8; ++c) {
            if (c + 1 < 8) W4_LOAD(c + 1);
            const LAS float* wb = WB + (c & 1) * 16384 + 4 * F.lane;
            f32x2 acc[4][2];
#pragma unroll
            for (int q = 0; q < 4; ++q) { acc[q][0] = (f32x2){0.f, 0.f}; acc[q][1] = (f32x2){0.f, 0.f}; }
#pragma unroll 4
            for (int k = 0; k < 64; ++k) { const f32x4 w = *(const LAS f32x4*)(wb + k * 256); const f32x2 wlo = {w[0], w[1]}, whi = {w[2], w[3]};
#pragma unroll
                for (int q = 0; q < 4; ++q) { const float fk = lane_bcast(f[q], k); const f32x2 f2 = {fk, fk}; acc[q][0] = __builtin_elementwise_fma(wlo, f2, acc[q][0]); acc[q][1] = __builtin_elementwise_fma(whi, f2, acc[q][1]); } }
            f32x4 val[4];
#pragma unroll
            for (int j = 0; j < 4; ++j) { const int d = (c * 256 + 4 * F.lane + j) & (DM - 1);
                const float rate = fabsf(r0 + (float)d * ((r1 - r0) / (float)(DM - 1)));
#pragma unroll
                for (int q = 0; q < 4; ++q) val[j][q] = acc[q][j >> 1][j & 1] * expf(-tn[q] * rate); }
            const bool fwd = c < 4;
            const int d0 = (c * 256 + 4 * F.lane) & (DM - 1);
            if (lat) {
#pragma unroll
                for (int j = 0; j < 4; ++j) { float* dst = (float*)(F.ws + WS_HCLAT) + (fwd ? (size_t)0 : (size_t)DM * SEQ) + (size_t)(d0 + j) * SEQ + t0; *(f32x4*)dst = val[j]; }
            } else {
#pragma unroll
                for (int q = 0; q < 4; ++q) { const int t = t0 + q; const f32x4 o = {val[0][q], val[1][q], val[2][q], val[3][q]};
                    if (fwd) *(f32x4*)(Hc + (size_t)(t + L - 1) * DM + d0) = o;
                    else if (t >= 1) *(f32x4*)(Hc + (size_t)(L - 1 - t) * DM + d0) = o; } }
            if (c + 1 < 8) W4_STORE((c + 1) & 1);
            __syncthreads();
        }
#undef W4_LOAD
#undef W4_STORE
    }
}

__device__ __forceinline__ void transpose_group(Frame& F, unsigned mask, int slot0, int nmine, int nslots) {
    LAS float* scr = (LAS float*)(F.lds + F.wave * (64 * 65 * 4));
    for (int s = 0; s < nmine; ++s)
    for (int gi = (slot0 + s) * NWAVES + F.wave;; gi += nslots * NWAVES) {
        int base = 0, mat = 0, items = 0; const float* src = nullptr; bf16* dst = nullptr; int K = DM, N = DM; bool found = false;
        for (; mat < 17; ++mat) {
            if (!((mask >> mat) & 1u)) continue;
            if (mat < 2)       { src = F.inp(I_AQKV) + (size_t)mat * DM * A_COLS; dst = (bf16*)(F.ws + WS_W_AQKV) + (size_t)mat * A_COLS * DM; K = DM; N = A_COLS; }
            else if (mat < 4)  { src = F.inp(I_AOUT) + (size_t)(mat - 2) * DM * DM; dst = (bf16*)(F.ws + WS_W_AOUT) + (size_t)(mat - 2) * DM * DM; K = DM; N = DM; }
            else if (mat == 4) { src = F.inp(I_BIN); dst = (bf16*)(F.ws + WS_W_BIN); K = DM; N = 3 * DM; }
            else if (mat == 5) { src = F.inp(I_BOUT); dst = (bf16*)(F.ws + WS_W_BOUT); K = DM; N = DM; }
            else if (mat == 6) { src = F.inp(I_CQKV); dst = (bf16*)(F.ws + WS_W_CQKV); K = DM; N = C_COLS; }
            else if (mat == 7) { src = F.inp(I_COUT); dst = (bf16*)(F.ws + WS_W_COUT); K = DM; N = DM; }
            else if (mat < 12) { src = F.inp(I_WUP) + (size_t)(mat - 8) * DM * 2 * DFF; dst = (bf16*)(F.ws + WS_W_UP) + (size_t)(mat - 8) * 2 * DFF * DM; K = DM; N = 2 * DFF; }
            else if (mat < 16) { src = F.inp(I_WDOWN) + (size_t)(mat - 12) * DFF * DM; dst = (bf16*)(F.ws + WS_W_DOWN) + (size_t)(mat - 12) * DM * DFF; K = DFF; N = DM; }
            else               { src = F.inp(I_FW4); dst = (bf16*)(F.ws + WS_W4T); K = 64; N = 2 * DM; }
            items = (K / 64) * (N / 64);
            if (gi < base + items) { found = true; break; }
            base += items;
        }
        if (!found) break;
        p0_transpose_item(src, K, N, dst, scr, gi - base, F.lane, mat >= 8 && mat < 12);
    }
}
constexpr unsigned TG_P0 = (1u << 0) | (1u << 4) | (1u << 16);
constexpr unsigned TG_L0 = (1u << 2) | (1u << 8) | (1u << 12);
constexpr unsigned TG_L1 = (1u << 5) | (1u << 9) | (1u << 13) | (1u << 6);
constexpr unsigned TG_L2 = (1u << 7) | (1u << 10) | (1u << 14) | (1u << 1);
constexpr unsigned TG_L3 = (1u << 3) | (1u << 11) | (1u << 15);
static_assert((TG_P0 | TG_L0 | TG_L1 | TG_L2 | TG_L3) == 0x1ffffu && (TG_P0 ^ TG_L0 ^ TG_L1 ^ TG_L2 ^ TG_L3) == 0x1ffffu, "every matrix exactly once");
__device__ __forceinline__ void filters_mfma(Frame& F, int slot, int nslots) {
    LAS unsigned short* FA = (LAS unsigned short*)F.lds;
    const float* w1 = F.inp(I_FW1); const float* w2 = F.inp(I_FW2); const float* w3 = F.inp(I_FW3);
    const bf16* W4T = (const bf16*)(F.ws + WS_W4T);
    const float bb1 = F.inp(I_FB1)[F.lane], bb2 = F.inp(I_FB2)[F.lane], bb3 = F.inp(I_FB3)[F.lane];
    const float r0 = -15.350567286626973f, r1 = -3.0701134573253945f;
    const int l15 = F.lane & 15, lg = F.lane >> 4;
    for (int it = slot; it < (SEQ + CTXL) / 32; it += nslots) {
        const int posb = it * 32; const bool lat = posb < SEQ; const int L = lat ? SEQ : CTXL, tb = lat ? posb : posb - SEQ, t0 = tb + F.wave * 4;
        float* Hc = (float*)(F.ws + WS_HCCTX);
        const float inv_lm1 = 1.0f / (float)(L - 1);
        float f[4], zv[4];
#pragma unroll
        for (int q = 0; q < 4; ++q) {
            const int t = t0 + q;
            const float tnq = (float)t / (float)(L - 1);
            const float omega = (6.283185307179586f / (float)L) * (float)t;
            zv[q] = 0.f;
            { const int k = F.lane;
              if (k == 0) zv[q] = tnq;
              else if (k <= 32) { const int kb = (k - 1) & 15; const float band = 1e-4f + (float)kb * ((15.0f - 1e-4f) / 15.0f); const float ang = omega * band; zv[q] = (k <= 16) ? cosf(ang) : -sinf(ang); } }
        }
        {
            float wr_[16], a_[4];
#define MLP_PART(W_, k0_, n_, in_) do { GAS const float* wb_ = (GAS const float*)((W_) + (k0_) * 64); asm volatile("" : "+s"(wb_)); \
                _Pragma("unroll") for (int k = 0; k < (n_); ++k) wr_[k] = wb_[k * 64 + F.lane]; \
                _Pragma("unroll") for (int q = 0; q < 4; ++q) { _Pragma("unroll") for (int k = 0; k < (n_); ++k) a_[q] += lane_bcast((in_)[q], (k0_) + k) * wr_[k]; } } while (0)
#pragma unroll
            for (int q = 0; q < 4; ++q) a_[q] = bb1;
            MLP_PART(w1, 0, 16, zv); MLP_PART(w1, 16, 16, zv); MLP_PART(w1, 32, 1, zv);
#pragma unroll
            for (int q = 0; q < 4; ++q) { f[q] = sinf(a_[q]); a_[q] = bb2; }
            MLP_PART(w2, 0, 16, f); MLP_PART(w2, 16, 16, f); MLP_PART(w2, 32, 16, f); MLP_PART(w2, 48, 16, f);
#pragma unroll
            for (int q = 0; q < 4; ++q) { zv[q] = sinf(a_[q]); a_[q] = bb3; }
            MLP_PART(w3, 0, 16, zv); MLP_PART(w3, 16, 16, zv); MLP_PART(w3, 32, 16, zv); MLP_PART(w3, 48, 16, zv);
#pragma unroll
            for (int q = 0; q < 4; ++q) f[q] = sinf(a_[q]);
#undef MLP_PART
        }
#pragma unroll
        for (int q = 0; q < 4; ++q) FA[(F.wave * 4 + q) * 64 + F.lane] = (unsigned short)f2bf(f[q]);
        __syncthreads();
        bf16x8 A[2][2];
#pragma unroll
        for (int mt = 0; mt < 2; ++mt)
#pragma unroll
            for (int ks = 0; ks < 2; ++ks) A[mt][ks] = *(const LAS bf16x8*)(FA + (mt * 16 + l15) * 64 + ks * 32 + lg * 8);
        const bool fwd = F.wave < 4;
        for (int nt = 0; nt < 16; ++nt) {
            const int n2 = F.wave * 256 + nt * 16 + l15, d = n2 & (DM - 1);
            const bf16x8 B0 = *(const GAS bf16x8*)(W4T + (size_t)n2 * 64 + lg * 8), B1 = *(const GAS bf16x8*)(W4T + (size_t)n2 * 64 + 32 + lg * 8);
            const float rate2 = fabsf(r0 + (float)d * ((r1 - r0) / (float)(DM - 1))) * 1.4426950408889634f;
#pragma unroll
            for (int mt = 0; mt < 2; ++mt) {
                f32x4 acc = {0.f, 0.f, 0.f, 0.f};
                acc = __builtin_amdgcn_mfma_f32_16x16x32_bf16(A[mt][0], B0, acc, 0, 0, 0);
                acc = __builtin_amdgcn_mfma_f32_16x16x32_bf16(A[mt][1], B1, acc, 0, 0, 0);
                const int tq = tb + mt * 16 + lg * 4;
                f32x4 val;
#pragma unroll
                for (int r = 0; r < 4; ++r) val[r] = acc[r] * __builtin_amdgcn_exp2f(-((float)(tq + r) * inv_lm1) * rate2);
                if (lat) { float* dst = (float*)(F.ws + WS_HCLAT) + (fwd ? (size_t)0 : (size_t)DM * SEQ) + (size_t)d * SEQ + tq; *(f32x4*)dst = val; }
                else {
#pragma unroll
                    for (int r = 0; r < 4; ++r) { const int t = tq + r;
                        if (fwd) Hc[(size_t)(t + L - 1) * DM + d] = val[r];
                        else if (t >= 1) Hc[(size_t)(L - 1 - t) * DM + d] = val[r]; } }
            }
        }
        __syncthreads();
    }
}
__device__ __forceinline__ void p0_gemv(Frame& F, int lo, int hi, int slot, int nslots) {
    LAS float* S = (LAS float*)F.lds;
    for (int e = F.tid; e < 5 * DM; e += NTHREADS) { const int v = e / DM, k = e % DM; const float x = v < 4 ? F.inp(I_C)[v * DM + k] : F.inp(I_CCTX)[k]; S[e] = silu_f(x); }
    __syncthreads();
    LAS float* RED4 = (LAS float*)(F.lds + 32768);
    const int hl = F.lane >> 5, c4 = F.lane & 31;
    for (int it = lo + slot; it < hi; it += nslots) {
        const int layer = it / 48, cb = it % 48;
        const f32x4* W = (const f32x4*)(F.inp(I_MODW) + (size_t)layer * DM * (NMOD * DM) + cb * 128) + c4;
        f32x4 a0 = {0.f, 0.f, 0.f, 0.f}, a1 = a0, a2 = a0, a3 = a0, a4 = a0;
        const int k0 = F.wave * 128 + hl;
#pragma unroll 16
        for (int k = k0; k < k0 + 128; k += 2) { const f32x4 w = __builtin_nontemporal_load(W + (size_t)k * (NMOD * DM / 4)); a0 += w * S[k]; a1 += w * S[DM + k]; a2 += w * S[2 * DM + k]; a3 += w * S[3 * DM + k]; a4 += w * S[4 * DM + k]; }
        LAS f32x4* R4 = (LAS f32x4*)RED4 + (F.wave * 5) * 64 + F.lane;
        R4[0] = a0; R4[64] = a1; R4[128] = a2; R4[192] = a3; R4[256] = a4;
        __syncthreads();
        for (int e = F.tid; e < 5 * 128; e += NTHREADS) { const int v = e >> 7, l = e & 127; float s = 0.f;
#pragma unroll
            for (int w = 0; w < 8; ++w) s += RED4[(w * 5 + v) * 256 + l] + RED4[(w * 5 + v) * 256 + 128 + l];
            s += F.inp(I_MODB)[layer * (NMOD * DM) + cb * 128 + l];
            const int idx = v < 4 ? layer * 4 + v : 16 + layer;
            ((float*)(F.ws + WS_MOD))[(size_t)idx * (NMOD * DM) + cb * 128 + l] = s; }
        __syncthreads();
    }
    __syncthreads();
}
__device__ __forceinline__ void p0_prologue(Frame& F) {
    const int gw = F.vcu * NWAVES + F.wave, NGW = F.G * NWAVES;
#ifndef P0_TREP
#define P0_TREP 1
#endif
    if (F.G == 256) {
        if (F.bx < 192) p0_gemv(F, 0, DEPTH * 48, F.bx, 192);
        else for (int rep_ = 0; rep_ < P0_TREP; ++rep_) transpose_group(F, TG_P0, F.bx - 192, 1, 64);
    } else {
        p0_gemv(F, 0, DEPTH * 48, F.bx, F.G);
        p0_filters(F, F.bx, F.G); __syncthreads();
        transpose_group(F, 0x1ffffu, F.bx, 1, F.G);
    }
    for (int e = gw * 64 + F.lane; e < 64 * 32 + 64 * 16; e += NGW * 64) {
        if (e < 64 * 32) { const int pos = e >> 5, k = e & 31; const float ang = (float)pos * expf(-(float)(2 * k) * (9.210340371976184f / 64.0f)); ((float2*)(F.ws + WS_CSA))[e] = make_float2(cosf(ang), sinf(ang)); }
        else { const int e2 = e - 64 * 32, pos = e2 >> 4, k = e2 & 15; const float ang = (float)pos * expf(-(float)(2 * k) * (9.210340371976184f / 32.0f)); ((float2*)(F.ws + WS_CSC))[e2] = make_float2(cosf(ang), sinf(ang)); }
    }
}
#ifndef TAIL_GREP
#define TAIL_GREP 1
#endif
#ifndef TAIL_TREP
#define TAIL_TREP 1
#endif
#ifndef TAIL_FREP
#define TAIL_FREP 1
#endif
__device__ __forceinline__ void prep_a(Frame& F, int j, int gw, int NGW);
__device__ __forceinline__ void prep_c(Frame& F, int gw, int NGW);
__device__ __forceinline__ void wait_ktiles(Frame& F, int layer) {
    if (F.tid == 0) {
        gu32* sig = F.ctl + CW_SEAM + 64 * layer; unsigned sp = 0;
        while (__hip_atomic_load(sig, __ATOMIC_RELAXED, __HIP_MEMORY_SCOPE_AGENT) < (unsigned)(MT / 256)) { __builtin_amdgcn_s_sleep(2); if (++sp > (1u << 20)) { __hip_atomic_store(F.ctl + 1, 1u, __ATOMIC_RELAXED, __HIP_MEMORY_SCOPE_AGENT); break; } }
        __builtin_amdgcn_fence(__ATOMIC_ACQUIRE, "agent");
        asm volatile("s_waitcnt vmcnt(0)" ::: "memory");
    }
    __syncthreads();
}
__device__ __forceinline__ void tail_work(Frame& F, int layer, int first_idle) {
    if (layer == 1) { if (F.bx >= 120) { for (int r_ = 0; r_ < TAIL_FREP; ++r_) filters_mfma(F, 255 - F.bx, 136); } }
    for (int r_ = 0; r_ < TAIL_TREP; ++r_) transpose_group(F, layer == 0 ? TG_L0 : layer == 1 ? TG_L1 : layer == 2 ? TG_L2 : TG_L3, F.bx - first_idle, 1, 256 - first_idle);
    if (layer != 1) {
        wait_ktiles(F, layer);
        const int gw = (F.bx - first_idle) * NWAVES + F.wave, NGW = (256 - first_idle) * NWAVES;
        if (layer == 2) prep_c(F, gw, NGW); else prep_a(F, layer / 3, gw, NGW);
    }
}
static_assert(((MT / 256) * (A_COLS / 256)) % 256 == 152 && ((MT / 256) * (3 * DM / 256)) % 256 == 48, "tail_work's workgroup ranges");
__device__ __forceinline__ void row_phase(Frame& F, int r_begin, int nrows, const bf16* src, int l_res, int g_res, int gate_idx, bool do_norm, int l_n, int g_n, int shift_idx, int scale_idx, const float* slab = nullptr, int nsplit = 0, bool h_in = false, bool out_f32 = false) {
    const int gw = F.vcu * NWAVES + F.wave, NGW = F.G * NWAVES;
    const float* NG = F.inp(I_NORMG); const float* xin = F.inp(I_X); const float* cin = F.inp(I_CTX);
    bf16* U = (bf16*)(F.ws + WS_U);
    const int nlat = r_begin == 0 ? (nrows < MLAT ? nrows : MLAT) : 0, RPW = (nlat + NGW - 1) / NGW;
    const bool skew = nsplit > 0 && nlat == MLAT && NGW == 2048 && nrows == MT;
    const bool cwv = F.wave < 4;
    const int l0 = skew ? F.vcu * 64 + (cwv ? 7 * F.wave : 28 + 9 * (F.wave - 4)) : gw * RPW, rpw = skew ? (cwv ? 7 : 9) : RPW;
    const int nl = l0 >= nlat ? 0 : (nlat - l0 < rpw ? nlat - l0 : rpw);
    const int nctx = nrows > MLAT ? nrows - MLAT : 0, c0 = skew ? F.vcu * 4 + F.wave : gw;
    const int nc = skew ? (cwv ? 1 : 0) : (gw < nctx ? (nctx - gw + NGW - 1) / NGW : 0);
    const int nseq = nl + nc;
#define RP_ROW(i_) ((i_) < nl ? l0 + (i_) : MLAT + c0 + ((i_) - nl) * NGW)
    f32x4 vn[4]; uint2 wn[4], hn[4];
#pragma unroll
    for (int j = 0; j < 4; ++j) { vn[j] = (f32x4){0.f, 0.f, 0.f, 0.f}; wn[j] = make_uint2(0u, 0u); hn[j] = wn[j]; }
#define RP_LOAD(r_) do { if (h_in || (r_) >= MLAT) { const float* hs_ = h_in ? ((r_) < MLAT ? xin + (size_t)(r_) * DM : cin + (size_t)((r_) - MLAT) * DM) : hrow_ctx(F, (r_)); \
            _Pragma("unroll") for (int j = 0; j < 4; ++j) vn[j] = *((const f32x4*)hs_ + F.lane + 64 * j); } \
        else { const bf16* hb_ = hrow_lat(F, (r_)); _Pragma("unroll") for (int j = 0; j < 4; ++j) hn[j] = *((const uint2*)hb_ + F.lane + 64 * j); } \
        if (src && !((r_) >= MLAT && nsplit > 0)) { _Pragma("unroll") for (int j = 0; j < 4; ++j) wn[j] = *((const uint2*)(src + (size_t)(r_) * DM) + F.lane + 64 * j); } } while (0)
#define RP_CVT(w_) ((f32x4){bf2f((w_).x & 0xffffu), bf2f((w_).x >> 16), bf2f((w_).y & 0xffffu), bf2f((w_).y >> 16)})
    f32x4 Pgm[4], Pgn[4], Psh[4]; int bcur = -1;
#pragma unroll
    for (int j = 0; j < 4; ++j) { Pgm[j] = (f32x4){0.f, 0.f, 0.f, 0.f}; Pgn[j] = Pgm[j]; Psh[j] = Pgm[j]; }
#define RP_PARAMS(rp_) do { const int b_ = (rp_) < MLAT ? (rp_) / SEQ : BATCH;     \
        if (b_ != bcur) { bcur = b_; \
            if (src) { const float* mv = modvec(F, l_res, (rp_)) + gate_idx * DM; const float* g = NG + (size_t)(l_res * 4 + g_res) * DM; \
                _Pragma("unroll") for (int j = 0; j < 4; ++j) Pgm[j] = *((const f32x4*)g + F.lane + 64 * j) * *((const f32x4*)mv + F.lane + 64 * j); } \
            if (do_norm) { const float* mv = modvec(F, l_n, (rp_)); const float* g = NG + (size_t)(l_n * 4 + g_n) * DM; \
                _Pragma("unroll") for (int j = 0; j < 4; ++j) { Pgn[j] = *((const f32x4*)g + F.lane + 64 * j) * (*((const f32x4*)(mv + scale_idx * DM) + F.lane + 64 * j) + 1.0f); Psh[j] = *((const f32x4*)(mv + shift_idx * DM) + F.lane + 64 * j); } } \
        } } while (0)
    if (nseq > 0) { const int r_ = RP_ROW(0); RP_LOAD(r_); }
    for (int i = 0; i < nseq; ++i) {
        const int r = RP_ROW(i);
        const bool hf32 = h_in || r >= MLAT;
        f32x4 v[4]; uint2 w[4];
#pragma unroll
        for (int j = 0; j < 4; ++j) { v[j] = hf32 ? vn[j] : RP_CVT(hn[j]); w[j] = wn[j]; }
        if (i + 1 < nseq) { const int r_ = RP_ROW(i + 1); RP_LOAD(r_); }
        RP_PARAMS(r);
        if (src) {
            f32x4 o[4]; float ss = 0.f;
            if (r >= MLAT && nsplit > 0) {
#pragma unroll
                for (int j = 0; j < 4; ++j) o[j] = (f32x4){0.f, 0.f, 0.f, 0.f};
                const f32x4* sl0 = (const f32x4*)(slab + (size_t)(r - MLAT) * DM) + F.lane;
#pragma unroll
                for (int sp0 = 0; sp0 < 8; sp0 += 4) {
                    f32x4 t[4][4]; float wg[4];
#pragma unroll
                    for (int s = 0; s < 4; ++s) { const int sp = sp0 + s < nsplit ? sp0 + s : nsplit - 1; wg[s] = sp0 + s < nsplit ? 1.f : 0.f;
                        const f32x4* sl = sl0 + (size_t)sp * (MCTX * DM / 4);
#pragma unroll
                        for (int j = 0; j < 4; ++j) t[s][j] = sl[64 * j]; }
#pragma unroll
                    for (int s = 0; s < 4; ++s)
#pragma unroll
                        for (int j = 0; j < 4; ++j) o[j] += t[s][j] * wg[s];
                }
            } else {
#pragma unroll
                for (int j = 0; j < 4; ++j) o[j] = RP_CVT(w[j]);
            }
#pragma unroll
            for (int j = 0; j < 4; ++j) ss += (o[j].x * o[j].x + o[j].y * o[j].y) + (o[j].z * o[j].z + o[j].w * o[j].w);
            const float rs = __builtin_amdgcn_rsqf(wave_sum(ss) * (1.0f / DM) + EPS);
#pragma unroll
            for (int j = 0; j < 4; ++j) v[j] = v[j] + (o[j] * rs) * Pgm[j];
            if (r >= MLAT) { float* h = hrow_ctx(F, r);
#pragma unroll
                for (int j = 0; j < 4; ++j) *((f32x4*)h + F.lane + 64 * j) = v[j];
            } else if (out_f32) { float* ho = F.out + (size_t)r * DM;
#pragma unroll
                for (int j = 0; j < 4; ++j) *((f32x4*)ho + F.lane + 64 * j) = v[j];
            } else { bf16* hb = hrow_lat(F, r);
#pragma unroll
                for (int j = 0; j < 4; ++j) { uint2 ww; ww.x = pk2(v[j].x, v[j].y); ww.y = pk2(v[j].z, v[j].w); *((uint2*)hb + F.lane + 64 * j) = ww;
                    v[j] = RP_CVT(ww); }
            }
        }
        if (do_norm) {
            float ss = 0.f;
#pragma unroll
            for (int j = 0; j < 4; ++j) ss += (v[j].x * v[j].x + v[j].y * v[j].y) + (v[j].z * v[j].z + v[j].w * v[j].w);
            const float rs = __builtin_amdgcn_rsqf(wave_sum(ss) * (1.0f / DM) + EPS);
#pragma unroll
            for (int j = 0; j < 4; ++j) { const f32x4 y = (v[j] * rs) * Pgn[j] + Psh[j];
                uint2 ww; ww.x = pk2(y.x, y.y); ww.y = pk2(y.z, y.w);
                *((uint2*)(U + (size_t)r * DM) + F.lane + 64 * j) = ww; }
        }
    }
#undef RP_PARAMS
#undef RP_LOAD
#undef RP_ROW
}
#undef RP_CVT

__device__ __forceinline__ void prep_a(Frame& F, int j, int gw, int NGW) {
    const int lane = F.lane;
    const bf16* QKV = (const bf16*)(F.ws + WS_R + R_QKV);
    bf16* KB = (bf16*)(F.ws + WS_R + R_KB);
    const float* kg = F.inp(I_AKG) + j * A_DH; const float* CSA = (const float*)(F.ws + WS_CSA);
    const float g1 = kg[lane], g2 = kg[64 + lane];
    for (int r0 = gw; r0 < MT; r0 += 9 * NGW) {
        bf16 n[9][4]; float2 cv[9];
#pragma unroll
        for (int i = 0; i < 9; ++i) { const int rr = r0 + i * NGW, r = rr < MT ? rr : MT - 1;
            const bf16* s_ = QKV + (size_t)r * A_COLS + A_HEADS * A_DH; n[i][0] = s_[lane]; n[i][1] = s_[64 + lane]; n[i][2] = s_[A_DH + lane]; n[i][3] = s_[A_DH + 64 + lane];
            const int t = r % SEQ; const float2 tv = *(const float2*)(CSA + ((lane < 32 ? t / GRID_W : t % GRID_W) * 32 + (lane & 31)) * 2); cv[i] = r < MLAT ? tv : make_float2(1.f, 0.f); }
#pragma unroll
        for (int i = 0; i < 9; ++i) { const int r = r0 + i * NGW;
            if (r < MT) {
                const bool lat = r < MLAT; const int b = lat ? r / SEQ : (r - MLAT) / CTXL, t = lat ? r % SEQ : (r - MLAT) % CTXL, key = lat ? CTXL + t : t;
                const float cs = cv[i].x, sn = cv[i].y;
                const float a1 = bf2f(n[i][0]), a2 = bf2f(n[i][1]), b1 = bf2f(n[i][2]), b2 = bf2f(n[i][3]);
                const float ra = __builtin_amdgcn_rsqf(wave_sum(a1 * a1 + a2 * a2) * (1.0f / A_DH) + EPS), rb = __builtin_amdgcn_rsqf(wave_sum(b1 * b1 + b2 * b2) * (1.0f / A_DH) + EPS);
                const float ya1 = a1 * ra * g1, ya2 = a2 * ra * g2, yb1 = b1 * rb * g1, yb2 = b2 * rb * g2;
                bf16* d = KB + ((size_t)b * NKEY + key) * 256;
                d[lane] = (bf16)f2bf(ya1 * cs - ya2 * sn); d[64 + lane] = (bf16)f2bf(ya1 * sn + ya2 * cs);
                d[A_DH + lane] = (bf16)f2bf(yb1 * cs - yb2 * sn); d[A_DH + 64 + lane] = (bf16)f2bf(yb1 * sn + yb2 * cs);
            } }
    }
}
__device__ __forceinline__ void prep_c(Frame& F, int gw, int NGW) {
    const int lane = F.lane;
    const bf16* QKV = (const bf16*)(F.ws + WS_R + R_QKV);
    bf16* KB = (bf16*)(F.ws + WS_R + R_KB);
    const float* CSC = (const float*)(F.ws + WS_CSC);
    const int i = lane & 31, hsel = lane >> 5;
    for (int r0 = gw; r0 < MT; r0 += 9 * NGW) {
        bf16 n[9][2]; float2 cv[9];
#pragma unroll
        for (int k = 0; k < 9; ++k) { const int rr = r0 + k * NGW, r = rr < MT ? rr : MT - 1;
            const bf16* s_ = QKV + (size_t)r * C_COLS + C_HEADS * C_DH + hsel * C_DH; n[k][0] = s_[i]; n[k][1] = s_[32 + i];
            const int t = r % SEQ; const float2 tv = *(const float2*)(CSC + ((i < 16 ? t / GRID_W : t % GRID_W) * 16 + (i & 15)) * 2); cv[k] = r < MLAT ? tv : make_float2(1.f, 0.f); }
#pragma unroll
        for (int k = 0; k < 9; ++k) { const int r = r0 + k * NGW;
            if (r < MT) {
                const bool lat = r < MLAT; const int b = lat ? r / SEQ : (r - MLAT) / CTXL, t = lat ? r % SEQ : (r - MLAT) % CTXL, key = lat ? CTXL + t : t;
                const float cs = cv[k].x, sn = cv[k].y;
                const float x1 = bf2f(n[k][0]), x2 = bf2f(n[k][1]);
                bf16* d = KB + ((size_t)b * NKEY + key) * 128 + hsel * C_DH;
                d[i] = (bf16)f2bf(x1 * cs - x2 * sn); d[32 + i] = (bf16)f2bf(x1 * sn + x2 * cs);
            } }
    }
}

__device__ __forceinline__ void attn_a_phase(Frame& F, bool with_ctx, int j) {
    const bf16* QKV = (const bf16*)(F.ws + WS_R + R_QKV); const bf16* KB = (const bf16*)(F.ws + WS_R + R_KB);
    bf16* OP = (bf16*)(F.ws + WS_U);
    const float* qg = F.inp(I_AQG) + j * A_DH; const float* CSA = (const float*)(F.ws + WS_CSA);
    const int ntotal = 512 + (with_ctx ? 32 : 0);
    const bool g256 = F.G == 256;
    for (int i = 0;; ++i) {
        int U;
        if (g256) { if (i >= 3) break; U = i < 2 ? 2 * F.vcu + i : 512 + F.vcu; if (U >= ntotal) break; }
        else { U = F.vcu + i * F.G; if (U >= ntotal) break; }
        int tid_u = F.tid; asm volatile("" : "+v"(tid_u));
        int b, kvh, seq, h, qrow, t_first; const float* cs;
        if (U < 512) { const int pair = U >> 6, g = (U & 63) >> 4, qb = U & 15; b = pair >> 1; kvh = pair & 1; h = kvh * 4 + g; qrow = b * SEQ + qb * 256; seq = NKEY; cs = CSA; t_first = qb * 256; }
        else { const int c = U - 512; b = c >> 3; h = c & 7; kvh = h >> 2; qrow = MLAT + b * CTXL; seq = CTXL; cs = nullptr; t_first = 0; }
        aa::attn_dense_body(QKV + (size_t)qrow * A_COLS + h * A_DH, KB + (size_t)b * NKEY * 256 + kvh * A_DH, QKV + (A_HEADS + A_KV) * A_DH + kvh * A_DH, MLAT + b * CTXL, b * SEQ, OP + (size_t)qrow * DM + h * A_DH, seq, (char*)F.ldsg, tid_u, qg, cs, t_first);
    }
}

__device__ __forceinline__ void attn_c_phase(Frame& F, bool with_ctx) {
    const bf16* QKV = (const bf16*)(F.ws + WS_R + R_QKV); const bf16* KB = (const bf16*)(F.ws + WS_R + R_KB);
    bf16* OP = (bf16*)(F.ws + WS_U);
    const float* sink = F.inp(I_CSINK); const float* CSC = (const float*)(F.ws + WS_CSC);
    const int ntotal = 1024 + (with_ctx ? 64 : 0);
    for (int U = F.vcu; U < ntotal; U += F.G) {
        int b, kvh, t0, qrow;
        if (U < 1024) { b = U >> 8; kvh = (U >> 7) & 1; const int qb = U & 127; t0 = qb * 32; qrow = b * SEQ + t0; }
        else { const int c = U - 1024; b = c >> 4; kvh = (c >> 3) & 1; const int qb = c & 7; t0 = -1; qrow = MLAT + b * CTXL + qb * 32; }
        const int h = kvh * 8 + F.wave;
        ac::unit(QKV + (size_t)qrow * C_COLS + h * C_DH, KB + (size_t)b * NKEY * 128 + kvh * C_DH, QKV + (C_HEADS + C_KV) * C_DH + kvh * C_DH, MLAT + b * CTXL, b * SEQ,
                 OP + (size_t)qrow * DM + h * C_DH, t0, sink[h] * 1.4426950408889634f, (char*)F.ldsg, F.tid, CSC);
    }
}

__device__ __forceinline__ float hy_dwconv(const bf16* u3, int r, int col, bool has_prev, bool has_next, const float* cw, const float* cb) {
    float a = cb[col] + cw[3 * DM + col] * bf2f(u3[(size_t)r * (3 * DM) + col]);
    if (has_prev) a += cw[col] * bf2f(u3[(size_t)(r - 1) * (3 * DM) + col]);
    if (has_next) a += cw[2 * 3 * DM + col] * bf2f(u3[(size_t)(r + 1) * (3 * DM) + col]);
    return a;
}
__device__ __forceinline__ void hy1t(Frame& F) {
    const int gw = F.vcu * NWAVES + F.wave, NGW = F.G * NWAVES, lane = F.lane;
    const bf16* u3 = (const bf16*)(F.ws + WS_R + R_QKV); float* VPT = (float*)(F.ws + WS_R + R_VPT);
    const float* cw = F.inp(I_BCW); const float* cb = F.inp(I_BCB);
    LAS float* tile = (LAS float*)(F.lds + F.wave * (64 * 65 * 4));
    constexpr int NA = BATCH * (SEQ / 64) * (DM / 64);
    const int hl = lane >> 5, c2 = lane & 31;
    for (int it = gw; it < NA; it += NGW) {
        const int dt = it % (DM / 64), tt = (it / (DM / 64)) % (SEQ / 64), b = it / ((DM / 64) * (SEQ / 64));
        const int d = dt * 64 + 2 * c2, ts = tt * 64 + 32 * hl, rs = b * SEQ + ts;
        const int c1 = DM + d, cv = 2 * DM + d;
        const float2 b1 = *(const float2*)(cb + c1), b2 = *(const float2*)(cb + cv);
        const float2 w10 = *(const float2*)(cw + c1), w11 = *(const float2*)(cw + 3 * DM + c1), w12 = *(const float2*)(cw + 6 * DM + c1);
        const float2 w20 = *(const float2*)(cw + cv), w21 = *(const float2*)(cw + 3 * DM + cv), w22 = *(const float2*)(cw + 6 * DM + cv);
        unsigned xr[34], vr[34];
#pragma unroll
        for (int i = 0; i < 34; ++i) { const int tq = ts - 1 + i; const bool ok = tq >= 0 && tq < SEQ; const size_t ro = (size_t)(ok ? rs - 1 + i : rs) * (3 * DM);
            const unsigned a = *(const unsigned*)(u3 + ro + c1), bq = *(const unsigned*)(u3 + ro + cv); xr[i] = ok ? a : 0u; vr[i] = ok ? bq : 0u; }
#pragma unroll
        for (int i = 0; i < 32; ++i) {
            const unsigned p1 = xr[i], q1 = xr[i + 1], n1 = xr[i + 2], p2 = vr[i], q2 = vr[i + 1], n2 = vr[i + 2];
            const float xa = b1.x + w10.x * bf2f(p1 & 0xffffu) + w11.x * bf2f(q1 & 0xffffu) + w12.x * bf2f(n1 & 0xffffu), xb = b1.y + w10.y * bf2f(p1 >> 16) + w11.y * bf2f(q1 >> 16) + w12.y * bf2f(n1 >> 16);
            const float va = b2.x + w20.x * bf2f(p2 & 0xffffu) + w21.x * bf2f(q2 & 0xffffu) + w22.x * bf2f(n2 & 0xffffu), vb = b2.y + w20.y * bf2f(p2 >> 16) + w21.y * bf2f(q2 >> 16) + w22.y * bf2f(n2 >> 16);
            tile[(32 * hl + i) * 65 + 2 * c2] = xa * va; tile[(32 * hl + i) * 65 + 2 * c2 + 1] = xb * vb;
        }
        LDS_WAIT(); asm volatile("" ::: "memory");
        float* dst = VPT + ((size_t)(b * DM + dt * 64)) * SEQ + tt * 64 + lane;
#pragma unroll 8
        for (int j = 0; j < 64; ++j) dst[(size_t)j * SEQ] = tile[lane * 65 + j];
        LDS_WAIT(); asm volatile("" ::: "memory");
    }
    float* VPC = (float*)(F.ws + WS_R + R_VPC);
    for (int q = F.vcu * NTHREADS + F.tid; q < (MCTX / 4) * (DM / 2); q += F.G * NTHREADS) {
        const int cp = q % (DM / 2), rc0 = (q / (DM / 2)) * 4, t0 = rc0 % CTXL, d = 2 * cp, r0 = MLAT + rc0;
        const int c1 = DM + d, cv = 2 * DM + d;
        unsigned xr[6], vr[6];
#pragma unroll
        for (int i = 0; i < 6; ++i) { const int tq = t0 - 1 + i; const bool ok = tq >= 0 && tq < CTXL; const size_t ro = (size_t)(ok ? r0 - 1 + i : r0) * (3 * DM);
            const unsigned a = *(const unsigned*)(u3 + ro + c1), bq = *(const unsigned*)(u3 + ro + cv); xr[i] = ok ? a : 0u; vr[i] = ok ? bq : 0u; }
        const float2 b1 = *(const float2*)(cb + c1), b2 = *(const float2*)(cb + cv);
        const float2 w10 = *(const float2*)(cw + c1), w11 = *(const float2*)(cw + 3 * DM + c1), w12 = *(const float2*)(cw + 6 * DM + c1);
        const float2 w20 = *(const float2*)(cw + cv), w21 = *(const float2*)(cw + 3 * DM + cv), w22 = *(const float2*)(cw + 6 * DM + cv);
#pragma unroll
        for (int k = 0; k < 4; ++k) {
            const unsigned p1 = xr[k], q1 = xr[k + 1], n1 = xr[k + 2], p2 = vr[k], q2 = vr[k + 1], n2 = vr[k + 2];
            const float xa = b1.x + w10.x * bf2f(p1 & 0xffffu) + w11.x * bf2f(q1 & 0xffffu) + w12.x * bf2f(n1 & 0xffffu), xb = b1.y + w10.y * bf2f(p1 >> 16) + w11.y * bf2f(q1 >> 16) + w12.y * bf2f(n1 >> 16);
            const float va = b2.x + w20.x * bf2f(p2 & 0xffffu) + w21.x * bf2f(q2 & 0xffffu) + w22.x * bf2f(n2 & 0xffffu), vb = b2.y + w20.y * bf2f(p2 >> 16) + w21.y * bf2f(q2 >> 16) + w22.y * bf2f(n2 >> 16);
            *(float2*)(VPC + (size_t)(rc0 + k) * DM + d) = make_float2(xa * va, xb * vb);
        }
    }
}
__device__ __forceinline__ void hyconv_ctx(Frame& F) {
    const bf16* u3 = (const bf16*)(F.ws + WS_R + R_QKV); const float* VPC = (const float*)(F.ws + WS_R + R_VPC);
    bf16* OP = (bf16*)(F.ws + WS_U);
    const float* cw = F.inp(I_BCW); const float* cb = F.inp(I_BCB); const float* skip = F.inp(I_BSKIP);
    constexpr int L = CTXL, n_ctx = BATCH * (CTXL / 8) * DM;
    for (int q = F.vcu * NTHREADS + F.tid; q < n_ctx; q += F.G * NTHREADS) {
        const int d = q % DM, tb = (q / DM) % (L / 8), b = q / (DM * (L / 8));
        const int rbase = b * CTXL, t0 = tb * 8;
        const float* Hc = (const float*)(F.ws + WS_HCCTX) + d;
        const float* vp = VPC + (size_t)rbase * DM + d;
        float y[8];
#pragma unroll
        for (int k = 0; k < 8; ++k) y[k] = 0.f;
#pragma unroll 4
        for (int s0 = 0; s0 < L; s0 += 8) {
            const int base = t0 - s0 + L - 1 - 7;
            float f[15];
#pragma unroll
            for (int i = 0; i < 15; ++i) { const int idx = base + i; f[i] = (idx >= 0 && idx <= 2 * L - 2) ? Hc[(size_t)idx * DM] : 0.f; }
#pragma unroll
            for (int j = 0; j < 8; ++j) { const float v = vp[(size_t)(s0 + j) * DM];
#pragma unroll
                for (int k = 0; k < 8; ++k) y[k] += f[k - j + 7] * v; }
        }
        const float sk = skip[d];
#pragma unroll
        for (int k = 0; k < 8; ++k) { const int t = t0 + k, r = MLAT + rbase + t;
            const float x0 = hy_dwconv(u3, r, d, t > 0, t < L - 1, cw, cb);
            OP[(size_t)r * DM + d] = (bf16)f2bf((y[k] + sk * vp[(size_t)t * DM]) * x0); }
    }
}
__device__ __forceinline__ void hy3(Frame& F) {
    const int gw = F.vcu * NWAVES + F.wave, NGW = F.G * NWAVES, lane = F.lane;
    const bf16* u3 = (const bf16*)(F.ws + WS_R + R_QKV); const float* YT = (const float*)(F.ws + WS_R + R_VPT);
    bf16* OP = (bf16*)(F.ws + WS_U);
    const float* cw = F.inp(I_BCW); const float* cb = F.inp(I_BCB);
    LAS float* tile = (LAS float*)(F.lds + F.wave * (64 * 65 * 4));
    constexpr int NA = BATCH * (SEQ / 64) * (DM / 64);
    for (int it = gw; it < NA; it += NGW) {
        const int dt = it % (DM / 64), tt = (it / (DM / 64)) % (SEQ / 64), b = it / ((DM / 64) * (SEQ / 64));
        const int d = dt * 64 + lane, t0 = tt * 64, r0 = b * SEQ + t0;
        const float* src = YT + ((size_t)(b * DM + dt * 64)) * SEQ + t0 + lane;
        float yv[64]; bf16 xr[66];
#pragma unroll
        for (int j = 0; j < 64; ++j) yv[j] = src[(size_t)j * SEQ];
#pragma unroll
        for (int i = 0; i < 66; ++i) { const int tq = t0 - 1 + i; const bool ok = tq >= 0 && tq < SEQ; const bf16 a = u3[(size_t)(ok ? r0 - 1 + i : r0) * (3 * DM) + d]; xr[i] = ok ? a : (bf16)0; }
#pragma unroll
        for (int j = 0; j < 64; ++j) tile[j * 65 + lane] = yv[j];
        LDS_WAIT(); asm volatile("" ::: "memory");
        const float b0 = cb[d], w0 = cw[d], w1 = cw[3 * DM + d], w2 = cw[6 * DM + d];
#pragma unroll
        for (int i = 0; i < 64; ++i) {
            const float x0 = b0 + w0 * bf2f(xr[i]) + w1 * bf2f(xr[i + 1]) + w2 * bf2f(xr[i + 2]);
            OP[(size_t)(r0 + i) * DM + d] = (bf16)f2bf(tile[lane * 65 + i] * x0);
        }
        LDS_WAIT(); asm volatile("" ::: "memory");
    }
}

namespace hf {
typedef float cf __attribute__((ext_vector_type(2)));
__device__ __forceinline__ cf cmul(cf a, cf w) { return {a.x * w.x - a.y * w.y, a.x * w.y + a.y * w.x}; }
__device__ __forceinline__ cf cmulc(cf a, cf w) { return {a.x * w.x + a.y * w.y, a.y * w.x - a.x * w.y}; }
constexpr int PAD = 272;
__device__ __forceinline__ int lidx(int k1, int a, int b) { return k1 * PAD + a * 16 + ((b + a) & 15); }
template <int S> __device__ __forceinline__ void dft4(cf& a, cf& b, cf& c, cf& d) {
    const cf s0 = a + c, s1 = a - c, s2 = b + d, s3 = b - d;
    const cf j3 = S > 0 ? cf{-s3.y, s3.x} : cf{s3.y, -s3.x};
    a = s0 + s2; c = s0 - s2; b = s1 + j3; d = s1 - j3;
}
template <int S> __device__ __forceinline__ void dft16(cf (&x)[16]) {
#pragma unroll
    for (int nb = 0; nb < 4; ++nb) dft4<S>(x[nb], x[4 + nb], x[8 + nb], x[12 + nb]);
    const float c1 = 0.92387953251128674f, s1 = 0.38268343236508977f, r2 = 0.70710678118654752f, sg = (float)S;
    x[4 + 1] = cmul(x[4 + 1], cf{c1, sg * s1});  x[4 + 2] = cmul(x[4 + 2], cf{r2, sg * r2});   x[4 + 3] = cmul(x[4 + 3], cf{s1, sg * c1});
    x[8 + 1] = cmul(x[8 + 1], cf{r2, sg * r2});  x[8 + 2] = cmul(x[8 + 2], cf{0.f, sg});       x[8 + 3] = cmul(x[8 + 3], cf{-r2, sg * r2});
    x[12 + 1] = cmul(x[12 + 1], cf{s1, sg * c1}); x[12 + 2] = cmul(x[12 + 2], cf{-r2, sg * r2}); x[12 + 3] = cmul(x[12 + 3], cf{-c1, -sg * s1});
#pragma unroll
    for (int ka = 0; ka < 4; ++ka) dft4<S>(x[4 * ka], x[4 * ka + 1], x[4 * ka + 2], x[4 * ka + 3]);
}
#define HF_OUT(x, k) x[4 * ((k) & 3) + ((k) >> 2)]
__device__ __forceinline__ void fft_fwd(cf (&x)[16], LAS cf* D, const LAS cf* TW, int u) {
    asm volatile("" : "+v"(u));
    int hi4 = u >> 4, lo4 = u & 15;
    dft16<-1>(x);
#pragma unroll
    for (int k1 = 0; k1 < 16; ++k1) D[lidx(k1, hi4, lo4)] = cmul(HF_OUT(x, k1), TW[(16 * hi4 * k1) & 4095]);
    __syncthreads();
    asm volatile("" : "+v"(hi4), "+v"(lo4));
#pragma unroll
    for (int n2 = 0; n2 < 16; ++n2) x[n2] = D[lidx(hi4, n2, lo4)];
    dft16<-1>(x);
#pragma unroll
    for (int k2 = 0; k2 < 16; ++k2) D[lidx(hi4, k2, lo4)] = cmul(HF_OUT(x, k2), TW[lo4 * (hi4 + 16 * k2)]);
    __syncthreads();
    asm volatile("" : "+v"(hi4), "+v"(lo4));
#pragma unroll
    for (int n3 = 0; n3 < 16; ++n3) x[n3] = D[lidx(hi4, lo4, n3)];
    dft16<-1>(x);
}
__device__ __forceinline__ void fft_inv(cf (&x)[16], LAS cf* D, const LAS cf* TW, int u) {
    asm volatile("" : "+v"(u));
    int hi4 = u >> 4, lo4 = u & 15;
    dft16<1>(x);
#pragma unroll
    for (int n3 = 0; n3 < 16; ++n3) D[lidx(hi4, lo4, n3)] = cmulc(HF_OUT(x, n3), TW[n3 * (hi4 + 16 * lo4)]);
    __syncthreads();
    asm volatile("" : "+v"(hi4), "+v"(lo4));
#pragma unroll
    for (int k2 = 0; k2 < 16; ++k2) x[k2] = D[lidx(hi4, k2, lo4)];
    dft16<1>(x);
#pragma unroll
    for (int n2 = 0; n2 < 16; ++n2) D[lidx(hi4, n2, lo4)] = cmulc(HF_OUT(x, n2), TW[(16 * n2 * hi4) & 4095]);
    __syncthreads();
    asm volatile("" : "+v"(hi4), "+v"(lo4));
#pragma unroll
    for (int k1 = 0; k1 < 16; ++k1) x[k1] = D[lidx(k1, hi4, lo4)];
    dft16<1>(x);
}
}
__device__ __forceinline__ void hyfft(Frame& F) {
    using namespace hf;
    const int tid = F.tid, half = F.wave >> 2, u_ = tid & 255;
    LAS cf* D = (LAS cf*)F.lds + half * (16 * PAD);
    LAS cf* TW = (LAS cf*)(F.lds + 2 * 16 * PAD * 8);
    LAS cf* COMB = (LAS cf*)(F.lds + 2 * 16 * PAD * 8 + 32768);
    for (int m = tid; m < 4096; m += NTHREADS) { const float a = (float)m * (1.0f / 2048.0f); TW[m] = cf{cospif(a), -sinpif(a)}; }
    cf w8u; { const float a = (float)u_ * (1.0f / 4096.0f); w8u = cf{cospif(a), -sinpif(a)}; }
    __syncthreads();
    const float* HF = (const float*)(F.ws + WS_HCLAT); float* VPT = (float*)(F.ws + WS_R + R_VPT);
    const float* skip = F.inp(I_BSKIP);
    float pb[32];
#define HF_LOAD_FILT(ch_) do { const float* hf_ = HF + (size_t)(ch_) * SEQ; const float* hb_ = HF + (size_t)DM * SEQ + (size_t)(ch_) * SEQ;     \
        _Pragma("unroll") for (int n1 = 0; n1 < 16; ++n1) { const int n = 256 * n1 + u_; pb[n1] = hf_[n]; pb[16 + n1] = hb_[n == 0 ? 0 : SEQ - n]; } } while (0)
#define HF_LOAD_PAIR(ch_, pr_) do { const float* a0_ = VPT + ((size_t)((2 * (pr_)) * DM + (ch_))) * SEQ; const float* a1_ = VPT + ((size_t)((2 * (pr_) + 1) * DM + (ch_))) * SEQ; \
        _Pragma("unroll") for (int n1 = 0; n1 < 16; ++n1) { const int n = 256 * n1 + u_; pb[2 * n1] = a0_[n]; pb[2 * n1 + 1] = a1_[n]; } } while (0)
    if (F.vcu < DM) HF_LOAD_FILT(F.vcu);
    for (int ch = F.vcu; ch < DM; ch += F.G) {
        int u = u_; asm volatile("" : "+v"(u));
        cf Fs[16];
        {
            cf x[16];
            const float sk = skip[ch];
#pragma unroll
            for (int n1 = 0; n1 < 16; ++n1) { const int n = 256 * n1 + u;
                float fa = pb[n1]; if (n == 0) fa += sk;
                const float fb = n == 0 ? 0.f : pb[16 + n1];
                if (half == 0) x[n1] = cf{fa + fb, 0.f};
                else { const cf w = cmul(w8u, TW[128 * n1]); const float dd = fa - fb; x[n1] = cf{dd * w.x, dd * w.y}; } }
            HF_LOAD_PAIR(ch, 0);
            fft_fwd(x, D, TW, u);
#pragma unroll
            for (int k3 = 0; k3 < 16; ++k3) { const cf v = HF_OUT(x, k3); Fs[k3] = cf{v.x * (1.0f / 8192.0f), v.y * (1.0f / 8192.0f)}; }
        }
#pragma unroll
        for (int pr = 0; pr < 2; ++pr) {
            __syncthreads();
            asm volatile("" : "+v"(u));
            float* v0 = VPT + ((size_t)((2 * pr) * DM + ch)) * SEQ; float* v1 = VPT + ((size_t)((2 * pr + 1) * DM + ch)) * SEQ;
            cf x[16];
#pragma unroll
            for (int n1 = 0; n1 < 16; ++n1) { const cf z = cf{pb[2 * n1], pb[2 * n1 + 1]};
                x[n1] = half == 0 ? z : cmul(z, cmul(w8u, TW[128 * n1])); }
            if (pr == 0) HF_LOAD_PAIR(ch, 1);
            else if (ch + F.G < DM) HF_LOAD_FILT(ch + F.G);
            fft_fwd(x, D, TW, u);
            cf w[16];
#pragma unroll
            for (int k3 = 0; k3 < 16; ++k3) w[k3] = cmul(HF_OUT(x, k3), Fs[k3]);
            fft_inv(w, D, TW, u);
            if (half == 1) {
#pragma unroll
                for (int n1 = 0; n1 < 16; ++n1) COMB[256 * n1 + u] = cmulc(HF_OUT(w, n1), cmul(w8u, TW[128 * n1]));
            }
            __syncthreads();
            if (half == 0) {
#pragma unroll
                for (int n1 = 0; n1 < 16; ++n1) { const int n = 256 * n1 + u; const cf y = HF_OUT(w, n1) + COMB[n]; v0[n] = y.x; v1[n] = y.y; }
            }
        }
        __syncthreads();
    }
#undef HF_LOAD_FILT
#undef HF_LOAD_PAIR
}

constexpr int N_PHASES = 2 + 8 * DEPTH + 1;
__global__ void __launch_bounds__(NTHREADS, 2) fwd_kernel(Args args) {
    extern __shared__ __attribute__((aligned(16))) unsigned char lds[];
    Frame F;
    F.lds = (LAS unsigned char*)lds; F.ldsg = lds;
    F.MISC = (volatile LAS unsigned*)(F.lds + MISC_OFF);
    int wave_s = __builtin_amdgcn_readfirstlane(threadIdx.x >> 6);
    F.tid = threadIdx.x; F.lane = F.tid & 63; F.wave = wave_s;
    F.G = gridDim.x; { const int bx = blockIdx.x; F.vcu = (F.G % 8 == 0) ? (bx % 8) * (F.G / 8) + bx / 8 : bx; }
    F.out = args.out; F.ws = args.ws; F.ctl = (gu32*)(args.ws + WS_CTL);
    F.intab = (LAS unsigned long long*)(F.lds + INTAB_OFF);
    for (int u = F.tid; u < 64; u += NTHREADS) ((LAS unsigned*)(F.lds + MISC_OFF))[u] = 0u;
    if (F.tid < N_IN) F.intab[F.tid] = (unsigned long long)args.in[F.tid];
    __syncthreads();
    XcdBarrier bar; bar.bar = (unsigned*)(F.ctl + CW_BAR); bar.x = 0; bar.st = nullptr;
    if (args.single) bar = xcd_barrier_post((unsigned*)(F.ctl + CW_BAR), F.MISC + 8, F.tid);

#ifndef DUP_STAGE
#define DUP_STAGE -1
#endif
#ifndef FUSE_RES
#define FUSE_RES 0
#endif
#define FUSE_SETUP(GRES, GATE, DONORM, LN, GN, SH, SC, HIN, BANK) do { if (FUSE_RES && F.G == 256) { const float* NG_ = F.inp(I_NORMG); const float* MOD_ = (const float*)(F.ws + WS_MOD); \
        E.fuse = 1; split_first = 1; E.do_norm = (DONORM); E.h_in = (HIN); E.h_out = F.out; E.Uo = (bf16*)(F.ws + WS_U); \
        E.g_res = NG_ + (size_t)(layer * 4 + (GRES)) * DM; E.mod_res = MOD_ + (size_t)(layer * 4) * (NMOD * DM); E.gate_idx = (GATE); \
        E.g_n = NG_ + (size_t)(((LN) < DEPTH ? (LN) : 0) * 4 + (GN)) * DM; E.mod_n = MOD_ + (size_t)(((LN) < DEPTH ? (LN) : 0) * 4) * (NMOD * DM); E.shift_idx = (SH); E.scale_idx = (SC); \
        const int bank_ = layer * 4 + (BANK); unsigned* ctlw_ = (unsigned*)(F.ws + WS_CTL); \
        E.st1.xbuf = (unsigned*)(F.ws + WS_R + R_XBUF + (size_t)bank_ * 524288); E.st1.cnt = ctlw_ + CW_SEAM + bank_ * 4096; E.st1.tmo = ctlw_; E.st1.eps = EPS; \
        E.st2.xbuf = (unsigned*)(F.ws + WS_R + R_XBUF + (size_t)(bank_ + 1) * 524288); E.st2.cnt = ctlw_ + CW_SEAM + (bank_ + 1) * 4096; E.st2.tmo = ctlw_; E.st2.eps = EPS; } } while (0)
    for (int pp = args.ph_lo * 2; pp < args.ph_hi * 2; ++pp) {
        const int p = pp >> 1;
        if (pp & 1) {
            if (DUP_STAGE < 0) continue;
            int s_ = -1; if (p == 0) s_ = 100; else if (p >= 2) { int i; if (p < 10) i = p - 2; else if (p < 19) { i = p - 10; if (i == 2) i = -100; else if (i == 3) i = 90; else if (i > 3) i -= 1; } else if (p < 27) i = p - 19; else i = p - 27;
                if (i == 90) s_ = 9; else if (i >= 0) s_ = i < 6 ? i : i + 1; }
#ifndef DUP_LAYER
#define DUP_LAYER -1
#endif
            if (s_ != DUP_STAGE) continue;
            if (DUP_LAYER >= 0 && (p < 10 ? 0 : p < 19 ? 1 : p < 27 ? 2 : 3) != DUP_LAYER) continue;
        }
        if (gridDim.x == 256 && (p == 3 || p == 20 || p == 28)) continue;
#ifndef BAR_REP
#define BAR_REP 1
#endif
        if (pp != args.ph_lo * 2) { for (int br_ = 0; br_ < BAR_REP; ++br_) { asm volatile("" : "+s"(bar.bar), "+s"(bar.x)); xcd_barrier(bar, wave_s * 64 + pg8::fresh_lane()); } }
        { GAS unsigned char* ws_ = (GAS unsigned char*)args.ws; GAS float* out_ = (GAS float*)args.out; asm volatile("" : "+s"(ws_), "+s"(out_)); F.ws = (unsigned char*)ws_; F.out = (float*)out_;
          int G_ = gridDim.x, bx_ = blockIdx.x; asm volatile("" : "+s"(wave_s), "+s"(G_), "+s"(bx_));
          LAS unsigned char* l_ = (LAS unsigned char*)lds; asm volatile("" : "+s"(l_)); F.lds = l_; F.ldsg = (unsigned char*)l_;
          F.MISC = (volatile LAS unsigned*)(l_ + MISC_OFF); F.intab = (LAS unsigned long long*)(l_ + INTAB_OFF);
          F.wave = wave_s; F.G = G_; F.bx = bx_; F.vcu = (G_ % 8 == 0) ? (bx_ % 8) * (G_ / 8) + bx_ / 8 : bx_; }
#define SET_TID() do { F.lane = pg8::fresh_lane(); __builtin_assume(F.lane >= 0 && F.lane < 64); __builtin_assume(F.wave >= 0 && F.wave < NWAVES); F.tid = F.wave * 64 + F.lane; } while (0)
        if (p == 0) { SET_TID(); p0_prologue(F); }
        else if (p == 1) { SET_TID(); row_phase(F, 0, MT, nullptr, 0, 0, 0, true, 0, 0, 0, 1, nullptr, 0, true); }
        else {
            int layer, s;
            if (p < 10) { layer = 0; const int i = p - 2; s = i < 6 ? i : i + 1; }
            else if (p < 19) { layer = 1; const int i = p - 10; if (i < 3) s = i; else if (i == 3) s = 9; else { const int jj = i - 1; s = jj < 6 ? jj : jj + 1; } }
            else if (p < 27) { layer = 2; const int i = p - 19; s = i < 6 ? i : i + 1; }
            else { layer = 3; const int i = p - 27; s = i < 6 ? i : i + 1; }
            const int kind = layer % 3, j = layer / 3;
            const bool need_ctx = layer < DEPTH - 1;
            const int nrows = need_ctx ? MT : MLAT;
            if (s == 0 || s == 3 || s == 5 || s == 7) {
                pg8::Gemm g; pg8::EpiBf16Slab E; E.slab = nullptr; int SK = 0; g.rowstep = 256; E.act = 0; E.cw = nullptr; E.cb = nullptr; E.ex = (LAS float*)(F.lds + 131072); E.nrows = nrows; E.fuse = 0; int split_first = 0;
                if (s == 0) {
                    g.A = (const bf16*)(F.ws + WS_U); g.lda = DM; g.K = DM; g.M = MT;
                    E.O = (bf16*)(F.ws + WS_R + R_QKV);
                    if (kind == 0)      { g.Bt = (const bf16*)(F.ws + WS_W_AQKV) + (size_t)j * A_COLS * DM; g.N = A_COLS; E.bias = nullptr; }
                    else if (kind == 1) { g.Bt = (const bf16*)(F.ws + WS_W_BIN); g.N = 3 * DM; E.bias = F.inp(I_BBIN); if (!need_ctx) g.M = MLAT; }
                    else                { g.Bt = (const bf16*)(F.ws + WS_W_CQKV); g.N = C_COLS; E.bias = F.inp(I_CBQKV); }
                    E.ldc = g.N;
                } else if (s == 3) {
                    g.A = (const bf16*)(F.ws + WS_U); g.lda = DM; g.K = DM; g.M = nrows; g.N = DM;
                    if (kind == 0)      { g.Bt = (const bf16*)(F.ws + WS_W_AOUT) + (size_t)j * DM * DM; E.bias = nullptr; }
                    else if (kind == 1) { g.Bt = (const bf16*)(F.ws + WS_W_BOUT); E.bias = F.inp(I_BBOUT); }
                    else                { g.Bt = (const bf16*)(F.ws + WS_W_COUT); E.bias = F.inp(I_CBOUT); }
                    E.O = (bf16*)(F.ws + WS_R + R_O); E.ldc = DM; if (need_ctx) { SK = SK_OUT; E.slab = (float*)(F.ws + WS_R + R_SLAB); }
                    FUSE_SETUP(1, 2, 1, layer, 2, 3, 4, layer == 0 ? F.inp(I_X) : (const float*)F.out, 0);
                } else if (s == 5) {
                    g.A = (const bf16*)(F.ws + WS_U) - DM; g.lda = DM; g.K = DM; g.rowstep = 254; g.M = ((nrows + 253) / 254) * 256; g.N = 2 * DFF;
                    g.Bt = (const bf16*)(F.ws + WS_W_UP) + (size_t)layer * 2 * DFF * DM; E.bias = nullptr;
                    E.O = (bf16*)(F.ws + WS_R + R_G); E.ldc = DFF; E.act = 1; E.cw = F.inp(I_FCW) + (size_t)layer * 3 * DFF; E.cb = F.inp(I_FCB) + (size_t)layer * DFF;
                } else {
                    g.A = (const bf16*)(F.ws + WS_R + R_G); g.lda = DFF; g.K = DFF; g.M = nrows; g.N = DM;
                    g.Bt = (const bf16*)(F.ws + WS_W_DOWN) + (size_t)layer * DM * DFF; E.bias = nullptr;
                    E.O = (bf16*)(F.ws + WS_U); E.ldc = DM; if (need_ctx) { SK = SK_DOWN; E.slab = (float*)(F.ws + WS_R + R_SLAB2); }
                    FUSE_SETUP(3, 5, layer + 1 < DEPTH, layer + 1, 0, 0, 1, (const float*)F.out, 2);
                }
                const bool handoff = s == 0 && kind != 1 && F.G == 256;
                E.sig = handoff ? (unsigned*)(F.ctl + CW_SEAM + 64 * layer) : nullptr;
                pg8::Order2 S; S.init(g.M, g.N, F.G, F.bx, g.K, SK, split_first, handoff ? 1 : 0);
                pg8::gemm_phase<pg8::EpiBf16Slab, pg8::Order2, true, true>(F.lds, g, S, E, F.wave);
                if (s == 0 && F.G == 256) {
                    const int nwg = (g.M / 256) * (g.N / 256), first_idle = nwg % 256;
                    if (F.bx >= first_idle) { SET_TID(); tail_work(F, layer, first_idle); }
                }
            } else if (s == 1) {
                SET_TID();
                if (kind == 0) prep_a(F, j, F.vcu * NWAVES + F.wave, F.G * NWAVES); else if (kind == 1) hy1t(F); else prep_c(F, F.vcu * NWAVES + F.wave, F.G * NWAVES);
            } else if (s == 2) {
                SET_TID();
                if (kind == 0) attn_a_phase(F, need_ctx, j); else if (kind == 1) { hyfft(F); hyconv_ctx(F); } else attn_c_phase(F, need_ctx);
            } else if (s == 9) {
                SET_TID(); hy3(F);
            } else if (s == 4) {
                SET_TID();
                row_phase(F, 0, nrows, (const bf16*)(F.ws + WS_R + R_O), layer, 1, 2, true, layer, 2, 3, 4, (const float*)(F.ws + WS_R + R_SLAB), need_ctx ? SK_OUT : 0, layer == 0);
            } else {
                SET_TID();
                const bool more = layer + 1 < DEPTH;
                row_phase(F, 0, nrows, (const bf16*)(F.ws + WS_U), layer, 3, 5, more, layer + 1, 0, 0, 1, (const float*)(F.ws + WS_R + R_SLAB2), need_ctx ? SK_DOWN : 0, false, !more);
            }
        }
    }
}

#ifndef SINGLE_LAUNCH
#define SINGLE_LAUNCH 1
#endif
extern "C" void kernel_launch(void* const* d_in, const int* in_sizes, int n_in, void* d_out, int out_size, void* d_ws, size_t ws_size, hipStream_t stream) {
    static int grid = 0;
    if (grid == 0) {
        if (n_in != N_IN || out_size != MLAT * DM || ws_size < WS_END) { fprintf(stderr, "kernel_launch: unexpected shapes: n_in %d out %d ws %zu (need %zu)\n", n_in, out_size, ws_size, (size_t)WS_END); grid = -1; return; }
        int dev = 0, cus = 0;
        if (hipGetDevice(&dev) != hipSuccess || hipDeviceGetAttribute(&cus, hipDeviceAttributeMultiprocessorCount, dev) != hipSuccess) { grid = -1; return; }
        if (hipFuncSetAttribute((const void*)fwd_kernel, hipFuncAttributeMaxDynamicSharedMemorySize, LDS_BYTES) != hipSuccess) { fprintf(stderr, "kernel_launch: hipFuncSetAttribute failed\n"); grid = -1; return; }
        int per_cu = 0;
        if (hipOccupancyMaxActiveBlocksPerMultiprocessor(&per_cu, (const void*)fwd_kernel, NTHREADS, LDS_BYTES) != hipSuccess || per_cu < 1) fprintf(stderr, "kernel_launch: occupancy query reports %d\n", per_cu);
        (void)hipGetLastError();
        grid = cus;
    }
    if (grid < 0) return;
    if (hipMemsetAsync((char*)d_ws + WS_CTL, 0, CTL_ZERO_BYTES, stream) != hipSuccess) return;
    Args a{};
    for (int i = 0; i < N_IN; ++i) a.in[i] = (const float*)d_in[i];
    a.out = (float*)d_out; a.ws = (unsigned char*)d_ws;
#if SINGLE_LAUNCH
    a.ph_lo = 0; a.ph_hi = N_PHASES; a.single = 1;
    hipLaunchKernelGGL(fwd_kernel, dim3(grid), dim3(NTHREADS), LDS_BYTES, stream, a);
#else
    for (int p = 0; p < N_PHASES; ++p) { a.ph_lo = p; a.ph_hi = p + 1; a.single = 0;
        hipLaunchKernelGGL(fwd_kernel, dim3(grid), dim3(NTHREADS), LDS_BYTES, stream, a); }
#endif
    const hipError_t le = hipPeekAtLastError();
    if (le != hipSuccess) fprintf(stderr, "kernel_launch: launch failed: %s\n", hipGetErrorName(le));
}
```

```cpp
#include <hip/hip_runtime.h>
#include <cstdio>
#include <cstdint>
#include <cmath>
namespace pg8 {
#define PG8_LAS __attribute__((address_space(3)))
typedef unsigned short bf16_t;
typedef short bf16x8 __attribute__((ext_vector_type(8)));
typedef float f32x4 __attribute__((ext_vector_type(4)));
typedef unsigned u32x4 __attribute__((ext_vector_type(4)));
constexpr int BM = 256, BK = 64, HALF = 128, HTB = HALF * BK * 2  , STAGE_BYTES = 8 * HTB, NXCD = 8, WGM = 8;

__host__ __device__ __forceinline__ int lds_byte(int r, int c) { const int st = (r >> 4) * 2 + (c >> 5), rr = r & 15, cc = c & 31, ob = rr * 64 + cc * 2; return st * 1024 + (ob ^ (((ob >> 9) & 1) << 5)); }
__host__ __device__ __forceinline__ void stage_rc(int b, int& R, int& C) { const int st = b / 1024, sb = b % 1024, swz = sb ^ (((sb >> 9) & 1) << 5); R = (st >> 1) * 16 + swz / 64; C = (st & 1) * 32 + (swz % 64) / 2; }
__host__ __device__ __forceinline__ int perm32(int rho) { const int n = rho >> 4, i = rho & 15; return 8 * (i >> 2) + 4 * n + (i & 3); }

struct Unit { int pm, pn, kt0, nt, split; };
struct Gemm { const bf16_t* A; const bf16_t* Bt; int M, N, K, lda, rowstep; };

struct StaticOrder {
    int nM, nN, nwg, G, c, ntK;
    __host__ __device__ __forceinline__ void init(int M, int N, int G_, int c_, int K_) { nM = M / BM; nN = N / BM; nwg = nM * nN; G = G_; c = c_; ntK = K_ / BK; }
    __host__ __device__ __forceinline__ bool next(int i, Unit& u) const {
        const long L = (long)i * G + c; if (L >= nwg) return false;
        u.kt0 = 0; u.nt = ntK; u.split = -1;
        int wgid = (int)L; { const int q = nwg / NXCD, r = nwg % NXCD, xcd = wgid % NXCD, off = wgid / NXCD; wgid = (xcd < r ? xcd * (q + 1) : r * (q + 1) + (xcd - r) * q) + off; }
        const int nig = WGM * nN, gid = wgid / nig, fm = gid * WGM, gsz = (nM - fm) < WGM ? (nM - fm) : WGM;
        u.pm = fm + ((wgid % nig) % gsz); u.pn = (wgid % nig) / gsz; return true;
    }
    __device__ __forceinline__ void a_ready(const Unit&) const {}
    __device__ __forceinline__ void done(const Unit&) const {}
};

__device__ __forceinline__ unsigned cvt_pk_bf16(float lo, float hi) { unsigned r; asm volatile("v_cvt_pk_bf16_f32 %0, %1, %2" : "=v"(r) : "v"(lo), "v"(hi)); return r; }
__device__ __forceinline__ int fresh_lane() { unsigned m = ~0u; asm volatile("" : "+s"(m)); return (int)__builtin_amdgcn_mbcnt_hi(m, __builtin_amdgcn_mbcnt_lo(m, 0u)); }
struct EpiBf16 {
    static constexpr bool PERM = true, AFTER_DRAIN = false;
    bf16_t* O; int ldc; const float* bias;
    __device__ __forceinline__ void operator()(const f32x4 (&acc)[2][2][4][2], const Unit& u, int wr, int wc, int fr, int fq) const {
        const int row0 = u.pm * BM + wr * 64 + fr; const int col0 = u.pn * BM + wc * 32 + 8 * fq;
        f32x4 bv[2][2];
#pragma unroll
        for (int bj = 0; bj < 2; ++bj)
#pragma unroll
            for (int n = 0; n < 2; ++n) bv[bj][n] = bias ? *(const f32x4*)(bias + col0 + bj * HALF + 4 * n) : (f32x4){0.f, 0.f, 0.f, 0.f};
#pragma unroll
        for (int ai = 0; ai < 2; ++ai)
#pragma unroll
            for (int m = 0; m < 4; ++m) { bf16_t* rowp = O + (size_t)(row0 + ai * HALF + m * 16) * ldc + col0;
#pragma unroll
                for (int bj = 0; bj < 2; ++bj) { const f32x4 v0 = acc[ai][bj][m][0] + bv[bj][0], v1 = acc[ai][bj][m][1] + bv[bj][1];
                    u32x4 w; w.x = cvt_pk_bf16(v0[0], v0[1]); w.y = cvt_pk_bf16(v0[2], v0[3]); w.z = cvt_pk_bf16(v1[0], v1[1]); w.w = cvt_pk_bf16(v1[2], v1[3]);
                    *(u32x4*)(rowp + bj * HALF) = w; } }
    }
};

struct RowStats {
    unsigned* xbuf;
    unsigned* cnt;
    unsigned* tmo;
    float eps;
    __device__ __forceinline__ bool run(const f32x4 (&v)[2][2][4][2], const Unit& u, int wr, int wc, int fr, int fq, PG8_LAS unsigned char* lds, int wid, int lane) const {
        PG8_LAS float* P = (PG8_LAS float*)lds;
        PG8_LAS float* S = (PG8_LAS float*)(lds + 8192);
        PG8_LAS unsigned* flag = (PG8_LAS unsigned*)(lds + 8192 + 2048);
#pragma unroll
        for (int ai = 0; ai < 2; ++ai)
#pragma unroll
            for (int m = 0; m < 4; ++m) {
                float s = 0.f;
#pragma unroll
                for (int bj = 0; bj < 2; ++bj)
#pragma unroll
                    for (int n = 0; n < 2; ++n) { const f32x4 x = v[ai][bj][m][n]; s += (x[0] * x[0] + x[1] * x[1]) + (x[2] * x[2] + x[3] * x[3]); }
                s += __int_as_float(__builtin_amdgcn_ds_swizzle(__float_as_int(s), (16 << 10) | 0x1f));
                { const auto rr = __builtin_amdgcn_permlane32_swap(__float_as_uint(s), __float_as_uint(s), false, false); s = __uint_as_float(rr[0]) + __uint_as_float(rr[1]); }
                if (fq == 0) P[(ai * HALF + wr * 64 + m * 16 + fr) * 4 + wc] = s;
            }
        asm volatile("s_waitcnt lgkmcnt(0)" ::: "memory"); __builtin_amdgcn_s_barrier(); asm volatile("" ::: "memory");
        const int row = wid * 32 + (lane & 31);
        if (lane < 32) {
            const float t = (P[row * 4 + 0] + P[row * 4 + 1]) + (P[row * 4 + 2] + P[row * 4 + 3]);
            unsigned long long* slot = (unsigned long long*)xbuf + ((size_t)(u.pm * BM + row) * 4 + u.pn);
            __hip_atomic_store(slot, (unsigned long long)__float_as_uint(t), __ATOMIC_RELAXED, __HIP_MEMORY_SCOPE_AGENT);
        }
        asm volatile("s_waitcnt vmcnt(0)" ::: "memory");
        if (lane == 0) __hip_atomic_fetch_add(cnt + 64 * u.pm, 1u, __ATOMIC_RELAXED, __HIP_MEMORY_SCOPE_AGENT);
        if (wid == 0) {
            bool dead = false; const unsigned long long t0 = __builtin_amdgcn_s_memrealtime(); const unsigned want = 32u;
            for (;;) {
                if ((unsigned)__builtin_amdgcn_readfirstlane(__hip_atomic_load(cnt + 64 * u.pm, __ATOMIC_RELAXED, __HIP_MEMORY_SCOPE_AGENT)) >= want) break;
                if (__builtin_amdgcn_s_memrealtime() - t0 > 2000000ull) { if (lane == 0) __hip_atomic_store(tmo, 1u, __ATOMIC_RELAXED, __HIP_MEMORY_SCOPE_AGENT); dead = true; break; }
                __builtin_amdgcn_s_sleep(2);
            }
            __builtin_amdgcn_fence(__ATOMIC_ACQUIRE, "agent");
            if (lane == 0) flag[0] = dead ? 1u : 0u;
        }
        asm volatile("s_waitcnt vmcnt(0) lgkmcnt(0)" ::: "memory"); __builtin_amdgcn_s_barrier(); asm volatile("" ::: "memory");
        const bool bad = flag[0] != 0u;
        if (lane < 32) {
            const unsigned long long* slot = (const unsigned long long*)xbuf + (size_t)(u.pm * BM + row) * 4; float tot = 0.f;
#pragma unroll
            for (int t = 0; t < 4; ++t) tot += __uint_as_float((unsigned)__hip_atomic_load(slot + t, __ATOMIC_RELAXED, __HIP_MEMORY_SCOPE_AGENT));
            S[row] = 1.0f / sqrtf(tot * (1.0f / 1024.0f) + eps);
        }
        asm volatile("s_waitcnt lgkmcnt(0)" ::: "memory"); __builtin_amdgcn_s_barrier(); asm volatile("" ::: "memory");
        return bad;
    }
};
struct EpiBf16Slab {
    static constexpr bool PERM = true, AFTER_DRAIN = false;
    bf16_t* O; int ldc; const float* bias; float* slab;
    int act; const float* cw; const float* cb; PG8_LAS float* ex; int nrows;
    int fuse, do_norm; const float* h_in; float* h_out; bf16_t* Uo; const float* g_res; const float* g_n; const float* mod_res; const float* mod_n; int gate_idx, shift_idx, scale_idx; RowStats st1, st2;
    __device__ __forceinline__ void fused(f32x4 (&acc)[2][2][4][2], const Unit& u, int wr, int wc, int fr, int fq, PG8_LAS unsigned char* lds, int wid, int lane) const {
        const PG8_LAS float* S = (const PG8_LAS float*)(lds + 8192);
        const int col0 = u.pn * BM + wc * 32 + 8 * fq, b = u.pm >> 4;
        const float qnan = __builtin_nanf("");
#pragma unroll
        for (int bj = 0; bj < 2; ++bj)
#pragma unroll
            for (int n = 0; n < 2; ++n) { const f32x4 bv = bias ? *(const f32x4*)(bias + col0 + bj * HALF + 4 * n) : (f32x4){0.f, 0.f, 0.f, 0.f};
#pragma unroll
                for (int ai = 0; ai < 2; ++ai)
#pragma unroll
                    for (int m = 0; m < 4; ++m) acc[ai][bj][m][n] += bv; }
        bool bad = st1.run(acc, u, wr, wc, fr, fq, lds, wid, lane);
        {
            const float* gt = mod_res + (size_t)b * 6144 + gate_idx * 1024;
            f32x4 gg[2][2], mm[2][2];
#pragma unroll
            for (int bj = 0; bj < 2; ++bj)
#pragma unroll
                for (int n = 0; n < 2; ++n) { gg[bj][n] = *(const f32x4*)(g_res + col0 + bj * HALF + 4 * n); mm[bj][n] = *(const f32x4*)(gt + col0 + bj * HALF + 4 * n); gg[bj][n] = gg[bj][n] * mm[bj][n]; }
#pragma unroll
            for (int ai = 0; ai < 2; ++ai)
#pragma unroll
                for (int m = 0; m < 4; ++m) { const int r = ai * HALF + wr * 64 + m * 16 + fr; const float rs = S[r]; const size_t off = (size_t)(u.pm * BM + r) * 1024 + col0;
#pragma unroll
                    for (int bj = 0; bj < 2; ++bj)
#pragma unroll
                        for (int n = 0; n < 2; ++n) { const f32x4 hb = *(const f32x4*)(h_in + off + bj * HALF + 4 * n); f32x4 o = hb + (acc[ai][bj][m][n] * rs) * gg[bj][n];
                            if (bad) o = (f32x4){qnan, qnan, qnan, qnan};
                            acc[ai][bj][m][n] = o; *(f32x4*)(h_out + off + bj * HALF + 4 * n) = o; }
                    if (m & 1) asm volatile("" ::: "memory"); }
        }
        if (!do_norm) return;
        bad = st2.run(acc, u, wr, wc, fr, fq, lds, wid, lane) || bad;
        {
            const float* mv = mod_n + (size_t)b * 6144;
            f32x4 gg[2][2], sh[2][2], sc[2][2];
#pragma unroll
            for (int bj = 0; bj < 2; ++bj)
#pragma unroll
                for (int n = 0; n < 2; ++n) { const int c = col0 + bj * HALF + 4 * n; gg[bj][n] = *(const f32x4*)(g_n + c); sh[bj][n] = *(const f32x4*)(mv + shift_idx * 1024 + c); sc[bj][n] = *(const f32x4*)(mv + scale_idx * 1024 + c) + 1.0f; gg[bj][n] = gg[bj][n] * sc[bj][n]; }
#pragma unroll
            for (int ai = 0; ai < 2; ++ai)
#pragma unroll
                for (int m = 0; m < 4; ++m) { const int r = ai * HALF + wr * 64 + m * 16 + fr; const float rs = S[r]; bf16_t* rowp = Uo + (size_t)(u.pm * BM + r) * 1024 + col0;
#pragma unroll
                    for (int bj = 0; bj < 2; ++bj) { const f32x4 y0 = (acc[ai][bj][m][0] * rs) * gg[bj][0] + sh[bj][0], y1 = (acc[ai][bj][m][1] * rs) * gg[bj][1] + sh[bj][1];
                        u32x4 w; w.x = cvt_pk_bf16(y0[0], y0[1]); w.y = cvt_pk_bf16(y0[2], y0[3]); w.z = cvt_pk_bf16(y1[0], y1[1]); w.w = cvt_pk_bf16(y1[2], y1[3]);
                        if (bad) { w.x = 0x7fc07fc0u; w.y = 0x7fc07fc0u; w.z = 0x7fc07fc0u; w.w = 0x7fc07fc0u; }
                        *(u32x4*)(rowp + bj * HALF) = w; } }
        }
    }
    __device__ __forceinline__ void prefetch(const Unit& u, int slot, int wid, PG8_LAS unsigned char* lds) const {
        if (wid != 0) return;
        const int lane = fresh_lane();
        PG8_LAS unsigned char* dst = lds + 131072 + 4096 + 2048 * slot;
        if (act) {
            const int arr = lane >> 5, col = 4 * (lane & 31);
            const float* s0 = (arr == 0 ? cw : cw + 2816) + u.pn * 128 + col; const float* s1 = (arr == 0 ? cw + 2 * 2816 : cb) + u.pn * 128 + col;
            __builtin_amdgcn_global_load_lds((const unsigned*)s0, (PG8_LAS unsigned*)dst, 16, 0, 0);
            __builtin_amdgcn_global_load_lds((const unsigned*)s1, (PG8_LAS unsigned*)(dst + 1024), 16, 0, 0);
        } else if (bias) {
            __builtin_amdgcn_global_load_lds((const unsigned*)(bias + u.pn * 256 + 4 * lane), (PG8_LAS unsigned*)dst, 16, 0, 0);
        }
    }
    __device__ __forceinline__ static float dpp_ror1(float v) { return __int_as_float(__builtin_amdgcn_mov_dpp(__float_as_int(v), 0x121, 0xf, 0xf, false)); }
    __device__ __forceinline__ static float dpp_ror15(float v) { return __int_as_float(__builtin_amdgcn_mov_dpp(__float_as_int(v), 0x12f, 0xf, 0xf, false)); }
    __device__ __forceinline__ void act_epilogue(const f32x4 (&acc)[2][2][4][2], const Unit& u, int wr, int wc, int fr, int fq, const PG8_LAS float* P) const {
        const int cl = wc * 32 + 8 * fq;
#pragma unroll
        for (int ai = 0; ai < 2; ++ai) { const int g = 2 * ai + wr;
            f32x4 e0, e1;
#pragma unroll
            for (int e = 0; e < 4; ++e) { e0[e] = fr == 0 ? acc[ai][0][0][0][e] : acc[ai][0][3][0][e]; e1[e] = fr == 0 ? acc[ai][0][0][1][e] : acc[ai][0][3][1][e]; }
            if (fr == 0 || fr == 15) { PG8_LAS float* dst = ex + (g * 2 + (fr == 0 ? 0 : 1)) * 128 + cl; *(PG8_LAS f32x4*)dst = e0; *(PG8_LAS f32x4*)(dst + 4) = e1; } }
        asm volatile("s_waitcnt lgkmcnt(0)" ::: "memory"); __builtin_amdgcn_s_barrier(); asm volatile("" ::: "memory");
        const int c0 = u.pn * 128 + cl;
        f32x4 w0[2], w1[2], w2[2], bb[2];
#pragma unroll
        for (int n = 0; n < 2; ++n) { w0[n] = *(const PG8_LAS f32x4*)(P + cl + 4 * n); w1[n] = *(const PG8_LAS f32x4*)(P + 128 + cl + 4 * n); w2[n] = *(const PG8_LAS f32x4*)(P + 256 + cl + 4 * n); bb[n] = *(const PG8_LAS f32x4*)(P + 384 + cl + 4 * n); }
        const int rbase = 254 * u.pm - 1;
#pragma unroll
        for (int ai = 0; ai < 2; ++ai) { const int g = 2 * ai + wr;
            f32x4 pb[2], nb[2];
#pragma unroll
            for (int n = 0; n < 2; ++n) { pb[n] = g > 0 ? *(const PG8_LAS f32x4*)(ex + ((g - 1) * 2 + 1) * 128 + cl + 4 * n) : (f32x4){0.f, 0.f, 0.f, 0.f};
                                          nb[n] = g < 3 ? *(const PG8_LAS f32x4*)(ex + ((g + 1) * 2 + 0) * 128 + cl + 4 * n) : (f32x4){0.f, 0.f, 0.f, 0.f}; }
            float fmk[4], lmk[4]; unsigned owp[4][4];
#pragma unroll
            for (int m = 0; m < 4; ++m) { const int R = rbase + 64 * g + 16 * m + fr, tq = R < 16384 ? (R & 4095) : ((R - 16384) & 255);
                fmk[m] = tq == 0 ? 0.f : 1.f; lmk[m] = (R < 16384 ? tq == 4095 : tq == 255) ? 0.f : 1.f; }
#pragma unroll
            for (int n = 0; n < 2; ++n) {
                f32x4 pv[4], nv[4];
#pragma unroll
                for (int e = 0; e < 4; ++e) { float rr[4], rl[4];
#pragma unroll
                    for (int m = 0; m < 4; ++m) { rr[m] = dpp_ror1(acc[ai][0][m][n][e]); rl[m] = dpp_ror15(acc[ai][0][m][n][e]); }
#pragma unroll
                    for (int m = 0; m < 4; ++m) { pv[m][e] = fr == 0 ? (m > 0 ? rr[m > 0 ? m - 1 : 0] : pb[n][e]) : rr[m]; nv[m][e] = fr == 15 ? (m < 3 ? rl[m < 3 ? m + 1 : 3] : nb[n][e]) : rl[m]; } }
#pragma unroll
                for (int m = 0; m < 4; ++m) {
                    const f32x4 gc = bb[n] + (w0[n] * fmk[m]) * pv[m] + w1[n] * acc[ai][0][m][n] + (w2[n] * lmk[m]) * nv[m];
                    f32x4 a;
#pragma unroll
                    for (int e = 0; e < 4; ++e) a[e] = gc[e] * __builtin_amdgcn_rcpf(1.0f + __builtin_amdgcn_exp2f(-1.4426950408889634f * gc[e])) * acc[ai][1][m][n][e];
                    owp[m][2 * n] = cvt_pk_bf16(a[0], a[1]); owp[m][2 * n + 1] = cvt_pk_bf16(a[2], a[3]); } }
#pragma unroll
            for (int m = 0; m < 4; ++m) { const int rho = 64 * g + 16 * m + fr, R = rbase + rho;
                if (rho >= 1 && rho <= 254 && R < nrows) *(u32x4*)(O + (size_t)R * ldc + c0) = (u32x4){owp[m][0], owp[m][1], owp[m][2], owp[m][3]}; }
        }
    }
    __device__ __forceinline__ void operator()(const f32x4 (&acc)[2][2][4][2], const Unit& u, int wr, int wc, int fr, int fq, int slot, PG8_LAS unsigned char* lds) const {
        const PG8_LAS float* P = (const PG8_LAS float*)(lds + 131072 + 4096 + 2048 * slot);
        if (act) { act_epilogue(acc, u, wr, wc, fr, fq, P); return; }
        const int row0 = u.pm * BM + wr * 64 + fr; const int col0 = u.pn * BM + wc * 32 + 8 * fq;
        f32x4 bv[2][2];
#pragma unroll
        for (int bj = 0; bj < 2; ++bj)
#pragma unroll
            for (int n = 0; n < 2; ++n) bv[bj][n] = (bias && u.split <= 0) ? *(const PG8_LAS f32x4*)(P + wc * 32 + 8 * fq + bj * HALF + 4 * n) : (f32x4){0.f, 0.f, 0.f, 0.f};
        float* sb = slab + ((size_t)(u.split < 0 ? 0 : u.split) * 1024 + (row0 - 64 * BM)) * 1024 + col0;
#pragma unroll
        for (int ai = 0; ai < 2; ++ai)
#pragma unroll
            for (int m = 0; m < 4; ++m) {
                const f32x4 v00 = acc[ai][0][m][0] + bv[0][0], v01 = acc[ai][0][m][1] + bv[0][1], v10 = acc[ai][1][m][0] + bv[1][0], v11 = acc[ai][1][m][1] + bv[1][1];
                if (u.split < 0) { bf16_t* rowp = O + (size_t)(row0 + ai * HALF + m * 16) * ldc + col0;
                    u32x4 w; w.x = cvt_pk_bf16(v00[0], v00[1]); w.y = cvt_pk_bf16(v00[2], v00[3]); w.z = cvt_pk_bf16(v01[0], v01[1]); w.w = cvt_pk_bf16(v01[2], v01[3]);
                    *(u32x4*)rowp = w;
                    w.x = cvt_pk_bf16(v10[0], v10[1]); w.y = cvt_pk_bf16(v10[2], v10[3]); w.z = cvt_pk_bf16(v11[0], v11[1]); w.w = cvt_pk_bf16(v11[2], v11[3]);
                    *(u32x4*)(rowp + HALF) = w;
                } else { float* rowp = sb + (size_t)(ai * HALF + m * 16) * 1024;
                    *(f32x4*)rowp = v00; *(f32x4*)(rowp + 4) = v01; *(f32x4*)(rowp + HALF) = v10; *(f32x4*)(rowp + HALF + 4) = v11; }
                asm volatile("" ::: "memory");
            }
    }
};

struct Order2 {
    int nM, nN, G, c, ntK, mode, SK, split_first;
    __host__ __device__ __forceinline__ void init(int M, int N, int G_, int c_, int K_, int SK_, int split_first_ = 0) { mode = SK_ > 0 || split_first_; SK = SK_; split_first = split_first_; nM = mode ? 64 : M / BM; nN = N / BM; G = G_; c = c_; ntK = K_ / BK; }
    __host__ __device__ __forceinline__ bool next(int i, Unit& u) const {
        const int L = i * G + c, nwg = nM * nN, ns = 16 * SK;
        int pm = 0, pn = 0, kt0 = 0, nt = ntK, split = -1; bool ok = true;
        int Lt = -1, xs = -1;
        if (mode && split_first) { if (i == 0) { if (c < ns) xs = c; else Lt = c; } else if (i == 1 && c < ns) Lt = c; else ok = false; }
        else if (L < nwg) Lt = L;
        else if (mode && L - nwg < ns) xs = L - nwg;
        else ok = false;
        if (Lt >= 0) {
            int wgid = Lt; { const int q = nwg / NXCD, r = nwg % NXCD, xcd = wgid % NXCD, off = wgid / NXCD; wgid = (xcd < r ? xcd * (q + 1) : r * (q + 1) + (xcd - r) * q) + off; }
            const int nig = WGM * nN, gid = wgid / nig, fm = gid * WGM, gsz = (nM - fm) < WGM ? (nM - fm) : WGM;
            pm = fm + ((wgid % nig) % gsz); pn = (wgid % nig) / gsz;
        } else if (xs >= 0) {
            const int tile = xs / SK, sp = xs % SK, pairs = ntK / 2, q = pairs / SK, r = pairs % SK;
            pm = 64 + (tile >> 2); pn = tile & 3; split = sp;
            if (sp < r) { kt0 = 2 * sp * (q + 1); nt = 2 * (q + 1); } else { kt0 = 2 * (r * (q + 1) + (sp - r) * q); nt = 2 * q; }
        }
#if defined(__HIP_DEVICE_COMPILE__)
        u.pm = __builtin_amdgcn_readfirstlane(pm); u.pn = __builtin_amdgcn_readfirstlane(pn); u.kt0 = __builtin_amdgcn_readfirstlane(kt0); u.nt = __builtin_amdgcn_readfirstlane(nt); u.split = __builtin_amdgcn_readfirstlane(split);
        return __builtin_amdgcn_readfirstlane((int)ok) != 0;
#else
        u.pm = pm; u.pn = pn; u.kt0 = kt0; u.nt = nt; u.split = split;
        return ok;
#endif
    }
    __device__ __forceinline__ void a_ready(const Unit&) const {}
    __device__ __forceinline__ void done(const Unit&) const {}
};

template <class Epi, class Sched, bool ALIGN_EPI = false, bool SP2 = false>
__device__ __forceinline__ void gemm_phase(PG8_LAS unsigned char* lds, const Gemm g, const Sched& S, const Epi& E, const int wid) {
    const int lane = fresh_lane(), tid = wid * 64 + lane, wr = wid >> 2, wc = wid & 3, fr = lane & 15, fq = lane >> 4;
    const int K = g.K;
    unsigned voffA[2], voffB[2];
#pragma unroll
    for (int i = 0; i < 2; ++i) { int R, C; stage_rc(tid * 16 + i * 8192, R, C); const int Rb = Epi::PERM ? ((R & ~31) + perm32(R & 31)) : R;
        voffA[i] = (unsigned)(R * g.lda + C) * 2u; voffB[i] = (unsigned)(Rb * K + C) * 2u; }
    const size_t kstep = (size_t)(BK * 2);
    const size_t hstepA = (size_t)HALF * g.lda * 2, hstepB = (size_t)HALF * K * 2;
    const size_t tstepA = (size_t)g.rowstep * g.lda * 2, tstepB = 2 * hstepB;
    const unsigned ldsw = (unsigned)wid * 1024u;
    const int aoff = lds_byte(wr * 64 + fr, fq * 8), boff = lds_byte(wc * 32 + fr, fq * 8);
#define PG8_SA(b, h) (((b) * 2 + (h)) * HTB)
#define PG8_SB(b, h) ((4 + (b) * 2 + (h)) * HTB)
#define PG8_STAGE(bufoff, gbase, voff) do { _Pragma("unroll") for (int _i = 0; _i < 2; ++_i) \
        __builtin_amdgcn_global_load_lds((const unsigned*)((const char*)(gbase) + (voff)[_i]), (PG8_LAS unsigned*)(lds + (bufoff) + ldsw + _i * 8192), 16, 0, 0); } while (0)
#define PG8_LDA(dst, b, h) do { _Pragma("unroll") for (int m = 0; m < 4; ++m) _Pragma("unroll") for (int k = 0; k < 2; ++k) dst[m][k] = *(const PG8_LAS bf16x8*)(lds + PG8_SA(b, h) + aoff + m * 2048 + k * 1024); } while (0)
#define PG8_LDB(dst, b, h) do { _Pragma("unroll") for (int n = 0; n < 2; ++n) _Pragma("unroll") for (int k = 0; k < 2; ++k) dst[n][k] = *(const PG8_LAS bf16x8*)(lds + PG8_SB(b, h) + boff + n * 2048 + k * 1024); } while (0)
#define PG8_MMA(ai, bj, At, Bt) do { __builtin_amdgcn_s_setprio(1); _Pragma("unroll") for (int m = 0; m < 4; ++m) _Pragma("unroll") for (int n = 0; n < 2; ++n) _Pragma("unroll") for (int k = 0; k < 2; ++k) \
        acc[ai][bj][m][n] = __builtin_amdgcn_mfma_f32_16x16x32_bf16(Bt[n][k], At[m][k], acc[ai][bj][m][n], 0, 0, 0); __builtin_amdgcn_s_setprio(0); } while (0)
#define PG8_WAIT_V(n) asm volatile("s_waitcnt vmcnt(" #n ")" ::: "memory")
#define PG8_WAIT_L(n) asm volatile("s_waitcnt lgkmcnt(" #n ")" ::: "memory")
#define PG8_BAR __builtin_amdgcn_s_barrier()
#define PG8_SCHED __builtin_amdgcn_sched_barrier(0)
    Unit cur, nxt; int ui = 0;
    if (!S.next(0, cur)) return;
    f32x4 acc[2][2][4][2];
#pragma unroll
    for (int a = 0; a < 2; ++a)
#pragma unroll
        for (int b = 0; b < 2; ++b)
#pragma unroll
            for (int m = 0; m < 4; ++m)
#pragma unroll
                for (int n = 0; n < 2; ++n) acc[a][b][m][n] = (f32x4){0.f, 0.f, 0.f, 0.f};
    bf16x8 At[4][2], B0[2][2], B1[2][2];
    const char* cA = (const char*)g.A + (size_t)cur.pm * tstepA + (size_t)cur.kt0 * kstep; const char* cB = (const char*)g.Bt + (size_t)cur.pn * tstepB + (size_t)cur.kt0 * kstep;
    S.a_ready(cur);
    E.prefetch(cur, 0, wid, lds);
    if constexpr (SP2) {
        PG8_STAGE(PG8_SB(0, 0), cB, voffB); PG8_STAGE(PG8_SB(0, 1), cB + hstepB, voffB); PG8_STAGE(PG8_SA(0, 0), cA, voffA); PG8_STAGE(PG8_SA(0, 1), cA + hstepA, voffA);
        if (wr == 1) PG8_BAR;
        PG8_WAIT_V(2); PG8_BAR;
        PG8_STAGE(PG8_SB(1, 0), cB + kstep, voffB); PG8_STAGE(PG8_SA(1, 0), cA + kstep, voffA); PG8_STAGE(PG8_SB(1, 1), cB + hstepB + kstep, voffB);
        PG8_WAIT_V(6); PG8_BAR;
    } else {
        PG8_STAGE(PG8_SB(0, 0), cB, voffB); PG8_STAGE(PG8_SA(0, 0), cA, voffA); PG8_STAGE(PG8_SB(0, 1), cB + hstepB, voffB); PG8_STAGE(PG8_SA(0, 1), cA + hstepA, voffA);
        if (wr == 1) PG8_BAR;
        PG8_WAIT_V(4); PG8_BAR;
        PG8_STAGE(PG8_SB(1, 0), cB + kstep, voffB); PG8_STAGE(PG8_SA(1, 0), cA + kstep, voffA); PG8_STAGE(PG8_SB(1, 1), cB + hstepB + kstep, voffB);
        PG8_WAIT_V(6); PG8_BAR;
    }
    for (;;) {
        const bool has_next = S.next(ui + 1, nxt);
        if (has_next) E.prefetch(nxt, (ui + 1) % 3, wid, lds);
        const char* nA = has_next ? (const char*)g.A + (size_t)nxt.pm * tstepA + (size_t)nxt.kt0 * kstep : cA; const char* nB = has_next ? (const char*)g.Bt + (size_t)nxt.pn * tstepB + (size_t)nxt.kt0 * kstep : cB;
        const int nt = cur.nt;
        for (int t = 0; t < nt; t += 2) {
            const bool last = (t == nt - 2);
            const char* a1 = cA + (size_t)(t + 1) * kstep;
            const char* a2 = last ? nA : cA + (size_t)(t + 2) * kstep; const char* b2 = last ? nB : cB + (size_t)(t + 2) * kstep;
            const char* a3 = a2 + kstep; const char* b3 = b2 + kstep;
            if (last && has_next) S.a_ready(nxt);
            if constexpr (SP2) {
            PG8_LDB(B0, 0, 0); PG8_LDB(B1, 0, 1); PG8_SCHED; PG8_LDA(At, 0, 0); PG8_STAGE(PG8_SA(1, 1), a1 + hstepA, voffA);
            PG8_WAIT_V(8); PG8_WAIT_L(0); PG8_BAR; PG8_MMA(0, 0, At, B0); PG8_MMA(0, 1, At, B1); PG8_BAR; PG8_SCHED;
            PG8_LDA(At, 0, 1); PG8_STAGE(PG8_SB(0, 0), b2, voffB); PG8_STAGE(PG8_SB(0, 1), b2 + hstepB, voffB); PG8_STAGE(PG8_SA(0, 0), a2, voffA);
            PG8_WAIT_V(8); PG8_WAIT_L(0); PG8_BAR; PG8_MMA(1, 0, At, B0); PG8_MMA(1, 1, At, B1); PG8_BAR; PG8_SCHED;
            PG8_LDB(B0, 1, 0); PG8_LDB(B1, 1, 1); PG8_SCHED; PG8_LDA(At, 1, 0); PG8_STAGE(PG8_SA(0, 1), a2 + hstepA, voffA);
            PG8_WAIT_V(8); PG8_WAIT_L(0); PG8_BAR; PG8_MMA(0, 0, At, B0); PG8_MMA(0, 1, At, B1); PG8_BAR; PG8_SCHED;
            PG8_LDA(At, 1, 1); PG8_STAGE(PG8_SB(1, 0), b3, voffB); PG8_STAGE(PG8_SB(1, 1), b3 + hstepB, voffB); PG8_STAGE(PG8_SA(1, 0), a3, voffA);
            PG8_WAIT_V(8); PG8_WAIT_L(0); PG8_BAR; PG8_MMA(1, 0, At, B0); PG8_MMA(1, 1, At, B1); PG8_BAR; PG8_SCHED;
            } else {
            PG8_LDB(B0, 0, 0); PG8_SCHED; PG8_LDA(At, 0, 0); PG8_STAGE(PG8_SA(1, 1), a1 + hstepA, voffA);
            PG8_WAIT_L(8); PG8_BAR; PG8_WAIT_L(0); PG8_MMA(0, 0, At, B0); PG8_BAR; PG8_SCHED;
            PG8_LDB(B1, 0, 1); PG8_STAGE(PG8_SB(0, 0), b2, voffB);
            PG8_BAR; PG8_WAIT_L(0); PG8_MMA(0, 1, At, B1); PG8_BAR;
            PG8_LDA(At, 0, 1); PG8_STAGE(PG8_SA(0, 0), a2, voffA);
            PG8_BAR; PG8_WAIT_L(0); PG8_MMA(1, 0, At, B0); PG8_BAR; PG8_SCHED;
            PG8_STAGE(PG8_SB(0, 1), b2 + hstepB, voffB);
            PG8_WAIT_V(6); PG8_BAR; PG8_MMA(1, 1, At, B1); PG8_BAR;
            PG8_LDB(B0, 1, 0); PG8_SCHED; PG8_LDA(At, 1, 0); PG8_STAGE(PG8_SA(0, 1), a2 + hstepA, voffA);
            PG8_WAIT_L(8); PG8_BAR; PG8_WAIT_L(0); PG8_MMA(0, 0, At, B0); PG8_BAR; PG8_SCHED;
            PG8_LDB(B1, 1, 1); PG8_STAGE(PG8_SB(1, 0), b3, voffB);
            PG8_BAR; PG8_WAIT_L(0); PG8_MMA(0, 1, At, B1); PG8_BAR;
            PG8_LDA(At, 1, 1); PG8_STAGE(PG8_SA(1, 0), a3, voffA);
            PG8_BAR; PG8_WAIT_L(0); PG8_MMA(1, 0, At, B0); PG8_BAR; PG8_SCHED;
            PG8_STAGE(PG8_SB(1, 1), b3 + hstepB, voffB);
            PG8_WAIT_V(6); PG8_BAR; PG8_MMA(1, 1, At, B1); PG8_BAR;
            }
        }
        if constexpr (ALIGN_EPI) { if (wr == 0) PG8_BAR; }
        if (!(E.fuse && !has_next)) { const int le = fresh_lane(); E(acc, cur, wr, wc, le & 15, le >> 4, ui % 3, lds); S.done(cur); }
        if (!has_next) break;
#pragma unroll
        for (int a = 0; a < 2; ++a)
#pragma unroll
            for (int b = 0; b < 2; ++b)
#pragma unroll
                for (int m = 0; m < 4; ++m)
#pragma unroll
                    for (int n = 0; n < 2; ++n) acc[a][b][m][n] = (f32x4){0.f, 0.f, 0.f, 0.f};
        cur = nxt; cA = nA; cB = nB; ++ui;
        if constexpr (ALIGN_EPI) { if (wr == 1) PG8_BAR; }
    }
    PG8_WAIT_V(0);
    if constexpr (!ALIGN_EPI) { if (wr == 0) PG8_BAR; }
    PG8_BAR;
    if (E.fuse) { const int le = fresh_lane(); E.fused(acc, cur, wr, wc, le & 15, le >> 4, lds, wid, le); S.done(cur); }
#undef PG8_SA
#undef PG8_SB
#undef PG8_STAGE
#undef PG8_LDA
#undef PG8_LDB
#undef PG8_MMA
#undef PG8_WAIT_V
#undef PG8_WAIT_L
#undef PG8_BAR
#undef PG8_SCHED
}
}

constexpr int NWAVES = 8, NTHREADS = 512;
constexpr int DM = 1024, BATCH = 4, SEQ = 4096, CTXL = 256, DEPTH = 4, DFF = 2816, NMOD = 6;
constexpr int MLAT = BATCH * SEQ, MCTX = BATCH * CTXL, MT = MLAT + MCTX;
constexpr int NKEY = CTXL + SEQ;
constexpr int A_HEADS = 8, A_KV = 2, A_DH = 128, A_COLS = (A_HEADS + 2 * A_KV) * A_DH;
constexpr int C_HEADS = 16, C_KV = 2, C_DH = 64, C_COLS = (C_HEADS + 2 * C_KV) * C_DH;
constexpr int WINDOW = 128, GRID_W = 64;
constexpr float EPS = 1e-6f;
constexpr int N_IN = 34;
enum { I_X = 0, I_C, I_CTX, I_CCTX, I_MODW, I_MODB, I_NORMG, I_WUP, I_FCW, I_FCB, I_WDOWN, I_AQKV, I_AQG, I_AKG, I_AOUT,
       I_BIN, I_BBIN, I_BCW, I_BCB, I_FW1, I_FB1, I_FW2, I_FB2, I_FW3, I_FB3, I_FW4, I_BSKIP, I_BOUT, I_BBOUT, I_CQKV, I_CBQKV, I_CSINK, I_COUT, I_CBOUT };

constexpr size_t MiB = 1u << 20;
constexpr size_t WS_CTL = 0, CTL_ZERO_BYTES = 1 * MiB;
constexpr size_t WS_W_AQKV = 1 * MiB, WS_W_AOUT = 7 * MiB, WS_W_BIN = 11 * MiB, WS_W_BOUT = 17 * MiB, WS_W_CQKV = 19 * MiB, WS_W_COUT = 22 * MiB;
constexpr size_t WS_W_UP = 24 * MiB, WS_W_DOWN = 68 * MiB;
constexpr size_t WS_MOD = 90 * MiB, WS_HCLAT = 91 * MiB, WS_HCCTX = 123 * MiB, WS_HCTX = 125 * MiB, WS_U = 130 * MiB, WS_R = 164 * MiB, WS_HB = 351 * MiB, WS_END = 383 * MiB;
constexpr size_t R_QKV = 0, R_QN = 102 * MiB, R_KB = 136 * MiB, R_VB = 145 * MiB, R_VPT = 102 * MiB, R_VPC = 166 * MiB, R_O = 0, R_G = 0;
static_assert(WS_W_AQKV + 2ull * A_COLS * DM * 2 <= WS_W_AOUT && WS_W_CQKV + (size_t)C_COLS * DM * 2 <= WS_W_COUT && WS_W_UP + 4ull * 2 * DFF * DM * 2 <= WS_W_DOWN && WS_W_DOWN + 4ull * DM * DFF * 2 <= WS_MOD, "weights map");
static_assert(WS_HCLAT + (size_t)(2 * SEQ - 1) * DM * 4 <= WS_HCCTX && WS_HCCTX + (size_t)(2 * CTXL - 1) * DM * 4 <= WS_HCTX && WS_U + (size_t)MT * DM * 2 <= WS_R && WS_R + (size_t)MT * 2 * DFF * 2 <= WS_HB && WS_HB + (size_t)MLAT * DM * 2 <= WS_END, "ws map");
static_assert(R_VB + (size_t)BATCH * NKEY * 256 * 2 <= 187 * MiB && R_VPT + (size_t)MLAT * DM * 4 <= R_VPC && R_VPC + (size_t)MCTX * DM * 4 <= 187 * MiB && (size_t)MT * 3 * DM * 2 <= R_QN, "R overlay");
constexpr size_t WS_CSA = WS_MOD + 512 * 1024, WS_CSC = WS_CSA + 64 * 32 * 8;
constexpr size_t WS_W4T = WS_MOD + 640 * 1024;
static_assert(WS_CSC + 64 * 16 * 8 <= WS_W4T && WS_W4T + 2048 * 64 * 2 <= WS_HCLAT, "mod page map");
constexpr size_t R_SLAB = 40 * MiB;
constexpr size_t R_SLAB2 = 100 * MiB;
constexpr int SK_OUT = 8, SK_DOWN = 7;
static_assert(R_SLAB >= (size_t)MLAT * DM * 2 && R_SLAB + (size_t)SK_OUT * MCTX * DM * 4 <= R_QN && R_SLAB2 >= (size_t)MT * DFF * 2 && R_SLAB2 + (size_t)SK_DOWN * MCTX * DM * 4 <= 187 * MiB, "slab map");
constexpr size_t R_XBUF = 100 * MiB;
constexpr int CW_SEAM = 16384;
constexpr int CW_BAR = 4096;

constexpr int LDS_BYTES = 147456;
constexpr int MISC_OFF = LDS_BYTES - 1024;
constexpr int INTAB_OFF = MISC_OFF + 256;

#define GAS __attribute__((address_space(1)))
#define LAS __attribute__((address_space(3)))
typedef unsigned short bf16;
typedef unsigned v4u __attribute__((ext_vector_type(4)));
typedef float f32x4 __attribute__((ext_vector_type(4)));
typedef short bf16x8 __attribute__((ext_vector_type(8)));
typedef GAS unsigned gu32;
typedef GAS unsigned long long gu64;
#define RLX_AGENT __ATOMIC_RELAXED, __HIP_MEMORY_SCOPE_AGENT
#define LDS_WAIT() asm volatile("s_waitcnt lgkmcnt(0)" ::: "memory")
#define VM_WAIT() asm volatile("s_waitcnt vmcnt(0)" ::: "memory")
__device__ __forceinline__ unsigned long long rt() { return __builtin_amdgcn_s_memrealtime(); }
__device__ __forceinline__ unsigned pk2(float lo, float hi) { unsigned r; asm("v_cvt_pk_bf16_f32 %0, %1, %2" : "=v"(r) : "v"(lo), "v"(hi)); return r; }
__device__ __forceinline__ unsigned f2bf(float f) { return pk2(f, 0.f) & 0xffffu; }

#define XB_TMO      128
#define XB_XCNT(j)  (256  + 64 * (j))
#define XB_XSUB(j)  (1280 + 64 * (j))
#define XB_XGEN(j)  (2304 + 64 * (j))
#define XB_TOP      3328
#define XB_TOPGEN   3392
#define XCD_BAR_WORDS 3456
#define XB_SPIN_CAP (1u << 18)

__device__ __forceinline__ unsigned xb_ld(unsigned* p)              { return __hip_atomic_load(p, __ATOMIC_RELAXED, __HIP_MEMORY_SCOPE_AGENT); }
__device__ __forceinline__ unsigned xb_add(unsigned* p, unsigned v) { return __hip_atomic_fetch_add(p, v, __ATOMIC_RELAXED, __HIP_MEMORY_SCOPE_AGENT); }
__device__ __forceinline__ unsigned xb_xcc_id() { return (unsigned)__builtin_amdgcn_s_getreg((3 << 11) | 20) & 0xFu; }
#define XB_SPIN(cond, bar) do { unsigned _sp = 0; while (cond) { __builtin_amdgcn_s_sleep(1); \
    if ((++_sp & 255u) == 0u) { if (xb_ld(&(bar)[XB_TMO])) break; if (_sp > XB_SPIN_CAP) { atomicAdd(&(bar)[XB_TMO], 1u); break; } } } } while (0)

struct XcdBarrier {
    unsigned* bar; unsigned x;
    volatile LAS unsigned* st;
};

__device__ __forceinline__ XcdBarrier xcd_barrier_post(unsigned* bar, volatile LAS unsigned* st, int tid) {
    XcdBarrier b; b.bar = bar; b.x = xb_xcc_id(); b.st = st;
    if (tid == 0) (void)xb_add(&bar[XB_XCNT(b.x)], 1u);
    return b;
}
__device__ __forceinline__ void xcd_barrier_complete(unsigned* bar, unsigned x, unsigned& nloc, unsigned& nx) {
    const unsigned G = gridDim.x * gridDim.y * gridDim.z;
    unsigned sum, cnt, mine, sp = 0u;
    for (;;) {
        sum = 0u; cnt = 0u; mine = 0u;
#pragma unroll
        for (unsigned j = 0; j < 16; ++j) { const unsigned c = xb_ld(&bar[XB_XCNT(j)]); sum += c; cnt += (c > 0u) ? 1u : 0u; mine = (j == x) ? c : mine; }
        if (sum == G) break;
        __builtin_amdgcn_s_sleep(1);
        if ((++sp & 255u) == 0u) { if (xb_ld(&bar[XB_TMO])) break; if (sp > XB_SPIN_CAP) { atomicAdd(&bar[XB_TMO], 1u); break; } }
    }
    nloc = mine > 0u ? mine : 1u; nx = cnt > 0u ? cnt : 1u;
}

__device__ __forceinline__ void xcd_barrier(const XcdBarrier& b, int tid) {
    asm volatile("s_waitcnt vmcnt(0)" ::: "memory");
    __syncthreads();
    if (tid == 0) {
        unsigned* bar = b.bar;
        __builtin_amdgcn_s_waitcnt(0);
        unsigned nloc = b.st[0], nx = b.st[1];
        if (nloc == 0u) { xcd_barrier_complete(bar, b.x, nloc, nx); b.st[0] = nloc; b.st[1] = nx; }
        const unsigned old = xb_add(&bar[XB_XSUB(b.x)], 1u);
        const unsigned gen = old / nloc;
        if (old + 1u == (gen + 1u) * nloc) {
            __builtin_amdgcn_fence(__ATOMIC_RELEASE, "agent");
            asm volatile("s_waitcnt vmcnt(0)" ::: "memory");
            const unsigned og = xb_add(&bar[XB_TOP], 1u);
            const unsigned tg = og / nx;
            if (og + 1u == (tg + 1u) * nx) xb_add(&bar[XB_TOPGEN], 1u);
            else XB_SPIN(xb_ld(&bar[XB_TOPGEN]) == tg, bar);
            __builtin_amdgcn_fence(__ATOMIC_ACQUIRE, "agent");
            asm volatile("s_waitcnt vmcnt(0)" ::: "memory");
        } else {
            XB_SPIN(xb_ld(&bar[XB_TOPGEN]) == gen, bar);
            __builtin_amdgcn_fence(__ATOMIC_ACQUIRE, "agent");
            asm volatile("s_waitcnt vmcnt(0)" ::: "memory");
        }
    }
    __syncthreads();
}
namespace aa {
typedef unsigned short bf16;
constexpr int D = 128, NW = 8, QBLK = 32, KVBLK = 64, SDEPTH = 1;
constexpr float SCALE = 0.088388347648318440f, THR = 8.f;
constexpr int LDQ = 1536, LDK = 256, LDV = 1536, LDO = 1024;
constexpr size_t SHM_V = KVBLK * D * 2, SHM_K = KVBLK * D * 2, SHM_ATTN = 2 * SHM_V + 2 * SHM_K + NW * 64 * 4;
using bf16x8 = __attribute__((ext_vector_type(8))) short;
using s16x4  = __attribute__((ext_vector_type(4))) short;
using f32x16 = __attribute__((ext_vector_type(16))) float;
using f32x8  = __attribute__((ext_vector_type(8))) float;
using u32x4  = __attribute__((ext_vector_type(4))) unsigned;
#define KSWZ(row, colB) ((row) * 256 + ((colB) ^ (((row) & 7) << 4)))
#define SBAR() __builtin_amdgcn_sched_barrier(0)
__device__ __forceinline__ int crow(int r, int hi) { return (r & 3) + 8 * (r >> 2) + 4 * hi; }
__device__ __forceinline__ unsigned cvtpk(float lo, float hi) {
  unsigned r; asm volatile("v_cvt_pk_bf16_f32 %0, %1, %2" : "=v"(r) : "v"(lo), "v"(hi)); return r;
}
struct St { using T = bf16x8; __device__ static __forceinline__ T ld8(const bf16* p) { return *reinterpret_cast<const bf16x8*>(p); } __device__ static __forceinline__ bf16x8 tobf(T x) { return x; } };
__device__ __forceinline__ void partialSM(f32x16& p0, f32x16& p1, float& m_reg, float& mn, float& alpha) {
  constexpr float C = SCALE * 1.4426950408889634f;
  float pmax = p0[0]; for (int r = 1; r < 16; ++r) pmax = fmaxf(pmax, p0[r]); for (int r = 0; r < 16; ++r) pmax = fmaxf(pmax, p1[r]);
  { auto rr = __builtin_amdgcn_permlane32_swap(__float_as_uint(pmax), __float_as_uint(pmax), false, false);
    pmax = fmaxf(__uint_as_float(rr[0]), __uint_as_float(rr[1])); }
  if (__builtin_expect(__all(pmax - m_reg <= THR / SCALE), 1)) { mn = m_reg; alpha = 1.f; }
  else { mn = fmaxf(m_reg, pmax); alpha = __builtin_amdgcn_exp2f((m_reg - mn) * C); m_reg = mn; }
  float mnC = -mn * C;
  for (int r = 0; r < 16; ++r) p0[r] = fmaf(p0[r], C, mnC); for (int r = 0; r < 16; ++r) p1[r] = fmaf(p1[r], C, mnC);
  for (int r = 0; r < 16; ++r) p0[r] = __builtin_amdgcn_exp2f(p0[r]);
}
__device__ __forceinline__ void finishSM(f32x16& p0, f32x16& p1, float alpha, float& l_reg, bf16x8& pa0, bf16x8& pa1, bf16x8& pa2, bf16x8& pa3) {
  for (int r = 0; r < 16; ++r) p1[r] = __builtin_amdgcn_exp2f(p1[r]);
  float ps = 0; for (int r = 0; r < 16; ++r) ps += p0[r]; for (int r = 0; r < 16; ++r) ps += p1[r];
  { auto rr = __builtin_amdgcn_permlane32_swap(__float_as_uint(ps), __float_as_uint(ps), false, false);
    ps = __uint_as_float(rr[0]) + __uint_as_float(rr[1]); }
  l_reg = l_reg * alpha + ps;
#define PK4(P, BASE, OUT) do { unsigned a0 = cvtpk(P[BASE + 0], P[BASE + 1]), a1 = cvtpk(P[BASE + 2], P[BASE + 3]);   \
    unsigned b0 = cvtpk(P[BASE + 4], P[BASE + 5]), b1 = cvtpk(P[BASE + 6], P[BASE + 7]);                              \
    auto r0 = __builtin_amdgcn_permlane32_swap(a0, b0, false, false); auto r1 = __builtin_amdgcn_permlane32_swap(a1, b1, false, false); \
    u32x4 w = {r0[0], r1[0], r0[1], r1[1]}; OUT = *reinterpret_cast<bf16x8*>(&w); } while (0)
  PK4(p0, 0, pa0); PK4(p0, 8, pa1); PK4(p1, 0, pa2); PK4(p1, 8, pa3);
#undef PK4
}
__device__ __forceinline__ void qkt(f32x16& p0, f32x16& p1, const bf16* Ks, const bf16x8* qr, int r32, int hi) {
  p0 = f32x16{}; p1 = f32x16{};
  for (int d0 = 0; d0 < 8; ++d0) { int cb = (d0 * 16 + hi * 8) * 2;
    bf16x8 b0 = *reinterpret_cast<const bf16x8*>((const char*)Ks + KSWZ(r32, cb));
    bf16x8 b1 = *reinterpret_cast<const bf16x8*>((const char*)Ks + KSWZ(32 + r32, cb));
    p0 = __builtin_amdgcn_mfma_f32_32x32x16_bf16(b0, qr[d0], p0, 0, 0, 0);
    p1 = __builtin_amdgcn_mfma_f32_32x32x16_bf16(b1, qr[d0], p1, 0, 0, 0); }
}
__device__ __forceinline__ int v_st(int k, int c) { const int kk = (k & ~0xC) | ((k & 4) << 1) | ((k & 8) >> 1); return ((kk >> 3) * 4 + (c >> 5)) * 512 + ((kk & 7) * 32 + (c & 31)) * 2; }
__device__ __forceinline__ int v_rd_base(int lane) { return ((lane & 3) << 3) | (((lane >> 2) & 3) << 6) | (((lane >> 4) & 1) << 5) | (((lane >> 5) & 1) << 8); }
constexpr int v_rd_off(int d0, int ks, int half) { return d0 * 512 + ks * 4096 + half * 2048; }
template <int OFF> __device__ __forceinline__ s16x4 tr_read(int vb) {
  s16x4 r; asm volatile("ds_read_b64_tr_b16 %0, %1 offset:%2" : "=&v"(r) : "v"(vb), "i"(OFF) : "memory"); return r;
}
template <int D0> __device__ __forceinline__ void pv_one(f32x16& od, int vb, bf16x8 pa0, bf16x8 pa1, bf16x8 pa2, bf16x8 pa3) {
  const s16x4 l0 = tr_read<v_rd_off(D0, 0, 0)>(vb), h0 = tr_read<v_rd_off(D0, 0, 1)>(vb), l1 = tr_read<v_rd_off(D0, 1, 0)>(vb), h1 = tr_read<v_rd_off(D0, 1, 1)>(vb);
  const s16x4 l2 = tr_read<v_rd_off(D0, 2, 0)>(vb), h2 = tr_read<v_rd_off(D0, 2, 1)>(vb), l3 = tr_read<v_rd_off(D0, 3, 0)>(vb), h3 = tr_read<v_rd_off(D0, 3, 1)>(vb);
  asm volatile("s_waitcnt lgkmcnt(0)" ::: "memory"); SBAR();
#define PK(L, H) (bf16x8){L[0], L[1], L[2], L[3], H[0], H[1], H[2], H[3]}
  od = __builtin_amdgcn_mfma_f32_32x32x16_bf16(pa0, PK(l0, h0), od, 0, 0, 0);
  od = __builtin_amdgcn_mfma_f32_32x32x16_bf16(pa1, PK(l1, h1), od, 0, 0, 0);
  od = __builtin_amdgcn_mfma_f32_32x32x16_bf16(pa2, PK(l2, h2), od, 0, 0, 0);
  od = __builtin_amdgcn_mfma_f32_32x32x16_bf16(pa3, PK(l3, h3), od, 0, 0, 0);
#undef PK
}
__device__ __forceinline__ void pv_d0(f32x16* o, int vb, bf16x8 pa0, bf16x8 pa1, bf16x8 pa2, bf16x8 pa3) {
  pv_one<0>(o[0], vb, pa0, pa1, pa2, pa3); pv_one<1>(o[1], vb, pa0, pa1, pa2, pa3); pv_one<2>(o[2], vb, pa0, pa1, pa2, pa3); pv_one<3>(o[3], vb, pa0, pa1, pa2, pa3);
}

__device__ __forceinline__ void attn_dense_body(const bf16* __restrict__ Qb, const bf16* __restrict__ Kh, const bf16* __restrict__ Vb, int rc, int rl, bf16* __restrict__ Ob, int seq, char* lds, const int tid,
                                                const float* __restrict__ qgain, const float* __restrict__ cs, int t_first) {
  using SQ = St;
  const int wid = __builtin_amdgcn_readfirstlane(tid >> 6), lane = tid & 63, r32 = lane & 31, hi = lane >> 5;
  bf16* V_lds = (bf16*)lds; bf16* K_lds = (bf16*)(lds + 2 * SHM_V);
  float* ws = (float*)(lds + 2 * SHM_V + 2 * SHM_K) + wid * 64; float* li_l = ws; float* al_l = ws + 32;
  float m_reg = -1e30f, l_reg = 0; f32x16 o[4] = {}; bf16x8 qr[8];
  const int sr = tid >> 4, sc = (tid & 15) * 8, vst0 = v_st(sr, sc), vst1 = v_st(32 + sr, sc);
  const unsigned vthr = (unsigned)(sr * LDV + sc), kthr = (unsigned)(sr * LDK + sc);
  const int vb0 = (int)(uintptr_t)V_lds + v_rd_base(lane);
  struct { typename St::T vs0, vs1, ks0, ks1; } sr_[SDEPTH];
#define SLOAD(i, k0) do { const unsigned vro_ = (unsigned)((k0) < 256 ? rc + (k0) : rl + (k0) - 256) * LDV + vthr; sr_[i].vs0 = St::ld8(Vb + vro_); sr_[i].vs1 = St::ld8(Vb + (vro_ + 32u * LDV)); \
    const unsigned kro_ = (unsigned)(k0) * LDK + kthr; sr_[i].ks0 = St::ld8(Kh + kro_); sr_[i].ks1 = St::ld8(Kh + (kro_ + 32u * LDK)); } while (0)
#define SWRITE(b, i) do { *(bf16x8*)((char*)V_lds + (b) * SHM_V + vst0) = St::tobf(sr_[i].vs0);          \
    *(bf16x8*)((char*)V_lds + (b) * SHM_V + vst1) = St::tobf(sr_[i].vs1); int kc = sc * 2;               \
    *(bf16x8*)((char*)K_lds + (b) * SHM_K + KSWZ(sr, kc)) = St::tobf(sr_[i].ks0);                       \
    *(bf16x8*)((char*)K_lds + (b) * SHM_K + KSWZ(32 + sr, kc)) = St::tobf(sr_[i].ks1); } while (0)
#define SWAIT() do { if constexpr (SDEPTH == 2) asm volatile("s_waitcnt vmcnt(4)" ::: "memory"); else asm volatile("s_waitcnt vmcnt(0)" ::: "memory"); } while (0)
#define RESC(a) do { if (__any((a) < 1.f)) { if (hi == 0) al_l[r32] = (a); asm volatile("s_waitcnt lgkmcnt(0)" ::: "memory"); \
    for (int d = 0; d < 4; ++d) for (int r = 0; r < 16; ++r) o[d][r] *= al_l[crow(r, hi)]; } } while (0)
  f32x16 pA0, pA1, pB0, pB1; float mnA, mnB, alA, alB; bf16x8 pa0, pa1, pa2, pa3; const int NT = seq / KVBLK;
  constexpr int SE = 0, SO = SDEPTH - 1;
  SLOAD(SE, 0);
  const bf16* Qw = Qb + (long)(wid * QBLK + r32) * LDQ + hi * 8;
#pragma unroll
  for (int d0 = 0; d0 < 8; ++d0) qr[d0] = SQ::tobf(SQ::ld8(Qw + d0 * 16));
  {
    float xf[8][8]; float ss = 0.f;
#pragma unroll
    for (int d0 = 0; d0 < 8; ++d0)
#pragma unroll
      for (int j = 0; j < 8; ++j) { xf[d0][j] = __uint_as_float(((unsigned)(unsigned short)qr[d0][j]) << 16); ss += xf[d0][j] * xf[d0][j]; }
    { auto rr = __builtin_amdgcn_permlane32_swap(__float_as_uint(ss), __float_as_uint(ss), false, false); ss = __uint_as_float(rr[0]) + __uint_as_float(rr[1]); }
    const float rs = __builtin_amdgcn_rsqf(ss * (1.0f / 128.0f) + 1e-6f);
#pragma unroll
    for (int d0 = 0; d0 < 8; ++d0) { const float4 g0 = *(const float4*)(qgain + d0 * 16 + hi * 8), g1 = *(const float4*)(qgain + d0 * 16 + hi * 8 + 4);
      xf[d0][0] *= rs * g0.x; xf[d0][1] *= rs * g0.y; xf[d0][2] *= rs * g0.z; xf[d0][3] *= rs * g0.w; xf[d0][4] *= rs * g1.x; xf[d0][5] *= rs * g1.y; xf[d0][6] *= rs * g1.z; xf[d0][7] *= rs * g1.w; }
    if (cs) { const int t = t_first + wid * QBLK + r32, prow = t >> 6, pcol = t & 63;
#pragma unroll
      for (int d0 = 0; d0 < 4; ++d0) { const float* c8 = cs + ((d0 < 2 ? prow : pcol) * 32 + ((d0 & 1) * 16 + hi * 8)) * 2;
#pragma unroll
        for (int j4 = 0; j4 < 4; ++j4) { const float4 v = *(const float4*)(c8 + 4 * j4);
          { const float y1 = xf[d0][2 * j4], y2 = xf[d0 + 4][2 * j4]; xf[d0][2 * j4] = y1 * v.x - y2 * v.y; xf[d0 + 4][2 * j4] = y1 * v.y + y2 * v.x; }
          { const float y1 = xf[d0][2 * j4 + 1], y2 = xf[d0 + 4][2 * j4 + 1]; xf[d0][2 * j4 + 1] = y1 * v.z - y2 * v.w; xf[d0 + 4][2 * j4 + 1] = y1 * v.w + y2 * v.z; } } } }
#pragma unroll
    for (int d0 = 0; d0 < 8; ++d0) { u32x4 w = {cvtpk(xf[d0][0], xf[d0][1]), cvtpk(xf[d0][2], xf[d0][3]), cvtpk(xf[d0][4], xf[d0][5]), cvtpk(xf[d0][6], xf[d0][7])}; qr[d0] = *reinterpret_cast<bf16x8*>(&w); }
  }
  asm volatile("s_waitcnt vmcnt(0)" ::: "memory"); SWRITE(0, SE);
  if constexpr (SDEPTH == 1) SLOAD(SO, KVBLK);
  __syncthreads();
  qkt(pA0, pA1, K_lds, qr, r32, hi); partialSM(pA0, pA1, m_reg, mnA, alA);
  if constexpr (SDEPTH == 2) { SLOAD(SO, KVBLK); if (2 < NT) SLOAD(SE, 2 * KVBLK); }
  SWAIT(); SWRITE(1, SO); __syncthreads();
  if (wid >= 4) __builtin_amdgcn_s_setprio(1);
  for (int j = 1; j + 1 < NT; j += 2) {
    SBAR(); qkt(pB0, pB1, (bf16*)((char*)K_lds + SHM_K), qr, r32, hi);
    finishSM(pA0, pA1, alA, l_reg, pa0, pa1, pa2, pa3); SBAR();
    SLOAD(SO, (j + SDEPTH) * KVBLK); SBAR();
    pv_d0(o, vb0, pa0, pa1, pa2, pa3); partialSM(pB0, pB1, m_reg, mnB, alB);
    __syncthreads(); SWAIT(); SWRITE(0, SE);
    RESC(alB); __syncthreads();
    SBAR(); qkt(pA0, pA1, K_lds, qr, r32, hi);
    finishSM(pB0, pB1, alB, l_reg, pa0, pa1, pa2, pa3); SBAR();
    if (SDEPTH == 1 || j + 3 < NT) SLOAD(SE, (j + 1 + SDEPTH) * KVBLK); SBAR();
    pv_d0(o, vb0 + (int)SHM_V, pa0, pa1, pa2, pa3); partialSM(pA0, pA1, m_reg, mnA, alA);
    __syncthreads(); SWAIT(); SWRITE(1, SO);
    RESC(alA); __syncthreads();
  }
  SBAR(); qkt(pB0, pB1, (bf16*)((char*)K_lds + SHM_K), qr, r32, hi);
  finishSM(pA0, pA1, alA, l_reg, pa0, pa1, pa2, pa3); SBAR();
  pv_d0(o, vb0, pa0, pa1, pa2, pa3); partialSM(pB0, pB1, m_reg, mnB, alB);
  __syncthreads(); RESC(alB);
  finishSM(pB0, pB1, alB, l_reg, pa0, pa1, pa2, pa3); SBAR();
  pv_d0(o, vb0 + (int)SHM_V, pa0, pa1, pa2, pa3);
  __builtin_amdgcn_s_setprio(0);
  if (hi == 0) li_l[r32] = l_reg; asm volatile("s_waitcnt lgkmcnt(0)" ::: "memory");
  float rli[16];
#pragma unroll
  for (int r = 0; r < 16; ++r) rli[r] = __builtin_amdgcn_rcpf(li_l[crow(r, hi)]);
  __syncthreads();
  int lane_e = lane; asm volatile("" : "+v"(lane_e));
  bf16* stg = (bf16*)lds + wid * (QBLK * D);
#pragma unroll
  for (int r = 0; r < 16; ++r) { const int orow = crow(r, hi);
#pragma unroll
    for (int d0 = 0; d0 < 4; ++d0) stg[orow * D + d0 * 32 + r32] = (bf16)(cvtpk(o[d0][r] * rli[r], 0.f) & 0xffffu); }
  asm volatile("s_waitcnt lgkmcnt(0)" ::: "memory");
  bf16* Ow = Ob + (long)(wid * QBLK) * LDO;
#pragma unroll
  for (int i = 0; i < 8; ++i) { const int row = i * 4 + (lane_e >> 4), ch = lane_e & 15; const u32x4 v = *(const u32x4*)(stg + row * D + ch * 8); *(u32x4*)(Ow + (long)row * LDO + ch * 8) = v; }
  __syncthreads();
#undef SLOAD
#undef SWRITE
#undef SWAIT
#undef RESC
}
#undef KSWZ
#undef SBAR
}
namespace ac {
using aa::bf16; using aa::bf16x8; using aa::s16x4; using aa::f32x16; using aa::u32x4; using aa::crow; using aa::cvtpk; using aa::tr_read; using aa::v_rd_base;
constexpr int D = 64, KVBLK = 64, KVW = 128, LDQ = 1280;
constexpr float SCALE = 0.125f, THR = 8.f, NEG = -1e30f;
constexpr int SHM_K = KVBLK * D * 2, SHM_V = KVBLK * D * 2;
constexpr int LDS_K = 0, LDS_V = 2 * SHM_K, LDS_WS = 2 * SHM_K + 2 * SHM_V, LDS_OST = 0;
#define CSBAR() __builtin_amdgcn_sched_barrier(0)
__device__ __forceinline__ int kswz(int row, int chunk) { return row * 128 + ((chunk ^ ((row >> 1) & 7)) << 4); }
__device__ __forceinline__ int v_st64(int k, int c) { const int kk = (k & ~0xC) | ((k & 4) << 1) | ((k & 8) >> 1); return ((kk >> 3) * 2 + (c >> 5)) * 512 + ((kk & 7) * 32 + (c & 31)) * 2; }
constexpr int v_rd_off64(int d0, int ks, int half) { return d0 * 512 + ks * 2048 + half * 1024; }
__device__ __forceinline__ void partialSM(f32x16& p0, f32x16& p1, float& m_reg, float& alpha) {
  constexpr float C = SCALE * 1.4426950408889634f;
  float pmax = p0[0]; for (int r = 1; r < 16; ++r) pmax = fmaxf(pmax, p0[r]); for (int r = 0; r < 16; ++r) pmax = fmaxf(pmax, p1[r]);
  { auto rr = __builtin_amdgcn_permlane32_swap(__float_as_uint(pmax), __float_as_uint(pmax), false, false);
    pmax = fmaxf(__uint_as_float(rr[0]), __uint_as_float(rr[1])); }
  float mn;
  if (__builtin_expect(__all(pmax - m_reg <= THR / SCALE), 1)) { mn = m_reg; alpha = 1.f; }
  else { mn = fmaxf(m_reg, pmax); alpha = __builtin_amdgcn_exp2f((m_reg - mn) * C); m_reg = mn; }
  const float mnC = -mn * C;
  for (int r = 0; r < 16; ++r) p0[r] = fmaf(p0[r], C, mnC); for (int r = 0; r < 16; ++r) p1[r] = fmaf(p1[r], C, mnC);
  for (int r = 0; r < 16; ++r) p0[r] = __builtin_amdgcn_exp2f(p0[r]); for (int r = 0; r < 16; ++r) p1[r] = __builtin_amdgcn_exp2f(p1[r]);
}
__device__ __forceinline__ void finishSM(f32x16& p0, f32x16& p1, float alpha, float& l_reg, bf16x8& pa0, bf16x8& pa1, bf16x8& pa2, bf16x8& pa3) {
  float ps = 0; for (int r = 0; r < 16; ++r) ps += p0[r]; for (int r = 0; r < 16; ++r) ps += p1[r];
  { auto rr = __builtin_amdgcn_permlane32_swap(__float_as_uint(ps), __float_as_uint(ps), false, false);
    ps = __uint_as_float(rr[0]) + __uint_as_float(rr[1]); }
  l_reg = l_reg * alpha + ps;
#define PK4(P, BASE, OUT) do { unsigned a0 = cvtpk(P[BASE + 0], P[BASE + 1]), a1 = cvtpk(P[BASE + 2], P[BASE + 3]);   \
    unsigned b0 = cvtpk(P[BASE + 4], P[BASE + 5]), b1 = cvtpk(P[BASE + 6], P[BASE + 7]);                              \
    auto r0 = __builtin_amdgcn_permlane32_swap(a0, b0, false, false); auto r1 = __builtin_amdgcn_permlane32_swap(a1, b1, false, false); \
    u32x4 w = {r0[0], r1[0], r0[1], r1[1]}; OUT = *reinterpret_cast<bf16x8*>(&w); } while (0)
  PK4(p0, 0, pa0); PK4(p0, 8, pa1); PK4(p1, 0, pa2); PK4(p1, 8, pa3);
#undef PK4
}
__device__ __forceinline__ void qkt(f32x16& p0, f32x16& p1, const char* Ks, const bf16x8* qr, int r32, int hi) {
  p0 = f32x16{}; p1 = f32x16{};
#pragma unroll
  for (int d0 = 0; d0 < 4; ++d0) { const int ch = d0 * 2 + hi;
    const bf16x8 b0 = *reinterpret_cast<const bf16x8*>(Ks + kswz(r32, ch));
    const bf16x8 b1 = *reinterpret_cast<const bf16x8*>(Ks + kswz(32 + r32, ch));
    p0 = __builtin_amdgcn_mfma_f32_32x32x16_bf16(b0, qr[d0], p0, 0, 0, 0);
    p1 = __builtin_amdgcn_mfma_f32_32x32x16_bf16(b1, qr[d0], p1, 0, 0, 0); }
}
template <int D0> __device__ __forceinline__ void pv_one(f32x16& od, int vb, bf16x8 pa0, bf16x8 pa1, bf16x8 pa2, bf16x8 pa3) {
  const s16x4 l0 = tr_read<v_rd_off64(D0, 0, 0)>(vb), h0 = tr_read<v_rd_off64(D0, 0, 1)>(vb), l1 = tr_read<v_rd_off64(D0, 1, 0)>(vb), h1 = tr_read<v_rd_off64(D0, 1, 1)>(vb);
  const s16x4 l2 = tr_read<v_rd_off64(D0, 2, 0)>(vb), h2 = tr_read<v_rd_off64(D0, 2, 1)>(vb), l3 = tr_read<v_rd_off64(D0, 3, 0)>(vb), h3 = tr_read<v_rd_off64(D0, 3, 1)>(vb);
  asm volatile("s_waitcnt lgkmcnt(0)" ::: "memory"); CSBAR();
#define PK(L, H) (bf16x8){L[0], L[1], L[2], L[3], H[0], H[1], H[2], H[3]}
  od = __builtin_amdgcn_mfma_f32_32x32x16_bf16(pa0, PK(l0, h0), od, 0, 0, 0);
  od = __builtin_amdgcn_mfma_f32_32x32x16_bf16(pa1, PK(l1, h1), od, 0, 0, 0);
  od = __builtin_amdgcn_mfma_f32_32x32x16_bf16(pa2, PK(l2, h2), od, 0, 0, 0);
  od = __builtin_amdgcn_mfma_f32_32x32x16_bf16(pa3, PK(l3, h3), od, 0, 0, 0);
#undef PK
}
__device__ __forceinline__ void unit(const bf16* __restrict__ Qh, const bf16* __restrict__ Kb, const bf16* __restrict__ Vb, int rc, int rl, bf16* __restrict__ Oh, int t0, float sink_l2, char* lds, const int tid, const float* __restrict__ cs) {
  const int wid = __builtin_amdgcn_readfirstlane(tid >> 6), lane = tid & 63, r32 = lane & 31, hi = lane >> 5;
  char* K_lds = lds + LDS_K; char* V_lds = lds + LDS_V;
  float* wsf = (float*)(lds + LDS_WS) + wid * 64; float* li_l = wsf; float* al_l = wsf + 32;
  float m_reg = -1e30f, l_reg = 0.f; f32x16 o[2] = {}; bf16x8 qr[4];
#pragma unroll
  for (int d0 = 0; d0 < 4; ++d0) qr[d0] = *reinterpret_cast<const bf16x8*>(Qh + (long)r32 * LDQ + d0 * 16 + hi * 8);
  if (t0 >= 0) {
    const int t = t0 + r32, prow = t >> 6, pcol = t & 63;
#pragma unroll
    for (int d0 = 0; d0 < 2; ++d0) { const float* c8 = cs + ((d0 == 0 ? prow : pcol) * 16 + hi * 8) * 2;
      float a[8], b[8];
#pragma unroll
      for (int j = 0; j < 8; ++j) { a[j] = __uint_as_float(((unsigned)(unsigned short)qr[d0][j]) << 16); b[j] = __uint_as_float(((unsigned)(unsigned short)qr[d0 + 2][j]) << 16); }
#pragma unroll
      for (int j4 = 0; j4 < 4; ++j4) { const float4 v = *(const float4*)(c8 + 4 * j4);
        { const float y1 = a[2 * j4], y2 = b[2 * j4]; a[2 * j4] = y1 * v.x - y2 * v.y; b[2 * j4] = y1 * v.y + y2 * v.x; }
        { const float y1 = a[2 * j4 + 1], y2 = b[2 * j4 + 1]; a[2 * j4 + 1] = y1 * v.z - y2 * v.w; b[2 * j4 + 1] = y1 * v.w + y2 * v.z; } }
      u32x4 wa = {cvtpk(a[0], a[1]), cvtpk(a[2], a[3]), cvtpk(a[4], a[5]), cvtpk(a[6], a[7])}, wb = {cvtpk(b[0], b[1]), cvtpk(b[2], b[3]), cvtpk(b[4], b[5]), cvtpk(b[6], b[7])};
      qr[d0] = *reinterpret_cast<bf16x8*>(&wa); qr[d0 + 2] = *reinterpret_cast<bf16x8*>(&wb); }
  }
  const int skey = tid >> 3, sch = tid & 7;
  const int kst = kswz(skey, sch), vst = v_st64(skey, sch * 8);
  const int vb0 = (int)(uintptr_t)V_lds + v_rd_base(lane);
  const int lo = t0 - WINDOW < 0 ? 0 : t0 - WINDOW, hiq = t0 + 31 + WINDOW > SEQ - 1 ? SEQ - 1 : t0 + 31 + WINDOW;
  const int NT = t0 < 0 ? 4 : 9;
#define TILE_S0(j) (t0 - WINDOW + 64 * ((j) - 4))
#define TILE_OK(j) ((j) < 4 || (TILE_S0(j) + 63 >= lo && TILE_S0(j) <= hiq))
#define KVROW(j) ((j) < 4 ? 64 * (j) + skey : CTXL + min(max(TILE_S0(j) + skey, 0), SEQ - 1))
  bf16x8 sk, sv, sk2, sv2;
#define SLOAD(j) do { const long row_ = KVROW(j); sk = *reinterpret_cast<const bf16x8*>(Kb + row_ * KVW + sch * 8); sv = *reinterpret_cast<const bf16x8*>(Vb + (row_ < CTXL ? rc + row_ : rl + row_ - CTXL) * LDQ + sch * 8); } while (0)
#define SLOAD2(j) do { const long row_ = KVROW(j); sk2 = *reinterpret_cast<const bf16x8*>(Kb + row_ * KVW + sch * 8); sv2 = *reinterpret_cast<const bf16x8*>(Vb + (row_ < CTXL ? rc + row_ : rl + row_ - CTXL) * LDQ + sch * 8); } while (0)
#define SWRITE(b) do { *(bf16x8*)(K_lds + (b) * SHM_K + kst) = sk; *(bf16x8*)(V_lds + (b) * SHM_V + vst) = sv; } while (0)
  SLOAD(0); SWRITE(0); __syncthreads();
  { int j1 = 1; while (j1 < NT && !TILE_OK(j1)) ++j1; if (j1 < NT) SLOAD(j1); }
  int buf = 0;
  for (int j = 0; j < NT; ++j) {
    if (!TILE_OK(j)) continue;
    int jn = j + 1; while (jn < NT && !TILE_OK(jn)) ++jn;
    int j2 = jn + 1; while (j2 < NT && !TILE_OK(j2)) ++j2;
    if (j2 < NT) SLOAD2(j2);
    f32x16 p0, p1; float alpha; bf16x8 pa0, pa1, pa2, pa3;
    qkt(p0, p1, K_lds + buf * SHM_K, qr, r32, hi);
    if (j >= 4 && (TILE_S0(j) < 0 || TILE_S0(j) + 63 >= SEQ || TILE_S0(j) < t0 + 31 - WINDOW || TILE_S0(j) + 63 > t0 + WINDOW)) {
      const int s0 = TILE_S0(j), t = t0 + r32;
#pragma unroll
      for (int r = 0; r < 16; ++r) { const int sA = s0 + crow(r, hi), sB = sA + 32;
        if (sA < 0 || sA >= SEQ || sA - t > WINDOW || t - sA > WINDOW) p0[r] = NEG;
        if (sB < 0 || sB >= SEQ || sB - t > WINDOW || t - sB > WINDOW) p1[r] = NEG; }
    }
    partialSM(p0, p1, m_reg, alpha);
    if (__any(alpha < 1.f)) { if (hi == 0) al_l[r32] = alpha; asm volatile("s_waitcnt lgkmcnt(0)" ::: "memory");
#pragma unroll
      for (int d = 0; d < 2; ++d)
#pragma unroll
        for (int r = 0; r < 16; ++r) o[d][r] *= al_l[crow(r, hi)]; }
    finishSM(p0, p1, alpha, l_reg, pa0, pa1, pa2, pa3); CSBAR();
    pv_one<0>(o[0], vb0 + buf * SHM_V, pa0, pa1, pa2, pa3); pv_one<1>(o[1], vb0 + buf * SHM_V, pa0, pa1, pa2, pa3);
    if (jn < NT) { SWRITE(buf ^ 1); }
    __syncthreads();
    sk = sk2; sv = sv2;
    buf ^= 1;
  }
  l_reg += __builtin_amdgcn_exp2f(sink_l2 - m_reg * (SCALE * 1.4426950408889634f));
  if (hi == 0) li_l[r32] = l_reg; asm volatile("s_waitcnt lgkmcnt(0)" ::: "memory");
  float rli[16];
#pragma unroll
  for (int r = 0; r < 16; ++r) rli[r] = __builtin_amdgcn_rcpf(li_l[crow(r, hi)]);
  bf16* stg = (bf16*)(lds + LDS_OST) + wid * (32 * D);
#pragma unroll
  for (int r = 0; r < 16; ++r) { const int orow = crow(r, hi);
#pragma unroll
    for (int d0 = 0; d0 < 2; ++d0) stg[orow * D + d0 * 32 + r32] = (bf16)(cvtpk(o[d0][r] * rli[r], 0.f) & 0xffffu); }
  asm volatile("s_waitcnt lgkmcnt(0)" ::: "memory");
#pragma unroll
  for (int i = 0; i < 4; ++i) { const int row = i * 8 + (lane >> 3), ch = lane & 7; const u32x4 v = *(const u32x4*)(stg + row * D + ch * 8); *(u32x4*)(Oh + (long)row * 1024 + ch * 8) = v; }
  __syncthreads();
#undef TILE_S0
#undef TILE_OK
#undef KVROW
#undef SLOAD
#undef SLOAD2
#undef SWRITE
}
#undef CSBAR
}

struct Args { const float* in[N_IN]; float* out; unsigned char* ws; int ph_lo, ph_hi, single, pad; };
struct Frame {
    LAS unsigned char* lds;
    unsigned char* ldsg;
    volatile LAS unsigned* MISC;
    gu32* ctl;
    int tid, lane, wave, vcu, G, bx;
    LAS unsigned long long* intab;
    float* out; unsigned char* ws;
    __device__ __forceinline__ const float* inp(int i) const { const unsigned long long v = intab[i];
        const unsigned lo = __builtin_amdgcn_readfirstlane((unsigned)v), hi = __builtin_amdgcn_readfirstlane((unsigned)(v >> 32));
        return (const float*)(GAS const float*)(((unsigned long long)hi << 32) | lo); }
};
__device__ __forceinline__ float bf2f(unsigned h) { return __uint_as_float(h << 16); }
#define SWZ_XOR(v, o) __int_as_float(__builtin_amdgcn_ds_swizzle(__float_as_int(v), ((o) << 10) | 0x1f))
#define DPP_F(v, ctrl) __int_as_float(__builtin_amdgcn_mov_dpp(__float_as_int(v), (ctrl), 0xf, 0xf, false))
__device__ __forceinline__ float wave_sum(float v) {
    v += DPP_F(v, 0xB1); v += DPP_F(v, 0x4E); v += DPP_F(v, 0x124); v += DPP_F(v, 0x128); v += SWZ_XOR(v, 16);
    const auto rr = __builtin_amdgcn_permlane32_swap(__float_as_uint(v), __float_as_uint(v), false, false);
    return __uint_as_float(rr[0]) + __uint_as_float(rr[1]);
}
__device__ __forceinline__ float wave_max(float v) {
    v = fmaxf(v, SWZ_XOR(v, 1)); v = fmaxf(v, SWZ_XOR(v, 2)); v = fmaxf(v, SWZ_XOR(v, 4)); v = fmaxf(v, SWZ_XOR(v, 8)); v = fmaxf(v, SWZ_XOR(v, 16));
    const auto rr = __builtin_amdgcn_permlane32_swap(__float_as_uint(v), __float_as_uint(v), false, false);
    return fmaxf(__uint_as_float(rr[0]), __uint_as_float(rr[1]));
}
typedef float f32x2 __attribute__((ext_vector_type(2)));
__device__ __forceinline__ float lane_bcast(float v, int k) { return __int_as_float(__builtin_amdgcn_readlane(__float_as_int(v), k)); }
__device__ __forceinline__ float silu_f(float x) { return x / (1.0f + expf(-x)); }
__device__ __forceinline__ float* hrow_ctx(const Frame& F, int r) { return (float*)(F.ws + WS_HCTX) + (size_t)(r - MLAT) * DM; }
__device__ __forceinline__ bf16* hrow_lat(const Frame& F, int r) { return (bf16*)(F.ws + WS_HB) + (size_t)r * DM; }
__device__ __forceinline__ const float* modvec(const Frame& F, int layer, int r) { const int idx = r < MLAT ? layer * 4 + r / SEQ : 16 + layer; return (const float*)(F.ws + WS_MOD) + (size_t)idx * (NMOD * DM); }

__device__ __forceinline__ void p0_transpose_item(const float* W, int K, int N, bf16* WT, LAS float* scr, int item, int lane, bool gate_up) {
    const int nblk = N / 64, kb = item / nblk, nb = item % nblk, k0 = 64 * kb, n0 = 64 * nb;
    const int n0d = gate_up ? (n0 < DFF ? (n0 / 128) * 256 + (n0 % 128) : ((n0 - DFF) / 128) * 256 + 128 + ((n0 - DFF) % 128)) : n0;
    const float* src = W + (size_t)k0 * N + n0 + lane;
    float ld_[64];
#pragma unroll
    for (int i = 0; i < 64; ++i) ld_[i] = __builtin_nontemporal_load(src + (size_t)i * N);
#pragma unroll
    for (int i = 0; i < 64; ++i) scr[i * 65 + lane] = ld_[i];
    LDS_WAIT(); asm volatile("" ::: "memory");
    const int c = lane & 7;
#pragma unroll
    for (int j = 0; j < 8; ++j) { const int n = (lane >> 3) + 8 * j; const LAS float* s = scr + (8 * c) * 65 + n;
        v4u o; o.x = pk2(s[0 * 65], s[1 * 65]); o.y = pk2(s[2 * 65], s[3 * 65]); o.z = pk2(s[4 * 65], s[5 * 65]); o.w = pk2(s[6 * 65], s[7 * 65]);
        *(GAS v4u*)(WT + (size_t)(n0d + n) * K + k0 + 8 * c) = o; }
    LDS_WAIT(); asm volatile("" ::: "memory");
}
__device__ __forceinline__ void p0_filters(Frame& F, int slot, int nslots) {
    LAS float* WB = (LAS float*)F.lds;
    const float* w1 = F.inp(I_FW1); const float* w2 = F.inp(I_FW2); const float* w3 = F.inp(I_FW3); const float* w4 = F.inp(I_FW4);
    const float bb1 = F.inp(I_FB1)[F.lane], bb2 = F.inp(I_FB2)[F.lane], bb3 = F.inp(I_FB3)[F.lane];
    const float r0 = -15.350567286626973f, r1 = -3.0701134573253945f;
    for (int it = slot; it < (SEQ + CTXL) / 32; it += nslots) {
        const int pos0 = it * 32 + F.wave * 4; const bool lat = pos0 < SEQ; const int L = lat ? SEQ : CTXL, t0 = lat ? pos0 : pos0 - SEQ;
        float* Hc = (float*)(F.ws + WS_HCCTX);
        f32x4 stg[8];
#define W4_LOAD(c_) do { _Pragma("unroll") for (int e_ = 0; e_ < 8; ++e_) { const int q_ = F.tid + e_ * NTHREADS, k_ = q_ >> 6, c4_ = q_ & 63; stg[e_] = *((const f32x4*)(w4 + (size_t)k_ * (2 * DM) + (c_) * 256) + c4_); } } while (0)
#define W4_STORE(buf_) do { _Pragma("unroll") for (int e_ = 0; e_ < 8; ++e_) *((LAS f32x4*)(WB + (buf_) * 16384) + F.tid + e_ * NTHREADS) = stg[e_]; } while (0)
        float f[4], tn[4], zv[4];
#pragma unroll
        for (int q = 0; q < 4; ++q) {
            const int t = t0 + q;
            tn[q] = (float)t / (float)(L - 1);
            const float omega = (6.283185307179586f / (float)L) * (float)t;
            zv[q] = 0.f;
            { const int k = F.lane;
              if (k == 0) zv[q] = tn[q];
              else if (k <= 32) { const int kb = (k - 1) & 15; const float band = 1e-4f + (float)kb * ((15.0f - 1e-4f) / 15.0f); const float ang = omega * band; zv[q] = (k <= 16) ? cosf(ang) : -sinf(ang); } }
        }
        {
            float wr_[16], a_[4];
#define MLP_PART(W_, k0_, n_, in_) do { GAS const float* wb_ = (GAS const float*)((W_) + (k0_) * 64); asm volatile("" : "+s"(wb_)); \
                _Pragma("unroll") for (int k = 0; k < (n_); ++k) wr_[k] = wb_[k * 64 + F.lane]; \
                _Pragma("unroll") for (int q = 0; q < 4; ++q) { _Pragma("unroll") for (int k = 0; k < (n_); ++k) a_[q] += lane_bcast((in_)[q], (k0_) + k) * wr_[k]; } } while (0)
#pragma unroll
            for (int q = 0; q < 4; ++q) a_[q] = bb1;
            MLP_PART(w1, 0, 16, zv); MLP_PART(w1, 16, 16, zv); MLP_PART(w1, 32, 1, zv);
#pragma unroll
            for (int q = 0; q < 4; ++q) { f[q] = sinf(a_[q]); a_[q] = bb2; }
            MLP_PART(w2, 0, 16, f); MLP_PART(w2, 16, 16, f); MLP_PART(w2, 32, 16, f); MLP_PART(w2, 48, 16, f);
#pragma unroll
            for (int q = 0; q < 4; ++q) { zv[q] = sinf(a_[q]); a_[q] = bb3; }
            MLP_PART(w3, 0, 16, zv); MLP_PART(w3, 16, 16, zv); MLP_PART(w3, 32, 16, zv); MLP_PART(w3, 48, 16, zv);
#pragma unroll
            for (int q = 0; q < 4; ++q) f[q] = sinf(a_[q]);
#undef MLP_PART
        }
        W4_LOAD(0);
        W4_STORE(0);
        __syncthreads();
        for (int c = 0; c < 8; ++c) {
            if (c + 1 < 8) W4_LOAD(c + 1);
            const LAS float* wb = WB + (c & 1) * 16384 + 4 * F.lane;
            f32x2 acc[4][2];
#pragma unroll
            for (int q = 0; q < 4; ++q) { acc[q][0] = (f32x2){0.f, 0.f}; acc[q][1] = (f32x2){0.f, 0.f}; }
#pragma unroll 4
            for (int k = 0; k < 64; ++k) { const f32x4 w = *(const LAS f32x4*)(wb + k * 256); const f32x2 wlo = {w[0], w[1]}, whi = {w[2], w[3]};
#pragma unroll
                for (int q = 0; q < 4; ++q) { const float fk = lane_bcast(f[q], k); const f32x2 f2 = {fk, fk}; acc[q][0] = __builtin_elementwise_fma(wlo, f2, acc[q][0]); acc[q][1] = __builtin_elementwise_fma(whi, f2, acc[q][1]); } }
            f32x4 val[4];
#pragma unroll
            for (int j = 0; j < 4; ++j) { const int d = (c * 256 + 4 * F.lane + j) & (DM - 1);
                const float rate = fabsf(r0 + (float)d * ((r1 - r0) / (float)(DM - 1)));
#pragma unroll
                for (int q = 0; q < 4; ++q) val[j][q] = acc[q][j >> 1][j & 1] * expf(-tn[q] * rate); }
            const bool fwd = c < 4;
            const int d0 = (c * 256 + 4 * F.lane) & (DM - 1);
            if (lat) {
#pragma unroll
                for (int j = 0; j < 4; ++j) { float* dst = (float*)(F.ws + WS_HCLAT) + (fwd ? (size_t)0 : (size_t)DM * SEQ) + (size_t)(d0 + j) * SEQ + t0; *(f32x4*)dst = val[j]; }
            } else {
#pragma unroll
                for (int q = 0; q < 4; ++q) { const int t = t0 + q; const f32x4 o = {val[0][q], val[1][q], val[2][q], val[3][q]};
                    if (fwd) *(f32x4*)(Hc + (size_t)(t + L - 1) * DM + d0) = o;
                    else if (t >= 1) *(f32x4*)(Hc + (size_t)(L - 1 - t) * DM + d0) = o; } }
            if (c + 1 < 8) W4_STORE((c + 1) & 1);
            __syncthreads();
        }
#undef W4_LOAD
#undef W4_STORE
    }
}

__device__ __forceinline__ void transpose_group(Frame& F, unsigned mask, int slot0, int nmine, int nslots) {
    LAS float* scr = (LAS float*)(F.lds + F.wave * (64 * 65 * 4));
    for (int s = 0; s < nmine; ++s)
    for (int gi = (slot0 + s) * NWAVES + F.wave;; gi += nslots * NWAVES) {
        int base = 0, mat = 0, items = 0; const float* src = nullptr; bf16* dst = nullptr; int K = DM, N = DM; bool found = false;
        for (; mat < 17; ++mat) {
            if (!((mask >> mat) & 1u)) continue;
            if (mat < 2)       { src = F.inp(I_AQKV) + (size_t)mat * DM * A_COLS; dst = (bf16*)(F.ws + WS_W_AQKV) + (size_t)mat * A_COLS * DM; K = DM; N = A_COLS; }
            else if (mat < 4)  { src = F.inp(I_AOUT) + (size_t)(mat - 2) * DM * DM; dst = (bf16*)(F.ws + WS_W_AOUT) + (size_t)(mat - 2) * DM * DM; K = DM; N = DM; }
            else if (mat == 4) { src = F.inp(I_BIN); dst = (bf16*)(F.ws + WS_W_BIN); K = DM; N = 3 * DM; }
            else if (mat == 5) { src = F.inp(I_BOUT); dst = (bf16*)(F.ws + WS_W_BOUT); K = DM; N = DM; }
            else if (mat == 6) { src = F.inp(I_CQKV); dst = (bf16*)(F.ws + WS_W_CQKV); K = DM; N = C_COLS; }
            else if (mat == 7) { src = F.inp(I_COUT); dst = (bf16*)(F.ws + WS_W_COUT); K = DM; N = DM; }
            else if (mat < 12) { src = F.inp(I_WUP) + (size_t)(mat - 8) * DM * 2 * DFF; dst = (bf16*)(F.ws + WS_W_UP) + (size_t)(mat - 8) * 2 * DFF * DM; K = DM; N = 2 * DFF; }
            else if (mat < 16) { src = F.inp(I_WDOWN) + (size_t)(mat - 12) * DFF * DM; dst = (bf16*)(F.ws + WS_W_DOWN) + (size_t)(mat - 12) * DM * DFF; K = DFF; N = DM; }
            else               { src = F.inp(I_FW4); dst = (bf16*)(F.ws + WS_W4T); K = 64; N = 2 * DM; }
            items = (K / 64) * (N / 64);
            if (gi < base + items) { found = true; break; }
            base += items;
        }
        if (!found) break;
        p0_transpose_item(src, K, N, dst, scr, gi - base, F.lane, mat >= 8 && mat < 12);
    }
}
constexpr unsigned TG_P0 = (1u << 0) | (1u << 4) | (1u << 16);
constexpr unsigned TG_L0 = (1u << 2) | (1u << 8) | (1u << 12);
constexpr unsigned TG_L1 = (1u << 5) | (1u << 9) | (1u << 13) | (1u << 6);
constexpr unsigned TG_L2 = (1u << 7) | (1u << 10) | (1u << 14) | (1u << 1);
constexpr unsigned TG_L3 = (1u << 3) | (1u << 11) | (1u << 15);
static_assert((TG_P0 | TG_L0 | TG_L1 | TG_L2 | TG_L3) == 0x1ffffu && (TG_P0 ^ TG_L0 ^ TG_L1 ^ TG_L2 ^ TG_L3) == 0x1ffffu, "every matrix exactly once");
__device__ __forceinline__ void filters_mfma(Frame& F, int slot, int nslots) {
    LAS unsigned short* FA = (LAS unsigned short*)F.lds;
    const float* w1 = F.inp(I_FW1); const float* w2 = F.inp(I_FW2); const float* w3 = F.inp(I_FW3);
    const bf16* W4T = (const bf16*)(F.ws + WS_W4T);
    const float bb1 = F.inp(I_FB1)[F.lane], bb2 = F.inp(I_FB2)[F.lane], bb3 = F.inp(I_FB3)[F.lane];
    const float r0 = -15.350567286626973f, r1 = -3.0701134573253945f;
    const int l15 = F.lane & 15, lg = F.lane >> 4;
    for (int it = slot; it < (SEQ + CTXL) / 32; it += nslots) {
        const int posb = it * 32; const bool lat = posb < SEQ; const int L = lat ? SEQ : CTXL, tb = lat ? posb : posb - SEQ, t0 = tb + F.wave * 4;
        float* Hc = (float*)(F.ws + WS_HCCTX);
        const float inv_lm1 = 1.0f / (float)(L - 1);
        float f[4], zv[4];
#pragma unroll
        for (int q = 0; q < 4; ++q) {
            const int t = t0 + q;
            const float tnq = (float)t / (float)(L - 1);
            const float omega = (6.283185307179586f / (float)L) * (float)t;
            zv[q] = 0.f;
            { const int k = F.lane;
              if (k == 0) zv[q] = tnq;
              else if (k <= 32) { const int kb = (k - 1) & 15; const float band = 1e-4f + (float)kb * ((15.0f - 1e-4f) / 15.0f); const float ang = omega * band; zv[q] = (k <= 16) ? cosf(ang) : -sinf(ang); } }
        }
        {
            float wr_[16], a_[4];
#define MLP_PART(W_, k0_, n_, in_) do { GAS const float* wb_ = (GAS const float*)((W_) + (k0_) * 64); asm volatile("" : "+s"(wb_)); \
                _Pragma("unroll") for (int k = 0; k < (n_); ++k) wr_[k] = wb_[k * 64 + F.lane]; \
                _Pragma("unroll") for (int q = 0; q < 4; ++q) { _Pragma("unroll") for (int k = 0; k < (n_); ++k) a_[q] += lane_bcast((in_)[q], (k0_) + k) * wr_[k]; } } while (0)
#pragma unroll
            for (int q = 0; q < 4; ++q) a_[q] = bb1;
            MLP_PART(w1, 0, 16, zv); MLP_PART(w1, 16, 16, zv); MLP_PART(w1, 32, 1, zv);
#pragma unroll
            for (int q = 0; q < 4; ++q) { f[q] = sinf(a_[q]); a_[q] = bb2; }
            MLP_PART(w2, 0, 16, f); MLP_PART(w2, 16, 16, f); MLP_PART(w2, 32, 16, f); MLP_PART(w2, 48, 16, f);
#pragma unroll
            for (int q = 0; q < 4; ++q) { zv[q] = sinf(a_[q]); a_[q] = bb3; }
            MLP_PART(w3, 0, 16, zv); MLP_PART(w3, 16, 16, zv); MLP_PART(w3, 32, 16, zv); MLP_PART(w3, 48, 16, zv);
#pragma unroll
            for (int q = 0; q < 4; ++q) f[q] = sinf(a_[q]);
#undef MLP_PART
        }
#pragma unroll
        for (int q = 0; q < 4; ++q) FA[(F.wave * 4 + q) * 64 + F.lane] = (unsigned short)f2bf(f[q]);
        __syncthreads();
        bf16x8 A[2][2];
#pragma unroll
        for (int mt = 0; mt < 2; ++mt)
#pragma unroll
            for (int ks = 0; ks < 2; ++ks) A[mt][ks] = *(const LAS bf16x8*)(FA + (mt * 16 + l15) * 64 + ks * 32 + lg * 8);
        const bool fwd = F.wave < 4;
        for (int nt = 0; nt < 16; ++nt) {
            const int n2 = F.wave * 256 + nt * 16 + l15, d = n2 & (DM - 1);
            const bf16x8 B0 = *(const GAS bf16x8*)(W4T + (size_t)n2 * 64 + lg * 8), B1 = *(const GAS bf16x8*)(W4T + (size_t)n2 * 64 + 32 + lg * 8);
            const float rate2 = fabsf(r0 + (float)d * ((r1 - r0) / (float)(DM - 1))) * 1.4426950408889634f;
#pragma unroll
            for (int mt = 0; mt < 2; ++mt) {
                f32x4 acc = {0.f, 0.f, 0.f, 0.f};
                acc = __builtin_amdgcn_mfma_f32_16x16x32_bf16(A[mt][0], B0, acc, 0, 0, 0);
                acc = __builtin_amdgcn_mfma_f32_16x16x32_bf16(A[mt][1], B1, acc, 0, 0, 0);
                const int tq = tb + mt * 16 + lg * 4;
                f32x4 val;
#pragma unroll
                for (int r = 0; r < 4; ++r) val[r] = acc[r] * __builtin_amdgcn_exp2f(-((float)(tq + r) * inv_lm1) * rate2);
                if (lat) { float* dst = (float*)(F.ws + WS_HCLAT) + (fwd ? (size_t)0 : (size_t)DM * SEQ) + (size_t)d * SEQ + tq; *(f32x4*)dst = val; }
                else {
#pragma unroll
                    for (int r = 0; r < 4; ++r) { const int t = tq + r;
                        if (fwd) Hc[(size_t)(t + L - 1) * DM + d] = val[r];
                        else if (t >= 1) Hc[(size_t)(L - 1 - t) * DM + d] = val[r]; } }
            }
        }
        __syncthreads();
    }
}
__device__ __forceinline__ void p0_gemv(Frame& F, int lo, int hi, int slot, int nslots) {
    LAS float* S = (LAS float*)F.lds;
    for (int e = F.tid; e < 5 * DM; e += NTHREADS) { const int v = e / DM, k = e % DM; const float x = v < 4 ? F.inp(I_C)[v * DM + k] : F.inp(I_CCTX)[k]; S[e] = silu_f(x); }
    __syncthreads();
    LAS float* RED4 = (LAS float*)(F.lds + 32768);
    const int hl = F.lane >> 5, c4 = F.lane & 31;
    for (int it = lo + slot; it < hi; it += nslots) {
        const int layer = it / 48, cb = it % 48;
        const f32x4* W = (const f32x4*)(F.inp(I_MODW) + (size_t)layer * DM * (NMOD * DM) + cb * 128) + c4;
        f32x4 a0 = {0.f, 0.f, 0.f, 0.f}, a1 = a0, a2 = a0, a3 = a0, a4 = a0;
        const int k0 = F.wave * 128 + hl;
#pragma unroll 16
        for (int k = k0; k < k0 + 128; k += 2) { const f32x4 w = __builtin_nontemporal_load(W + (size_t)k * (NMOD * DM / 4)); a0 += w * S[k]; a1 += w * S[DM + k]; a2 += w * S[2 * DM + k]; a3 += w * S[3 * DM + k]; a4 += w * S[4 * DM + k]; }
        LAS f32x4* R4 = (LAS f32x4*)RED4 + (F.wave * 5) * 64 + F.lane;
        R4[0] = a0; R4[64] = a1; R4[128] = a2; R4[192] = a3; R4[256] = a4;
        __syncthreads();
        for (int e = F.tid; e < 5 * 128; e += NTHREADS) { const int v = e >> 7, l = e & 127; float s = 0.f;
#pragma unroll
            for (int w = 0; w < 8; ++w) s += RED4[(w * 5 + v) * 256 + l] + RED4[(w * 5 + v) * 256 + 128 + l];
            s += F.inp(I_MODB)[layer * (NMOD * DM) + cb * 128 + l];
            const int idx = v < 4 ? layer * 4 + v : 16 + layer;
            ((float*)(F.ws + WS_MOD))[(size_t)idx * (NMOD * DM) + cb * 128 + l] = s; }
        __syncthreads();
    }
    __syncthreads();
}
__device__ __forceinline__ void p0_prologue(Frame& F) {
    const int gw = F.vcu * NWAVES + F.wave, NGW = F.G * NWAVES;
#ifndef P0_TREP
#define P0_TREP 1
#endif
    if (F.G == 256) {
        if (F.bx < 192) p0_gemv(F, 0, DEPTH * 48, F.bx, 192);
        else for (int rep_ = 0; rep_ < P0_TREP; ++rep_) transpose_group(F, TG_P0, F.bx - 192, 1, 64);
    } else {
        p0_gemv(F, 0, DEPTH * 48, F.bx, F.G);
        p0_filters(F, F.bx, F.G); __syncthreads();
        transpose_group(F, 0x1ffffu, F.bx, 1, F.G);
    }
    for (int e = gw * 64 + F.lane; e < 64 * 32 + 64 * 16; e += NGW * 64) {
        if (e < 64 * 32) { const int pos = e >> 5, k = e & 31; const float ang = (float)pos * expf(-(float)(2 * k) * (9.210340371976184f / 64.0f)); ((float2*)(F.ws + WS_CSA))[e] = make_float2(cosf(ang), sinf(ang)); }
        else { const int e2 = e - 64 * 32, pos = e2 >> 4, k = e2 & 15; const float ang = (float)pos * expf(-(float)(2 * k) * (9.210340371976184f / 32.0f)); ((float2*)(F.ws + WS_CSC))[e2] = make_float2(cosf(ang), sinf(ang)); }
    }
}
#ifndef TAIL_GREP
#define TAIL_GREP 1
#endif
#ifndef TAIL_TREP
#define TAIL_TREP 1
#endif
#ifndef TAIL_FREP
#define TAIL_FREP 1
#endif
__device__ __forceinline__ void tail_work(Frame& F, int layer, int first_idle) {
    if (layer == 1) { if (F.bx >= 120) { for (int r_ = 0; r_ < TAIL_FREP; ++r_) filters_mfma(F, 255 - F.bx, 136); } }
    for (int r_ = 0; r_ < TAIL_TREP; ++r_) transpose_group(F, layer == 0 ? TG_L0 : layer == 1 ? TG_L1 : layer == 2 ? TG_L2 : TG_L3, F.bx - first_idle, 1, 256 - first_idle);
}
static_assert(((MT / 256) * (A_COLS / 256)) % 256 == 152 && ((MT / 256) * (3 * DM / 256)) % 256 == 48, "tail_work's workgroup ranges");
__device__ __forceinline__ void row_phase(Frame& F, int r_begin, int nrows, const bf16* src, int l_res, int g_res, int gate_idx, bool do_norm, int l_n, int g_n, int shift_idx, int scale_idx, const float* slab = nullptr, int nsplit = 0, bool h_in = false, bool out_f32 = false) {
    const int gw = F.vcu * NWAVES + F.wave, NGW = F.G * NWAVES;
    const float* NG = F.inp(I_NORMG); const float* xin = F.inp(I_X); const float* cin = F.inp(I_CTX);
    bf16* U = (bf16*)(F.ws + WS_U);
    const int nlat = r_begin == 0 ? (nrows < MLAT ? nrows : MLAT) : 0, RPW = (nlat + NGW - 1) / NGW;
    const bool skew = nsplit > 0 && nlat == MLAT && NGW == 2048 && nrows == MT;
    const bool cwv = F.wave < 4;
    const int l0 = skew ? F.vcu * 64 + (cwv ? 7 * F.wave : 28 + 9 * (F.wave - 4)) : gw * RPW, rpw = skew ? (cwv ? 7 : 9) : RPW;
    const int nl = l0 >= nlat ? 0 : (nlat - l0 < rpw ? nlat - l0 : rpw);
    const int nctx = nrows > MLAT ? nrows - MLAT : 0, c0 = skew ? F.vcu * 4 + F.wave : gw;
    const int nc = skew ? (cwv ? 1 : 0) : (gw < nctx ? (nctx - gw + NGW - 1) / NGW : 0);
    const int nseq = nl + nc;
#define RP_ROW(i_) ((i_) < nl ? l0 + (i_) : MLAT + c0 + ((i_) - nl) * NGW)
    f32x4 vn[4]; uint2 wn[4], hn[4];
#pragma unroll
    for (int j = 0; j < 4; ++j) { vn[j] = (f32x4){0.f, 0.f, 0.f, 0.f}; wn[j] = make_uint2(0u, 0u); hn[j] = wn[j]; }
#define RP_LOAD(r_) do { if (h_in || (r_) >= MLAT) { const float* hs_ = h_in ? ((r_) < MLAT ? xin + (size_t)(r_) * DM : cin + (size_t)((r_) - MLAT) * DM) : hrow_ctx(F, (r_)); \
            _Pragma("unroll") for (int j = 0; j < 4; ++j) vn[j] = *((const f32x4*)hs_ + F.lane + 64 * j); } \
        else { const bf16* hb_ = hrow_lat(F, (r_)); _Pragma("unroll") for (int j = 0; j < 4; ++j) hn[j] = *((const uint2*)hb_ + F.lane + 64 * j); } \
        if (src && !((r_) >= MLAT && nsplit > 0)) { _Pragma("unroll") for (int j = 0; j < 4; ++j) wn[j] = *((const uint2*)(src + (size_t)(r_) * DM) + F.lane + 64 * j); } } while (0)
#define RP_CVT(w_) ((f32x4){bf2f((w_).x & 0xffffu), bf2f((w_).x >> 16), bf2f((w_).y & 0xffffu), bf2f((w_).y >> 16)})
    f32x4 Pgm[4], Pgn[4], Psh[4]; int bcur = -1;
#pragma unroll
    for (int j = 0; j < 4; ++j) { Pgm[j] = (f32x4){0.f, 0.f, 0.f, 0.f}; Pgn[j] = Pgm[j]; Psh[j] = Pgm[j]; }
#define RP_PARAMS(rp_) do { const int b_ = (rp_) < MLAT ? (rp_) / SEQ : BATCH;     \
        if (b_ != bcur) { bcur = b_; \
            if (src) { const float* mv = modvec(F, l_res, (rp_)) + gate_idx * DM; const float* g = NG + (size_t)(l_res * 4 + g_res) * DM; \
                _Pragma("unroll") for (int j = 0; j < 4; ++j) Pgm[j] = *((const f32x4*)g + F.lane + 64 * j) * *((const f32x4*)mv + F.lane + 64 * j); } \
            if (do_norm) { const float* mv = modvec(F, l_n, (rp_)); const float* g = NG + (size_t)(l_n * 4 + g_n) * DM; \
                _Pragma("unroll") for (int j = 0; j < 4; ++j) { Pgn[j] = *((const f32x4*)g + F.lane + 64 * j) * (*((const f32x4*)(mv + scale_idx * DM) + F.lane + 64 * j) + 1.0f); Psh[j] = *((const f32x4*)(mv + shift_idx * DM) + F.lane + 64 * j); } } \
        } } while (0)
    if (nseq > 0) { const int r_ = RP_ROW(0); RP_LOAD(r_); }
    for (int i = 0; i < nseq; ++i) {
        const int r = RP_ROW(i);
        const bool hf32 = h_in || r >= MLAT;
        f32x4 v[4]; uint2 w[4];
#pragma unroll
        for (int j = 0; j < 4; ++j) { v[j] = hf32 ? vn[j] : RP_CVT(hn[j]); w[j] = wn[j]; }
        if (i + 1 < nseq) { const int r_ = RP_ROW(i + 1); RP_LOAD(r_); }
        RP_PARAMS(r);
        if (src) {
            f32x4 o[4]; float ss = 0.f;
            if (r >= MLAT && nsplit > 0) {
#pragma unroll
                for (int j = 0; j < 4; ++j) o[j] = (f32x4){0.f, 0.f, 0.f, 0.f};
                const f32x4* sl0 = (const f32x4*)(slab + (size_t)(r - MLAT) * DM) + F.lane;
#pragma unroll
                for (int sp0 = 0; sp0 < 8; sp0 += 4) {
                    f32x4 t[4][4]; float wg[4];
#pragma unroll
                    for (int s = 0; s < 4; ++s) { const int sp = sp0 + s < nsplit ? sp0 + s : nsplit - 1; wg[s] = sp0 + s < nsplit ? 1.f : 0.f;
                        const f32x4* sl = sl0 + (size_t)sp * (MCTX * DM / 4);
#pragma unroll
                        for (int j = 0; j < 4; ++j) t[s][j] = sl[64 * j]; }
#pragma unroll
                    for (int s = 0; s < 4; ++s)
#pragma unroll
                        for (int j = 0; j < 4; ++j) o[j] += t[s][j] * wg[s];
                }
            } else {
#pragma unroll
                for (int j = 0; j < 4; ++j) o[j] = RP_CVT(w[j]);
            }
#pragma unroll
            for (int j = 0; j < 4; ++j) ss += (o[j].x * o[j].x + o[j].y * o[j].y) + (o[j].z * o[j].z + o[j].w * o[j].w);
            const float rs = __builtin_amdgcn_rsqf(wave_sum(ss) * (1.0f / DM) + EPS);
#pragma unroll
            for (int j = 0; j < 4; ++j) v[j] = v[j] + (o[j] * rs) * Pgm[j];
            if (r >= MLAT) { float* h = hrow_ctx(F, r);
#pragma unroll
                for (int j = 0; j < 4; ++j) *((f32x4*)h + F.lane + 64 * j) = v[j];
            } else if (out_f32) { float* ho = F.out + (size_t)r * DM;
#pragma unroll
                for (int j = 0; j < 4; ++j) *((f32x4*)ho + F.lane + 64 * j) = v[j];
            } else { bf16* hb = hrow_lat(F, r);
#pragma unroll
                for (int j = 0; j < 4; ++j) { uint2 ww; ww.x = pk2(v[j].x, v[j].y); ww.y = pk2(v[j].z, v[j].w); *((uint2*)hb + F.lane + 64 * j) = ww;
                    v[j] = RP_CVT(ww); }
            }
        }
        if (do_norm) {
            float ss = 0.f;
#pragma unroll
            for (int j = 0; j < 4; ++j) ss += (v[j].x * v[j].x + v[j].y * v[j].y) + (v[j].z * v[j].z + v[j].w * v[j].w);
            const float rs = __builtin_amdgcn_rsqf(wave_sum(ss) * (1.0f / DM) + EPS);
#pragma unroll
            for (int j = 0; j < 4; ++j) { const f32x4 y = (v[j] * rs) * Pgn[j] + Psh[j];
                uint2 ww; ww.x = pk2(y.x, y.y); ww.y = pk2(y.z, y.w);
                *((uint2*)(U + (size_t)r * DM) + F.lane + 64 * j) = ww; }
        }
    }
#undef RP_PARAMS
#undef RP_LOAD
#undef RP_ROW
}
#undef RP_CVT

__device__ __forceinline__ void prep_a(Frame& F, int j) {
    const int gw = F.vcu * NWAVES + F.wave, NGW = F.G * NWAVES, lane = F.lane;
    const bf16* QKV = (const bf16*)(F.ws + WS_R + R_QKV);
    bf16* KB = (bf16*)(F.ws + WS_R + R_KB);
    const float* kg = F.inp(I_AKG) + j * A_DH; const float* CSA = (const float*)(F.ws + WS_CSA);
    const float g1 = kg[lane], g2 = kg[64 + lane];
    for (int r0 = gw; r0 < MT; r0 += 9 * NGW) {
        bf16 n[9][4]; float2 cv[9];
#pragma unroll
        for (int i = 0; i < 9; ++i) { const int rr = r0 + i * NGW, r = rr < MT ? rr : MT - 1;
            const bf16* s_ = QKV + (size_t)r * A_COLS + A_HEADS * A_DH; n[i][0] = s_[lane]; n[i][1] = s_[64 + lane]; n[i][2] = s_[A_DH + lane]; n[i][3] = s_[A_DH + 64 + lane];
            const int t = r % SEQ; const float2 tv = *(const float2*)(CSA + ((lane < 32 ? t / GRID_W : t % GRID_W) * 32 + (lane & 31)) * 2); cv[i] = r < MLAT ? tv : make_float2(1.f, 0.f); }
#pragma unroll
        for (int i = 0; i < 9; ++i) { const int r = r0 + i * NGW;
            if (r < MT) {
                const bool lat = r < MLAT; const int b = lat ? r / SEQ : (r - MLAT) / CTXL, t = lat ? r % SEQ : (r - MLAT) % CTXL, key = lat ? CTXL + t : t;
                const float cs = cv[i].x, sn = cv[i].y;
                const float a1 = bf2f(n[i][0]), a2 = bf2f(n[i][1]), b1 = bf2f(n[i][2]), b2 = bf2f(n[i][3]);
                const float ra = __builtin_amdgcn_rsqf(wave_sum(a1 * a1 + a2 * a2) * (1.0f / A_DH) + EPS), rb = __builtin_amdgcn_rsqf(wave_sum(b1 * b1 + b2 * b2) * (1.0f / A_DH) + EPS);
                const float ya1 = a1 * ra * g1, ya2 = a2 * ra * g2, yb1 = b1 * rb * g1, yb2 = b2 * rb * g2;
                bf16* d = KB + ((size_t)b * NKEY + key) * 256;
                d[lane] = (bf16)f2bf(ya1 * cs - ya2 * sn); d[64 + lane] = (bf16)f2bf(ya1 * sn + ya2 * cs);
                d[A_DH + lane] = (bf16)f2bf(yb1 * cs - yb2 * sn); d[A_DH + 64 + lane] = (bf16)f2bf(yb1 * sn + yb2 * cs);
            } }
    }
}
__device__ __forceinline__ void prep_c(Frame& F) {
    const int gw = F.vcu * NWAVES + F.wave, NGW = F.G * NWAVES, lane = F.lane;
    const bf16* QKV = (const bf16*)(F.ws + WS_R + R_QKV);
    bf16* KB = (bf16*)(F.ws + WS_R + R_KB);
    const float* CSC = (const float*)(F.ws + WS_CSC);
    const int i = lane & 31, hsel = lane >> 5;
    for (int r0 = gw; r0 < MT; r0 += 9 * NGW) {
        bf16 n[9][2]; float2 cv[9];
#pragma unroll
        for (int k = 0; k < 9; ++k) { const int rr = r0 + k * NGW, r = rr < MT ? rr : MT - 1;
            const bf16* s_ = QKV + (size_t)r * C_COLS + C_HEADS * C_DH + hsel * C_DH; n[k][0] = s_[i]; n[k][1] = s_[32 + i];
            const int t = r % SEQ; const float2 tv = *(const float2*)(CSC + ((i < 16 ? t / GRID_W : t % GRID_W) * 16 + (i & 15)) * 2); cv[k] = r < MLAT ? tv : make_float2(1.f, 0.f); }
#pragma unroll
        for (int k = 0; k < 9; ++k) { const int r = r0 + k * NGW;
            if (r < MT) {
                const bool lat = r < MLAT; const int b = lat ? r / SEQ : (r - MLAT) / CTXL, t = lat ? r % SEQ : (r - MLAT) % CTXL, key = lat ? CTXL + t : t;
                const float cs = cv[k].x, sn = cv[k].y;
                const float x1 = bf2f(n[k][0]), x2 = bf2f(n[k][1]);
                bf16* d = KB + ((size_t)b * NKEY + key) * 128 + hsel * C_DH;
                d[i] = (bf16)f2bf(x1 * cs - x2 * sn); d[32 + i] = (bf16)f2bf(x1 * sn + x2 * cs);
            } }
    }
}

__device__ __forceinline__ void attn_a_phase(Frame& F, bool with_ctx, int j) {
    const bf16* QKV = (const bf16*)(F.ws + WS_R + R_QKV); const bf16* KB = (const bf16*)(F.ws + WS_R + R_KB);
    bf16* OP = (bf16*)(F.ws + WS_U);
    const float* qg = F.inp(I_AQG) + j * A_DH; const float* CSA = (const float*)(F.ws + WS_CSA);
    const int ntotal = 512 + (with_ctx ? 32 : 0);
    const bool g256 = F.G == 256;
    for (int i = 0;; ++i) {
        int U;
        if (g256) { if (i >= 3) break; U = i < 2 ? 2 * F.vcu + i : 512 + F.vcu; if (U >= ntotal) break; }
        else { U = F.vcu + i * F.G; if (U >= ntotal) break; }
        int tid_u = F.tid; asm volatile("" : "+v"(tid_u));
        int b, kvh, seq, h, qrow, t_first; const float* cs;
        if (U < 512) { const int pair = U >> 6, g = (U & 63) >> 4, qb = U & 15; b = pair >> 1; kvh = pair & 1; h = kvh * 4 + g; qrow = b * SEQ + qb * 256; seq = NKEY; cs = CSA; t_first = qb * 256; }
        else { const int c = U - 512; b = c >> 3; h = c & 7; kvh = h >> 2; qrow = MLAT + b * CTXL; seq = CTXL; cs = nullptr; t_first = 0; }
        aa::attn_dense_body(QKV + (size_t)qrow * A_COLS + h * A_DH, KB + (size_t)b * NKEY * 256 + kvh * A_DH, QKV + (A_HEADS + A_KV) * A_DH + kvh * A_DH, MLAT + b * CTXL, b * SEQ, OP + (size_t)qrow * DM + h * A_DH, seq, (char*)F.ldsg, tid_u, qg, cs, t_first);
    }
}

__device__ __forceinline__ void attn_c_phase(Frame& F, bool with_ctx) {
    const bf16* QKV = (const bf16*)(F.ws + WS_R + R_QKV); const bf16* KB = (const bf16*)(F.ws + WS_R + R_KB);
    bf16* OP = (bf16*)(F.ws + WS_U);
    const float* sink = F.inp(I_CSINK); const float* CSC = (const float*)(F.ws + WS_CSC);
    const int ntotal = 1024 + (with_ctx ? 64 : 0);
    for (int U = F.vcu; U < ntotal; U += F.G) {
        int b, kvh, t0, qrow;
        if (U < 1024) { b = U >> 8; kvh = (U >> 7) & 1; const int qb = U & 127; t0 = qb * 32; qrow = b * SEQ + t0; }
        else { const int c = U - 1024; b = c >> 4; kvh = (c >> 3) & 1; const int qb = c & 7; t0 = -1; qrow = MLAT + b * CTXL + qb * 32; }
        const int h = kvh * 8 + F.wave;
        ac::unit(QKV + (size_t)qrow * C_COLS + h * C_DH, KB + (size_t)b * NKEY * 128 + kvh * C_DH, QKV + (C_HEADS + C_KV) * C_DH + kvh * C_DH, MLAT + b * CTXL, b * SEQ,
                 OP + (size_t)qrow * DM + h * C_DH, t0, sink[h] * 1.4426950408889634f, (char*)F.ldsg, F.tid, CSC);
    }
}

__device__ __forceinline__ float hy_dwconv(const bf16* u3, int r, int col, bool has_prev, bool has_next, const float* cw, const float* cb) {
    float a = cb[col] + cw[3 * DM + col] * bf2f(u3[(size_t)r * (3 * DM) + col]);
    if (has_prev) a += cw[col] * bf2f(u3[(size_t)(r - 1) * (3 * DM) + col]);
    if (has_next) a += cw[2 * 3 * DM + col] * bf2f(u3[(size_t)(r + 1) * (3 * DM) + col]);
    return a;
}
__device__ __forceinline__ void hy1t(Frame& F) {
    const int gw = F.vcu * NWAVES + F.wave, NGW = F.G * NWAVES, lane = F.lane;
    const bf16* u3 = (const bf16*)(F.ws + WS_R + R_QKV); float* VPT = (float*)(F.ws + WS_R + R_VPT);
    const float* cw = F.inp(I_BCW); const float* cb = F.inp(I_BCB);
    LAS float* tile = (LAS float*)(F.lds + F.wave * (64 * 65 * 4));
    constexpr int NA = BATCH * (SEQ / 64) * (DM / 64);
    const int hl = lane >> 5, c2 = lane & 31;
    for (int it = gw; it < NA; it += NGW) {
        const int dt = it % (DM / 64), tt = (it / (DM / 64)) % (SEQ / 64), b = it / ((DM / 64) * (SEQ / 64));
        const int d = dt * 64 + 2 * c2, ts = tt * 64 + 32 * hl, rs = b * SEQ + ts;
        const int c1 = DM + d, cv = 2 * DM + d;
        const float2 b1 = *(const float2*)(cb + c1), b2 = *(const float2*)(cb + cv);
        const float2 w10 = *(const float2*)(cw + c1), w11 = *(const float2*)(cw + 3 * DM + c1), w12 = *(const float2*)(cw + 6 * DM + c1);
        const float2 w20 = *(const float2*)(cw + cv), w21 = *(const float2*)(cw + 3 * DM + cv), w22 = *(const float2*)(cw + 6 * DM + cv);
        unsigned xr[34], vr[34];
#pragma unroll
        for (int i = 0; i < 34; ++i) { const int tq = ts - 1 + i; const bool ok = tq >= 0 && tq < SEQ; const size_t ro = (size_t)(ok ? rs - 1 + i : rs) * (3 * DM);
            const unsigned a = *(const unsigned*)(u3 + ro + c1), bq = *(const unsigned*)(u3 + ro + cv); xr[i] = ok ? a : 0u; vr[i] = ok ? bq : 0u; }
#pragma unroll
        for (int i = 0; i < 32; ++i) {
            const unsigned p1 = xr[i], q1 = xr[i + 1], n1 = xr[i + 2], p2 = vr[i], q2 = vr[i + 1], n2 = vr[i + 2];
            const float xa = b1.x + w10.x * bf2f(p1 & 0xffffu) + w11.x * bf2f(q1 & 0xffffu) + w12.x * bf2f(n1 & 0xffffu), xb = b1.y + w10.y * bf2f(p1 >> 16) + w11.y * bf2f(q1 >> 16) + w12.y * bf2f(n1 >> 16);
            const float va = b2.x + w20.x * bf2f(p2 & 0xffffu) + w21.x * bf2f(q2 & 0xffffu) + w22.x * bf2f(n2 & 0xffffu), vb = b2.y + w20.y * bf2f(p2 >> 16) + w21.y * bf2f(q2 >> 16) + w22.y * bf2f(n2 >> 16);
            tile[(32 * hl + i) * 65 + 2 * c2] = xa * va; tile[(32 * hl + i) * 65 + 2 * c2 + 1] = xb * vb;
        }
        LDS_WAIT(); asm volatile("" ::: "memory");
        float* dst = VPT + ((size_t)(b * DM + dt * 64)) * SEQ + tt * 64 + lane;
#pragma unroll 8
        for (int j = 0; j < 64; ++j) dst[(size_t)j * SEQ] = tile[lane * 65 + j];
        LDS_WAIT(); asm volatile("" ::: "memory");
    }
    float* VPC = (float*)(F.ws + WS_R + R_VPC);
    for (int q = F.vcu * NTHREADS + F.tid; q < (MCTX / 4) * (DM / 2); q += F.G * NTHREADS) {
        const int cp = q % (DM / 2), rc0 = (q / (DM / 2)) * 4, t0 = rc0 % CTXL, d = 2 * cp, r0 = MLAT + rc0;
        const int c1 = DM + d, cv = 2 * DM + d;
        unsigned xr[6], vr[6];
#pragma unroll
        for (int i = 0; i < 6; ++i) { const int tq = t0 - 1 + i; const bool ok = tq >= 0 && tq < CTXL; const size_t ro = (size_t)(ok ? r0 - 1 + i : r0) * (3 * DM);
            const unsigned a = *(const unsigned*)(u3 + ro + c1), bq = *(const unsigned*)(u3 + ro + cv); xr[i] = ok ? a : 0u; vr[i] = ok ? bq : 0u; }
        const float2 b1 = *(const float2*)(cb + c1), b2 = *(const float2*)(cb + cv);
        const float2 w10 = *(const float2*)(cw + c1), w11 = *(const float2*)(cw + 3 * DM + c1), w12 = *(const float2*)(cw + 6 * DM + c1);
        const float2 w20 = *(const float2*)(cw + cv), w21 = *(const float2*)(cw + 3 * DM + cv), w22 = *(const float2*)(cw + 6 * DM + cv);
#pragma unroll
        for (int k = 0; k < 4; ++k) {
            const unsigned p1 = xr[k], q1 = xr[k + 1], n1 = xr[k + 2], p2 = vr[k], q2 = vr[k + 1], n2 = vr[k + 2];
            const float xa = b1.x + w10.x * bf2f(p1 & 0xffffu) + w11.x * bf2f(q1 & 0xffffu) + w12.x * bf2f(n1 & 0xffffu), xb = b1.y + w10.y * bf2f(p1 >> 16) + w11.y * bf2f(q1 >> 16) + w12.y * bf2f(n1 >> 16);
            const float va = b2.x + w20.x * bf2f(p2 & 0xffffu) + w21.x * bf2f(q2 & 0xffffu) + w22.x * bf2f(n2 & 0xffffu), vb = b2.y + w20.y * bf2f(p2 >> 16) + w21.y * bf2f(q2 >> 16) + w22.y * bf2f(n2 >> 16);
            *(float2*)(VPC + (size_t)(rc0 + k) * DM + d) = make_float2(xa * va, xb * vb);
        }
    }
}
__device__ __forceinline__ void hyconv_ctx(Frame& F) {
    const bf16* u3 = (const bf16*)(F.ws + WS_R + R_QKV); const float* VPC = (const float*)(F.ws + WS_R + R_VPC);
    bf16* OP = (bf16*)(F.ws + WS_U);
    const float* cw = F.inp(I_BCW); const float* cb = F.inp(I_BCB); const float* skip = F.inp(I_BSKIP);
    constexpr int L = CTXL, n_ctx = BATCH * (CTXL / 8) * DM;
    for (int q = F.vcu * NTHREADS + F.tid; q < n_ctx; q += F.G * NTHREADS) {
        const int d = q % DM, tb = (q / DM) % (L / 8), b = q / (DM * (L / 8));
        const int rbase = b * CTXL, t0 = tb * 8;
        const float* Hc = (const float*)(F.ws + WS_HCCTX) + d;
        const float* vp = VPC + (size_t)rbase * DM + d;
        float y[8];
#pragma unroll
        for (int k = 0; k < 8; ++k) y[k] = 0.f;
#pragma unroll 4
        for (int s0 = 0; s0 < L; s0 += 8) {
            const int base = t0 - s0 + L - 1 - 7;
            float f[15];
#pragma unroll
            for (int i = 0; i < 15; ++i) { const int idx = base + i; f[i] = (idx >= 0 && idx <= 2 * L - 2) ? Hc[(size_t)idx * DM] : 0.f; }
#pragma unroll
            for (int j = 0; j < 8; ++j) { const float v = vp[(size_t)(s0 + j) * DM];
#pragma unroll
                for (int k = 0; k < 8; ++k) y[k] += f[k - j + 7] * v; }
        }
        const float sk = skip[d];
#pragma unroll
        for (int k = 0; k < 8; ++k) { const int t = t0 + k, r = MLAT + rbase + t;
            const float x0 = hy_dwconv(u3, r, d, t > 0, t < L - 1, cw, cb);
            OP[(size_t)r * DM + d] = (bf16)f2bf((y[k] + sk * vp[(size_t)t * DM]) * x0); }
    }
}
__device__ __forceinline__ void hy3(Frame& F) {
    const int gw = F.vcu * NWAVES + F.wave, NGW = F.G * NWAVES, lane = F.lane;
    const bf16* u3 = (const bf16*)(F.ws + WS_R + R_QKV); const float* YT = (const float*)(F.ws + WS_R + R_VPT);
    bf16* OP = (bf16*)(F.ws + WS_U);
    const float* cw = F.inp(I_BCW); const float* cb = F.inp(I_BCB);
    LAS float* tile = (LAS float*)(F.lds + F.wave * (64 * 65 * 4));
    constexpr int NA = BATCH * (SEQ / 64) * (DM / 64);
    for (int it = gw; it < NA; it += NGW) {
        const int dt = it % (DM / 64), tt = (it / (DM / 64)) % (SEQ / 64), b = it / ((DM / 64) * (SEQ / 64));
        const int d = dt * 64 + lane, t0 = tt * 64, r0 = b * SEQ + t0;
        const float* src = YT + ((size_t)(b * DM + dt * 64)) * SEQ + t0 + lane;
        float yv[64]; bf16 xr[66];
#pragma unroll
        for (int j = 0; j < 64; ++j) yv[j] = src[(size_t)j * SEQ];
#pragma unroll
        for (int i = 0; i < 66; ++i) { const int tq = t0 - 1 + i; const bool ok = tq >= 0 && tq < SEQ; const bf16 a = u3[(size_t)(ok ? r0 - 1 + i : r0) * (3 * DM) + d]; xr[i] = ok ? a : (bf16)0; }
#pragma unroll
        for (int j = 0; j < 64; ++j) tile[j * 65 + lane] = yv[j];
        LDS_WAIT(); asm volatile("" ::: "memory");
        const float b0 = cb[d], w0 = cw[d], w1 = cw[3 * DM + d], w2 = cw[6 * DM + d];
#pragma unroll
        for (int i = 0; i < 64; ++i) {
            const float x0 = b0 + w0 * bf2f(xr[i]) + w1 * bf2f(xr[i + 1]) + w2 * bf2f(xr[i + 2]);
            OP[(size_t)(r0 + i) * DM + d] = (bf16)f2bf(tile[lane * 65 + i] * x0);
        }
        LDS_WAIT(); asm volatile("" ::: "memory");
    }
}

namespace hf {
typedef float cf __attribute__((ext_vector_type(2)));
__device__ __forceinline__ cf cmul(cf a, cf w) { return {a.x * w.x - a.y * w.y, a.x * w.y + a.y * w.x}; }
__device__ __forceinline__ cf cmulc(cf a, cf w) { return {a.x * w.x + a.y * w.y, a.y * w.x - a.x * w.y}; }
constexpr int PAD = 272;
__device__ __forceinline__ int lidx(int k1, int a, int b) { return k1 * PAD + a * 16 + ((b + a) & 15); }
template <int S> __device__ __forceinline__ void dft4(cf& a, cf& b, cf& c, cf& d) {
    const cf s0 = a + c, s1 = a - c, s2 = b + d, s3 = b - d;
    const cf j3 = S > 0 ? cf{-s3.y, s3.x} : cf{s3.y, -s3.x};
    a = s0 + s2; c = s0 - s2; b = s1 + j3; d = s1 - j3;
}
template <int S> __device__ __forceinline__ void dft16(cf (&x)[16]) {
#pragma unroll
    for (int nb = 0; nb < 4; ++nb) dft4<S>(x[nb], x[4 + nb], x[8 + nb], x[12 + nb]);
    const float c1 = 0.92387953251128674f, s1 = 0.38268343236508977f, r2 = 0.70710678118654752f, sg = (float)S;
    x[4 + 1] = cmul(x[4 + 1], cf{c1, sg * s1});  x[4 + 2] = cmul(x[4 + 2], cf{r2, sg * r2});   x[4 + 3] = cmul(x[4 + 3], cf{s1, sg * c1});
    x[8 + 1] = cmul(x[8 + 1], cf{r2, sg * r2});  x[8 + 2] = cmul(x[8 + 2], cf{0.f, sg});       x[8 + 3] = cmul(x[8 + 3], cf{-r2, sg * r2});
    x[12 + 1] = cmul(x[12 + 1], cf{s1, sg * c1}); x[12 + 2] = cmul(x[12 + 2], cf{-r2, sg * r2}); x[12 + 3] = cmul(x[12 + 3], cf{-c1, -sg * s1});
#pragma unroll
    for (int ka = 0; ka < 4; ++ka) dft4<S>(x[4 * ka], x[4 * ka + 1], x[4 * ka + 2], x[4 * ka + 3]);
}
#define HF_OUT(x, k) x[4 * ((k) & 3) + ((k) >> 2)]
__device__ __forceinline__ void fft_fwd(cf (&x)[16], LAS cf* D, const LAS cf* TW, int u) {
    asm volatile("" : "+v"(u));
    int hi4 = u >> 4, lo4 = u & 15;
    dft16<-1>(x);
#pragma unroll
    for (int k1 = 0; k1 < 16; ++k1) D[lidx(k1, hi4, lo4)] = cmul(HF_OUT(x, k1), TW[(16 * hi4 * k1) & 4095]);
    __syncthreads();
    asm volatile("" : "+v"(hi4), "+v"(lo4));
#pragma unroll
    for (int n2 = 0; n2 < 16; ++n2) x[n2] = D[lidx(hi4, n2, lo4)];
    dft16<-1>(x);
#pragma unroll
    for (int k2 = 0; k2 < 16; ++k2) D[lidx(hi4, k2, lo4)] = cmul(HF_OUT(x, k2), TW[lo4 * (hi4 + 16 * k2)]);
    __syncthreads();
    asm volatile("" : "+v"(hi4), "+v"(lo4));
#pragma unroll
    for (int n3 = 0; n3 < 16; ++n3) x[n3] = D[lidx(hi4, lo4, n3)];
    dft16<-1>(x);
}
__device__ __forceinline__ void fft_inv(cf (&x)[16], LAS cf* D, const LAS cf* TW, int u) {
    asm volatile("" : "+v"(u));
    int hi4 = u >> 4, lo4 = u & 15;
    dft16<1>(x);
#pragma unroll
    for (int n3 = 0; n3 < 16; ++n3) D[lidx(hi4, lo4, n3)] = cmulc(HF_OUT(x, n3), TW[n3 * (hi4 + 16 * lo4)]);
    __syncthreads();
    asm volatile("" : "+v"(hi4), "+v"(lo4));
#pragma unroll
    for (int k2 = 0; k2 < 16; ++k2) x[k2] = D[lidx(hi4, k2, lo4)];
    dft16<1>(x);
#pragma unroll
    for (int n2 = 0; n2 < 16; ++n2) D[lidx(hi4, n2, lo4)] = cmulc(HF_OUT(x, n2), TW[(16 * n2 * hi4) & 4095]);
    __syncthreads();
    asm volatile("" : "+v"(hi4), "+v"(lo4));
#pragma unroll
    for (int k1 = 0; k1 < 16; ++k1) x[k1] = D[lidx(k1, hi4, lo4)];
    dft16<1>(x);
}
}
__device__ __forceinline__ void hyfft(Frame& F) {
    using namespace hf;
    const int tid = F.tid, half = F.wave >> 2, u_ = tid & 255;
    LAS cf* D = (LAS cf*)F.lds + half * (16 * PAD);
    LAS cf* TW = (LAS cf*)(F.lds + 2 * 16 * PAD * 8);
    LAS cf* COMB = (LAS cf*)(F.lds + 2 * 16 * PAD * 8 + 32768);
    for (int m = tid; m < 4096; m += NTHREADS) { const float a = (float)m * (1.0f / 2048.0f); TW[m] = cf{cospif(a), -sinpif(a)}; }
    cf w8u; { const float a = (float)u_ * (1.0f / 4096.0f); w8u = cf{cospif(a), -sinpif(a)}; }
    __syncthreads();
    const float* HF = (const float*)(F.ws + WS_HCLAT); float* VPT = (float*)(F.ws + WS_R + R_VPT);
    const float* skip = F.inp(I_BSKIP);
    float pb[32];
#define HF_LOAD_FILT(ch_) do { const float* hf_ = HF + (size_t)(ch_) * SEQ; const float* hb_ = HF + (size_t)DM * SEQ + (size_t)(ch_) * SEQ;     \
        _Pragma("unroll") for (int n1 = 0; n1 < 16; ++n1) { const int n = 256 * n1 + u_; pb[n1] = hf_[n]; pb[16 + n1] = hb_[n == 0 ? 0 : SEQ - n]; } } while (0)
#define HF_LOAD_PAIR(ch_, pr_) do { const float* a0_ = VPT + ((size_t)((2 * (pr_)) * DM + (ch_))) * SEQ; const float* a1_ = VPT + ((size_t)((2 * (pr_) + 1) * DM + (ch_))) * SEQ; \
        _Pragma("unroll") for (int n1 = 0; n1 < 16; ++n1) { const int n = 256 * n1 + u_; pb[2 * n1] = a0_[n]; pb[2 * n1 + 1] = a1_[n]; } } while (0)
    if (F.vcu < DM) HF_LOAD_FILT(F.vcu);
    for (int ch = F.vcu; ch < DM; ch += F.G) {
        int u = u_; asm volatile("" : "+v"(u));
        cf Fs[16];
        {
            cf x[16];
            const float sk = skip[ch];
#pragma unroll
            for (int n1 = 0; n1 < 16; ++n1) { const int n = 256 * n1 + u;
                float fa = pb[n1]; if (n == 0) fa += sk;
                const float fb = n == 0 ? 0.f : pb[16 + n1];
                if (half == 0) x[n1] = cf{fa + fb, 0.f};
                else { const cf w = cmul(w8u, TW[128 * n1]); const float dd = fa - fb; x[n1] = cf{dd * w.x, dd * w.y}; } }
            HF_LOAD_PAIR(ch, 0);
            fft_fwd(x, D, TW, u);
#pragma unroll
            for (int k3 = 0; k3 < 16; ++k3) { const cf v = HF_OUT(x, k3); Fs[k3] = cf{v.x * (1.0f / 8192.0f), v.y * (1.0f / 8192.0f)}; }
        }
#pragma unroll
        for (int pr = 0; pr < 2; ++pr) {
            __syncthreads();
            asm volatile("" : "+v"(u));
            float* v0 = VPT + ((size_t)((2 * pr) * DM + ch)) * SEQ; float* v1 = VPT + ((size_t)((2 * pr + 1) * DM + ch)) * SEQ;
            cf x[16];
#pragma unroll
            for (int n1 = 0; n1 < 16; ++n1) { const cf z = cf{pb[2 * n1], pb[2 * n1 + 1]};
                x[n1] = half == 0 ? z : cmul(z, cmul(w8u, TW[128 * n1])); }
            if (pr == 0) HF_LOAD_PAIR(ch, 1);
            else if (ch + F.G < DM) HF_LOAD_FILT(ch + F.G);
            fft_fwd(x, D, TW, u);
            cf w[16];
#pragma unroll
            for (int k3 = 0; k3 < 16; ++k3) w[k3] = cmul(HF_OUT(x, k3), Fs[k3]);
            fft_inv(w, D, TW, u);
            if (half == 1) {
#pragma unroll
                for (int n1 = 0; n1 < 16; ++n1) COMB[256 * n1 + u] = cmulc(HF_OUT(w, n1), cmul(w8u, TW[128 * n1]));
            }
            __syncthreads();
            if (half == 0) {
#pragma unroll
                for (int n1 = 0; n1 < 16; ++n1) { const int n = 256 * n1 + u; const cf y = HF_OUT(w, n1) + COMB[n]; v0[n] = y.x; v1[n] = y.y; }
            }
        }
        __syncthreads();
    }
#undef HF_LOAD_FILT
#undef HF_LOAD_PAIR
}

constexpr int N_PHASES = 2 + 8 * DEPTH + 1;
__global__ void __launch_bounds__(NTHREADS, 2) fwd_kernel(Args args) {
    extern __shared__ __attribute__((aligned(16))) unsigned char lds[];
    Frame F;
    F.lds = (LAS unsigned char*)lds; F.ldsg = lds;
    F.MISC = (volatile LAS unsigned*)(F.lds + MISC_OFF);
    int wave_s = __builtin_amdgcn_readfirstlane(threadIdx.x >> 6);
    F.tid = threadIdx.x; F.lane = F.tid & 63; F.wave = wave_s;
    F.G = gridDim.x; { const int bx = blockIdx.x; F.vcu = (F.G % 8 == 0) ? (bx % 8) * (F.G / 8) + bx / 8 : bx; }
    F.out = args.out; F.ws = args.ws; F.ctl = (gu32*)(args.ws + WS_CTL);
    F.intab = (LAS unsigned long long*)(F.lds + INTAB_OFF);
    for (int u = F.tid; u < 64; u += NTHREADS) ((LAS unsigned*)(F.lds + MISC_OFF))[u] = 0u;
    if (F.tid < N_IN) F.intab[F.tid] = (unsigned long long)args.in[F.tid];
    __syncthreads();
    XcdBarrier bar; bar.bar = (unsigned*)(F.ctl + CW_BAR); bar.x = 0; bar.st = nullptr;
    if (args.single) bar = xcd_barrier_post((unsigned*)(F.ctl + CW_BAR), F.MISC + 8, F.tid);

#ifndef DUP_STAGE
#define DUP_STAGE -1
#endif
#ifndef FUSE_RES
#define FUSE_RES 0
#endif
#define FUSE_SETUP(GRES, GATE, DONORM, LN, GN, SH, SC, HIN, BANK) do { if (FUSE_RES && F.G == 256) { const float* NG_ = F.inp(I_NORMG); const float* MOD_ = (const float*)(F.ws + WS_MOD); \
        E.fuse = 1; split_first = 1; E.do_norm = (DONORM); E.h_in = (HIN); E.h_out = F.out; E.Uo = (bf16*)(F.ws + WS_U); \
        E.g_res = NG_ + (size_t)(layer * 4 + (GRES)) * DM; E.mod_res = MOD_ + (size_t)(layer * 4) * (NMOD * DM); E.gate_idx = (GATE); \
        E.g_n = NG_ + (size_t)(((LN) < DEPTH ? (LN) : 0) * 4 + (GN)) * DM; E.mod_n = MOD_ + (size_t)(((LN) < DEPTH ? (LN) : 0) * 4) * (NMOD * DM); E.shift_idx = (SH); E.scale_idx = (SC); \
        const int bank_ = layer * 4 + (BANK); unsigned* ctlw_ = (unsigned*)(F.ws + WS_CTL); \
        E.st1.xbuf = (unsigned*)(F.ws + WS_R + R_XBUF + (size_t)bank_ * 524288); E.st1.cnt = ctlw_ + CW_SEAM + bank_ * 4096; E.st1.tmo = ctlw_; E.st1.eps = EPS; \
        E.st2.xbuf = (unsigned*)(F.ws + WS_R + R_XBUF + (size_t)(bank_ + 1) * 524288); E.st2.cnt = ctlw_ + CW_SEAM + (bank_ + 1) * 4096; E.st2.tmo = ctlw_; E.st2.eps = EPS; } } while (0)
    for (int pp = args.ph_lo * 2; pp < args.ph_hi * 2; ++pp) {
        const int p = pp >> 1;
        if (pp & 1) {
            if (DUP_STAGE < 0) continue;
            int s_ = -1; if (p == 0) s_ = 100; else if (p >= 2) { int i; if (p < 10) i = p - 2; else if (p < 19) { i = p - 10; if (i == 2) i = -100; else if (i == 3) i = 90; else if (i > 3) i -= 1; } else if (p < 27) i = p - 19; else i = p - 27;
                if (i == 90) s_ = 9; else if (i >= 0) s_ = i < 6 ? i : i + 1; }
#ifndef DUP_LAYER
#define DUP_LAYER -1
#endif
            if (s_ != DUP_STAGE) continue;
            if (DUP_LAYER >= 0 && (p < 10 ? 0 : p < 19 ? 1 : p < 27 ? 2 : 3) != DUP_LAYER) continue;
        }
#ifndef BAR_REP
#define BAR_REP 1
#endif
        if (pp != args.ph_lo * 2) { for (int br_ = 0; br_ < BAR_REP; ++br_) { asm volatile("" : "+s"(bar.bar), "+s"(bar.x)); xcd_barrier(bar, wave_s * 64 + pg8::fresh_lane()); } }
        { GAS unsigned char* ws_ = (GAS unsigned char*)args.ws; GAS float* out_ = (GAS float*)args.out; asm volatile("" : "+s"(ws_), "+s"(out_)); F.ws = (unsigned char*)ws_; F.out = (float*)out_;
          int G_ = gridDim.x, bx_ = blockIdx.x; asm volatile("" : "+s"(wave_s), "+s"(G_), "+s"(bx_));
          LAS unsigned char* l_ = (LAS unsigned char*)lds; asm volatile("" : "+s"(l_)); F.lds = l_; F.ldsg = (unsigned char*)l_;
          F.MISC = (volatile LAS unsigned*)(l_ + MISC_OFF); F.intab = (LAS unsigned long long*)(l_ + INTAB_OFF);
          F.wave = wave_s; F.G = G_; F.bx = bx_; F.vcu = (G_ % 8 == 0) ? (bx_ % 8) * (G_ / 8) + bx_ / 8 : bx_; }
#define SET_TID() do { F.lane = pg8::fresh_lane(); __builtin_assume(F.lane >= 0 && F.lane < 64); __builtin_assume(F.wave >= 0 && F.wave < NWAVES); F.tid = F.wave * 64 + F.lane; } while (0)
        if (p == 0) { SET_TID(); p0_prologue(F); }
        else if (p == 1) { SET_TID(); row_phase(F, 0, MT, nullptr, 0, 0, 0, true, 0, 0, 0, 1, nullptr, 0, true); }
        else {
            int layer, s;
            if (p < 10) { layer = 0; const int i = p - 2; s = i < 6 ? i : i + 1; }
            else if (p < 19) { layer = 1; const int i = p - 10; if (i < 3) s = i; else if (i == 3) s = 9; else { const int jj = i - 1; s = jj < 6 ? jj : jj + 1; } }
            else if (p < 27) { layer = 2; const int i = p - 19; s = i < 6 ? i : i + 1; }
            else { layer = 3; const int i = p - 27; s = i < 6 ? i : i + 1; }
            const int kind = layer % 3, j = layer / 3;
            const bool need_ctx = layer < DEPTH - 1;
            const int nrows = need_ctx ? MT : MLAT;
            if (s == 0 || s == 3 || s == 5 || s == 7) {
                pg8::Gemm g; pg8::EpiBf16Slab E; E.slab = nullptr; int SK = 0; g.rowstep = 256; E.act = 0; E.cw = nullptr; E.cb = nullptr; E.ex = (LAS float*)(F.lds + 131072); E.nrows = nrows; E.fuse = 0; int split_first = 0;
                if (s == 0) {
                    g.A = (const bf16*)(F.ws + WS_U); g.lda = DM; g.K = DM; g.M = MT;
                    E.O = (bf16*)(F.ws + WS_R + R_QKV);
                    if (kind == 0)      { g.Bt = (const bf16*)(F.ws + WS_W_AQKV) + (size_t)j * A_COLS * DM; g.N = A_COLS; E.bias = nullptr; }
                    else if (kind == 1) { g.Bt = (const bf16*)(F.ws + WS_W_BIN); g.N = 3 * DM; E.bias = F.inp(I_BBIN); if (!need_ctx) g.M = MLAT; }
                    else                { g.Bt = (const bf16*)(F.ws + WS_W_CQKV); g.N = C_COLS; E.bias = F.inp(I_CBQKV); }
                    E.ldc = g.N;
                } else if (s == 3) {
                    g.A = (const bf16*)(F.ws + WS_U); g.lda = DM; g.K = DM; g.M = nrows; g.N = DM;
                    if (kind == 0)      { g.Bt = (const bf16*)(F.ws + WS_W_AOUT) + (size_t)j * DM * DM; E.bias = nullptr; }
                    else if (kind == 1) { g.Bt = (const bf16*)(F.ws + WS_W_BOUT); E.bias = F.inp(I_BBOUT); }
                    else                { g.Bt = (const bf16*)(F.ws + WS_W_COUT); E.bias = F.inp(I_CBOUT); }
                    E.O = (bf16*)(F.ws + WS_R + R_O); E.ldc = DM; if (need_ctx) { SK = SK_OUT; E.slab = (float*)(F.ws + WS_R + R_SLAB); }
                    FUSE_SETUP(1, 2, 1, layer, 2, 3, 4, layer == 0 ? F.inp(I_X) : (const float*)F.out, 0);
                } else if (s == 5) {
                    g.A = (const bf16*)(F.ws + WS_U) - DM; g.lda = DM; g.K = DM; g.rowstep = 254; g.M = ((nrows + 253) / 254) * 256; g.N = 2 * DFF;
                    g.Bt = (const bf16*)(F.ws + WS_W_UP) + (size_t)layer * 2 * DFF * DM; E.bias = nullptr;
                    E.O = (bf16*)(F.ws + WS_R + R_G); E.ldc = DFF; E.act = 1; E.cw = F.inp(I_FCW) + (size_t)layer * 3 * DFF; E.cb = F.inp(I_FCB) + (size_t)layer * DFF;
                } else {
                    g.A = (const bf16*)(F.ws + WS_R + R_G); g.lda = DFF; g.K = DFF; g.M = nrows; g.N = DM;
                    g.Bt = (const bf16*)(F.ws + WS_W_DOWN) + (size_t)layer * DM * DFF; E.bias = nullptr;
                    E.O = (bf16*)(F.ws + WS_U); E.ldc = DM; if (need_ctx) { SK = SK_DOWN; E.slab = (float*)(F.ws + WS_R + R_SLAB2); }
                    FUSE_SETUP(3, 5, layer + 1 < DEPTH, layer + 1, 0, 0, 1, (const float*)F.out, 2);
                }
                pg8::Order2 S; S.init(g.M, g.N, F.G, F.bx, g.K, SK, split_first);
                pg8::gemm_phase<pg8::EpiBf16Slab, pg8::Order2, true, true>(F.lds, g, S, E, F.wave);
                if (s == 0 && F.G == 256) {
                    const int nwg = (g.M / 256) * (g.N / 256), first_idle = nwg % 256;
                    if (F.bx >= first_idle) { SET_TID(); tail_work(F, layer, first_idle); }
                }
            } else if (s == 1) {
                SET_TID();
                if (kind == 0) prep_a(F, j); else if (kind == 1) hy1t(F); else prep_c(F);
            } else if (s == 2) {
                SET_TID();
                if (kind == 0) attn_a_phase(F, need_ctx, j); else if (kind == 1) { hyfft(F); hyconv_ctx(F); } else attn_c_phase(F, need_ctx);
            } else if (s == 9) {
                SET_TID(); hy3(F);
            } else if (s == 4) {
                SET_TID();
                row_phase(F, 0, nrows, (const bf16*)(F.ws + WS_R + R_O), layer, 1, 2, true, layer, 2, 3, 4, (const float*)(F.ws + WS_R + R_SLAB), need_ctx ? SK_OUT : 0, layer == 0);
            } else {
                SET_TID();
                const bool more = layer + 1 < DEPTH;
                row_phase(F, 0, nrows, (const bf16*)(F.ws + WS_U), layer, 3, 5, more, layer + 1, 0, 0, 1, (const float*)(F.ws + WS_R + R_SLAB2), need_ctx ? SK_DOWN : 0, false, !more);
            }
        }
    }
}

#ifndef SINGLE_LAUNCH
#define SINGLE_LAUNCH 1
#endif
extern "C" void kernel_launch(void* const* d_in, const int* in_sizes, int n_in, void* d_out, int out_size, void* d_ws, size_t ws_size, hipStream_t stream) {
    static int grid = 0;
    if (grid == 0) {
        if (n_in != N_IN || out_size != MLAT * DM || ws_size < WS_END) { fprintf(stderr, "kernel_launch: unexpected shapes: n_in %d out %d ws %zu (need %zu)\n", n_in, out_size, ws_size, (size_t)WS_END); grid = -1; return; }
        int dev = 0, cus = 0;
        if (hipGetDevice(&dev) != hipSuccess || hipDeviceGetAttribute(&cus, hipDeviceAttributeMultiprocessorCount, dev) != hipSuccess) { grid = -1; return; }
        if (hipFuncSetAttribute((const void*)fwd_kernel, hipFuncAttributeMaxDynamicSharedMemorySize, LDS_BYTES) != hipSuccess) { fprintf(stderr, "kernel_launch: hipFuncSetAttribute failed\n"); grid = -1; return; }
        int per_cu = 0;
        if (hipOccupancyMaxActiveBlocksPerMultiprocessor(&per_cu, (const void*)fwd_kernel, NTHREADS, LDS_BYTES) != hipSuccess || per_cu < 1) fprintf(stderr, "kernel_launch: occupancy query reports %d\n", per_cu);
        (void)hipGetLastError();
        grid = cus;
    }
    if (grid < 0) return;
    if (hipMemsetAsync((char*)d_ws + WS_CTL, 0, CTL_ZERO_BYTES, stream) != hipSuccess) return;
    Args a{};
    for (int i = 0; i < N_IN; ++i) a.in[i] = (const float*)d_in[i];
    a.out = (float*)d_out; a.ws = (unsigned char*)d_ws;
#if SINGLE_LAUNCH
    a.ph_lo = 0; a.ph_hi = N_PHASES; a.single = 1;
    hipLaunchKernelGGL(fwd_kernel, dim3(grid), dim3(NTHREADS), LDS_BYTES, stream, a);
#else
    for (int p = 0; p < N_PHASES; ++p) { a.ph_lo = p; a.ph_hi = p + 1; a.single = 0;
        hipLaunchKernelGGL(fwd_kernel, dim3(grid), dim3(NTHREADS), LDS_BYTES, stream, a); }
#endif
    const hipError_t le = hipPeekAtLastError();
    if (le != hipSuccess) fprintf(stderr, "kernel_launch: launch failed: %s\n", hipGetErrorName(le));
}
```

```cpp
#include <hip/hip_runtime.h>
#include <cstdio>
#include <cstdint>
#include <cmath>
namespace pg8 {
#define PG8_LAS __attribute__((address_space(3)))
typedef unsigned short bf16_t;
typedef short bf16x8 __attribute__((ext_vector_type(8)));
typedef float f32x4 __attribute__((ext_vector_type(4)));
typedef unsigned u32x4 __attribute__((ext_vector_type(4)));
constexpr int BM = 256, BK = 64, HALF = 128, HTB = HALF * BK * 2  , STAGE_BYTES = 8 * HTB, NXCD = 8, WGM = 8;

__host__ __device__ __forceinline__ int lds_byte(int r, int c) { const int st = (r >> 4) * 2 + (c >> 5), rr = r & 15, cc = c & 31, ob = rr * 64 + cc * 2; return st * 1024 + (ob ^ (((ob >> 9) & 1) << 5)); }
__host__ __device__ __forceinline__ void stage_rc(int b, int& R, int& C) { const int st = b / 1024, sb = b % 1024, swz = sb ^ (((sb >> 9) & 1) << 5); R = (st >> 1) * 16 + swz / 64; C = (st & 1) * 32 + (swz % 64) / 2; }
__host__ __device__ __forceinline__ int perm32(int rho) { const int n = rho >> 4, i = rho & 15; return 8 * (i >> 2) + 4 * n + (i & 3); }

struct Unit { int pm, pn, kt0, nt, split; };
struct Gemm { const bf16_t* A; const bf16_t* Bt; int M, N, K, lda, rowstep; };

struct StaticOrder {
    int nM, nN, nwg, G, c, ntK;
    __host__ __device__ __forceinline__ void init(int M, int N, int G_, int c_, int K_) { nM = M / BM; nN = N / BM; nwg = nM * nN; G = G_; c = c_; ntK = K_ / BK; }
    __host__ __device__ __forceinline__ bool next(int i, Unit& u) const {
        const long L = (long)i * G + c; if (L >= nwg) return false;
        u.kt0 = 0; u.nt = ntK; u.split = -1;
        int wgid = (int)L; { const int q = nwg / NXCD, r = nwg % NXCD, xcd = wgid % NXCD, off = wgid / NXCD; wgid = (xcd < r ? xcd * (q + 1) : r * (q + 1) + (xcd - r) * q) + off; }
        const int nig = WGM * nN, gid = wgid / nig, fm = gid * WGM, gsz = (nM - fm) < WGM ? (nM - fm) : WGM;
        u.pm = fm + ((wgid % nig) % gsz); u.pn = (wgid % nig) / gsz; return true;
    }
    __device__ __forceinline__ void a_ready(const Unit&) const {}
    __device__ __forceinline__ void done(const Unit&) const {}
};

__device__ __forceinline__ unsigned cvt_pk_bf16(float lo, float hi) { unsigned r; asm volatile("v_cvt_pk_bf16_f32 %0, %1, %2" : "=v"(r) : "v"(lo), "v"(hi)); return r; }
__device__ __forceinline__ int fresh_lane() { unsigned m = ~0u; asm volatile("" : "+s"(m)); return (int)__builtin_amdgcn_mbcnt_hi(m, __builtin_amdgcn_mbcnt_lo(m, 0u)); }
struct EpiBf16 {
    static constexpr bool PERM = true, AFTER_DRAIN = false;
    bf16_t* O; int ldc; const float* bias;
    __device__ __forceinline__ void operator()(const f32x4 (&acc)[2][2][4][2], const Unit& u, int wr, int wc, int fr, int fq) const {
        const int row0 = u.pm * BM + wr * 64 + fr; const int col0 = u.pn * BM + wc * 32 + 8 * fq;
        f32x4 bv[2][2];
#pragma unroll
        for (int bj = 0; bj < 2; ++bj)
#pragma unroll
            for (int n = 0; n < 2; ++n) bv[bj][n] = bias ? *(const f32x4*)(bias + col0 + bj * HALF + 4 * n) : (f32x4){0.f, 0.f, 0.f, 0.f};
#pragma unroll
        for (int ai = 0; ai < 2; ++ai)
#pragma unroll
            for (int m = 0; m < 4; ++m) { bf16_t* rowp = O + (size_t)(row0 + ai * HALF + m * 16) * ldc + col0;
#pragma unroll
                for (int bj = 0; bj < 2; ++bj) { const f32x4 v0 = acc[ai][bj][m][0] + bv[bj][0], v1 = acc[ai][bj][m][1] + bv[bj][1];
                    u32x4 w; w.x = cvt_pk_bf16(v0[0], v0[1]); w.y = cvt_pk_bf16(v0[2], v0[3]); w.z = cvt_pk_bf16(v1[0], v1[1]); w.w = cvt_pk_bf16(v1[2], v1[3]);
                    *(u32x4*)(rowp + bj * HALF) = w; } }
    }
};

struct RowStats {
    unsigned* xbuf;
    unsigned* cnt;
    unsigned* tmo;
    float eps;
    __device__ __forceinline__ bool run(const f32x4 (&v)[2][2][4][2], const Unit& u, int wr, int wc, int fr, int fq, PG8_LAS unsigned char* lds, int wid, int lane) const {
        PG8_LAS float* P = (PG8_LAS float*)lds;
        PG8_LAS float* S = (PG8_LAS float*)(lds + 8192);
        PG8_LAS unsigned* flag = (PG8_LAS unsigned*)(lds + 8192 + 2048);
#pragma unroll
        for (int ai = 0; ai < 2; ++ai)
#pragma unroll
            for (int m = 0; m < 4; ++m) {
                float s = 0.f;
#pragma unroll
                for (int bj = 0; bj < 2; ++bj)
#pragma unroll
                    for (int n = 0; n < 2; ++n) { const f32x4 x = v[ai][bj][m][n]; s += (x[0] * x[0] + x[1] * x[1]) + (x[2] * x[2] + x[3] * x[3]); }
                s += __int_as_float(__builtin_amdgcn_ds_swizzle(__float_as_int(s), (16 << 10) | 0x1f));
                { const auto rr = __builtin_amdgcn_permlane32_swap(__float_as_uint(s), __float_as_uint(s), false, false); s = __uint_as_float(rr[0]) + __uint_as_float(rr[1]); }
                if (fq == 0) P[(ai * HALF + wr * 64 + m * 16 + fr) * 4 + wc] = s;
            }
        asm volatile("s_waitcnt lgkmcnt(0)" ::: "memory"); __builtin_amdgcn_s_barrier(); asm volatile("" ::: "memory");
        const int row = wid * 32 + (lane & 31);
        if (lane < 32) {
            const float t = (P[row * 4 + 0] + P[row * 4 + 1]) + (P[row * 4 + 2] + P[row * 4 + 3]);
            unsigned long long* slot = (unsigned long long*)xbuf + ((size_t)(u.pm * BM + row) * 4 + u.pn);
            __hip_atomic_store(slot, (unsigned long long)__float_as_uint(t), __ATOMIC_RELAXED, __HIP_MEMORY_SCOPE_AGENT);
        }
        asm volatile("s_waitcnt vmcnt(0)" ::: "memory");
        if (lane == 0) __hip_atomic_fetch_add(cnt + 64 * u.pm, 1u, __ATOMIC_RELAXED, __HIP_MEMORY_SCOPE_AGENT);
        if (wid == 0) {
            bool dead = false; const unsigned long long t0 = __builtin_amdgcn_s_memrealtime(); const unsigned want = 32u;
            for (;;) {
                if ((unsigned)__builtin_amdgcn_readfirstlane(__hip_atomic_load(cnt + 64 * u.pm, __ATOMIC_RELAXED, __HIP_MEMORY_SCOPE_AGENT)) >= want) break;
                if (__builtin_amdgcn_s_memrealtime() - t0 > 2000000ull) { if (lane == 0) __hip_atomic_store(tmo, 1u, __ATOMIC_RELAXED, __HIP_MEMORY_SCOPE_AGENT); dead = true; break; }
                __builtin_amdgcn_s_sleep(2);
            }
            __builtin_amdgcn_fence(__ATOMIC_ACQUIRE, "agent");
            if (lane == 0) flag[0] = dead ? 1u : 0u;
        }
        asm volatile("s_waitcnt vmcnt(0) lgkmcnt(0)" ::: "memory"); __builtin_amdgcn_s_barrier(); asm volatile("" ::: "memory");
        const bool bad = flag[0] != 0u;
        if (lane < 32) {
            const unsigned long long* slot = (const unsigned long long*)xbuf + (size_t)(u.pm * BM + row) * 4; float tot = 0.f;
#pragma unroll
            for (int t = 0; t < 4; ++t) tot += __uint_as_float((unsigned)__hip_atomic_load(slot + t, __ATOMIC_RELAXED, __HIP_MEMORY_SCOPE_AGENT));
            S[row] = 1.0f / sqrtf(tot * (1.0f / 1024.0f) + eps);
        }
        asm volatile("s_waitcnt lgkmcnt(0)" ::: "memory"); __builtin_amdgcn_s_barrier(); asm volatile("" ::: "memory");
        return bad;
    }
};
struct EpiBf16Slab {
    static constexpr bool PERM = true, AFTER_DRAIN = false;
    bf16_t* O; int ldc; const float* bias; float* slab;
    int act; const float* cw; const float* cb; PG8_LAS float* ex; int nrows;
    bf16_t* kro; const float* kcs;
    int fuse, do_norm; const float* h_in; float* h_out; bf16_t* Uo; const float* g_res; const float* g_n; const float* mod_res; const float* mod_n; int gate_idx, shift_idx, scale_idx; RowStats st1, st2;
    __device__ __forceinline__ void fused(f32x4 (&acc)[2][2][4][2], const Unit& u, int wr, int wc, int fr, int fq, PG8_LAS unsigned char* lds, int wid, int lane) const {
        const PG8_LAS float* S = (const PG8_LAS float*)(lds + 8192);
        const int col0 = u.pn * BM + wc * 32 + 8 * fq, b = u.pm >> 4;
        const float qnan = __builtin_nanf("");
#pragma unroll
        for (int bj = 0; bj < 2; ++bj)
#pragma unroll
            for (int n = 0; n < 2; ++n) { const f32x4 bv = bias ? *(const f32x4*)(bias + col0 + bj * HALF + 4 * n) : (f32x4){0.f, 0.f, 0.f, 0.f};
#pragma unroll
                for (int ai = 0; ai < 2; ++ai)
#pragma unroll
                    for (int m = 0; m < 4; ++m) acc[ai][bj][m][n] += bv; }
        bool bad = st1.run(acc, u, wr, wc, fr, fq, lds, wid, lane);
        {
            const float* gt = mod_res + (size_t)b * 6144 + gate_idx * 1024;
            f32x4 gg[2][2], mm[2][2];
#pragma unroll
            for (int bj = 0; bj < 2; ++bj)
#pragma unroll
                for (int n = 0; n < 2; ++n) { gg[bj][n] = *(const f32x4*)(g_res + col0 + bj * HALF + 4 * n); mm[bj][n] = *(const f32x4*)(gt + col0 + bj * HALF + 4 * n); gg[bj][n] = gg[bj][n] * mm[bj][n]; }
#pragma unroll
            for (int ai = 0; ai < 2; ++ai)
#pragma unroll
                for (int m = 0; m < 4; ++m) { const int r = ai * HALF + wr * 64 + m * 16 + fr; const float rs = S[r]; const size_t off = (size_t)(u.pm * BM + r) * 1024 + col0;
#pragma unroll
                    for (int bj = 0; bj < 2; ++bj)
#pragma unroll
                        for (int n = 0; n < 2; ++n) { const f32x4 hb = *(const f32x4*)(h_in + off + bj * HALF + 4 * n); f32x4 o = hb + (acc[ai][bj][m][n] * rs) * gg[bj][n];
                            if (bad) o = (f32x4){qnan, qnan, qnan, qnan};
                            acc[ai][bj][m][n] = o; *(f32x4*)(h_out + off + bj * HALF + 4 * n) = o; }
                    if (m & 1) asm volatile("" ::: "memory"); }
        }
        if (!do_norm) return;
        bad = st2.run(acc, u, wr, wc, fr, fq, lds, wid, lane) || bad;
        {
            const float* mv = mod_n + (size_t)b * 6144;
            f32x4 gg[2][2], sh[2][2], sc[2][2];
#pragma unroll
            for (int bj = 0; bj < 2; ++bj)
#pragma unroll
                for (int n = 0; n < 2; ++n) { const int c = col0 + bj * HALF + 4 * n; gg[bj][n] = *(const f32x4*)(g_n + c); sh[bj][n] = *(const f32x4*)(mv + shift_idx * 1024 + c); sc[bj][n] = *(const f32x4*)(mv + scale_idx * 1024 + c) + 1.0f; gg[bj][n] = gg[bj][n] * sc[bj][n]; }
#pragma unroll
            for (int ai = 0; ai < 2; ++ai)
#pragma unroll
                for (int m = 0; m < 4; ++m) { const int r = ai * HALF + wr * 64 + m * 16 + fr; const float rs = S[r]; bf16_t* rowp = Uo + (size_t)(u.pm * BM + r) * 1024 + col0;
#pragma unroll
                    for (int bj = 0; bj < 2; ++bj) { const f32x4 y0 = (acc[ai][bj][m][0] * rs) * gg[bj][0] + sh[bj][0], y1 = (acc[ai][bj][m][1] * rs) * gg[bj][1] + sh[bj][1];
                        u32x4 w; w.x = cvt_pk_bf16(y0[0], y0[1]); w.y = cvt_pk_bf16(y0[2], y0[3]); w.z = cvt_pk_bf16(y1[0], y1[1]); w.w = cvt_pk_bf16(y1[2], y1[3]);
                        if (bad) { w.x = 0x7fc07fc0u; w.y = 0x7fc07fc0u; w.z = 0x7fc07fc0u; w.w = 0x7fc07fc0u; }
                        *(u32x4*)(rowp + bj * HALF) = w; } }
        }
    }
    __device__ __forceinline__ void prefetch(const Unit& u, int slot, int wid, PG8_LAS unsigned char* lds) const {
        if (wid != 0) return;
        const int lane = fresh_lane();
        PG8_LAS unsigned char* dst = lds + 131072 + 4096 + 2048 * slot;
        if (act) {
            const int arr = lane >> 5, col = 4 * (lane & 31);
            const float* s0 = (arr == 0 ? cw : cw + 2816) + u.pn * 128 + col; const float* s1 = (arr == 0 ? cw + 2 * 2816 : cb) + u.pn * 128 + col;
            __builtin_amdgcn_global_load_lds((const unsigned*)s0, (PG8_LAS unsigned*)dst, 16, 0, 0);
            __builtin_amdgcn_global_load_lds((const unsigned*)s1, (PG8_LAS unsigned*)(dst + 1024), 16, 0, 0);
        } else if (bias) {
            __builtin_amdgcn_global_load_lds((const unsigned*)(bias + u.pn * 256 + 4 * lane), (PG8_LAS unsigned*)dst, 16, 0, 0);
        }
    }
    __device__ __forceinline__ static float dpp_ror1(float v) { return __int_as_float(__builtin_amdgcn_mov_dpp(__float_as_int(v), 0x121, 0xf, 0xf, false)); }
    __device__ __forceinline__ static float dpp_ror15(float v) { return __int_as_float(__builtin_amdgcn_mov_dpp(__float_as_int(v), 0x12f, 0xf, 0xf, false)); }
    __device__ __forceinline__ void act_epilogue(const f32x4 (&acc)[2][2][4][2], const Unit& u, int wr, int wc, int fr, int fq, const PG8_LAS float* P) const {
        const int cl = wc * 32 + 8 * fq;
#pragma unroll
        for (int ai = 0; ai < 2; ++ai) { const int g = 2 * ai + wr;
            f32x4 e0, e1;
#pragma unroll
            for (int e = 0; e < 4; ++e) { e0[e] = fr == 0 ? acc[ai][0][0][0][e] : acc[ai][0][3][0][e]; e1[e] = fr == 0 ? acc[ai][0][0][1][e] : acc[ai][0][3][1][e]; }
            if (fr == 0 || fr == 15) { PG8_LAS float* dst = ex + (g * 2 + (fr == 0 ? 0 : 1)) * 128 + cl; *(PG8_LAS f32x4*)dst = e0; *(PG8_LAS f32x4*)(dst + 4) = e1; } }
        asm volatile("s_waitcnt lgkmcnt(0)" ::: "memory"); __builtin_amdgcn_s_barrier(); asm volatile("" ::: "memory");
        const int c0 = u.pn * 128 + cl;
        f32x4 w0[2], w1[2], w2[2], bb[2];
#pragma unroll
        for (int n = 0; n < 2; ++n) { w0[n] = *(const PG8_LAS f32x4*)(P + cl + 4 * n); w1[n] = *(const PG8_LAS f32x4*)(P + 128 + cl + 4 * n); w2[n] = *(const PG8_LAS f32x4*)(P + 256 + cl + 4 * n); bb[n] = *(const PG8_LAS f32x4*)(P + 384 + cl + 4 * n); }
        const int rbase = 254 * u.pm - 1;
#pragma unroll
        for (int ai = 0; ai < 2; ++ai) { const int g = 2 * ai + wr;
            f32x4 pb[2], nb[2];
#pragma unroll
            for (int n = 0; n < 2; ++n) { pb[n] = g > 0 ? *(const PG8_LAS f32x4*)(ex + ((g - 1) * 2 + 1) * 128 + cl + 4 * n) : (f32x4){0.f, 0.f, 0.f, 0.f};
                                          nb[n] = g < 3 ? *(const PG8_LAS f32x4*)(ex + ((g + 1) * 2 + 0) * 128 + cl + 4 * n) : (f32x4){0.f, 0.f, 0.f, 0.f}; }
            float fmk[4], lmk[4]; unsigned owp[4][4];
#pragma unroll
            for (int m = 0; m < 4; ++m) { const int R = rbase + 64 * g + 16 * m + fr, tq = R < 16384 ? (R & 4095) : ((R - 16384) & 255);
                fmk[m] = tq == 0 ? 0.f : 1.f; lmk[m] = (R < 16384 ? tq == 4095 : tq == 255) ? 0.f : 1.f; }
#pragma unroll
            for (int n = 0; n < 2; ++n) {
                f32x4 pv[4], nv[4];
#pragma unroll
                for (int e = 0; e < 4; ++e) { float rr[4], rl[4];
#pragma unroll
                    for (int m = 0; m < 4; ++m) { rr[m] = dpp_ror1(acc[ai][0][m][n][e]); rl[m] = dpp_ror15(acc[ai][0][m][n][e]); }
#pragma unroll
                    for (int m = 0; m < 4; ++m) { pv[m][e] = fr == 0 ? (m > 0 ? rr[m > 0 ? m - 1 : 0] : pb[n][e]) : rr[m]; nv[m][e] = fr == 15 ? (m < 3 ? rl[m < 3 ? m + 1 : 3] : nb[n][e]) : rl[m]; } }
#pragma unroll
                for (int m = 0; m < 4; ++m) {
                    typedef float f32x2_ __attribute__((ext_vector_type(2)));
                    const f32x2_ fm2 = {fmk[m], fmk[m]}, lm2 = {lmk[m], lmk[m]};
#pragma unroll
                    for (int h = 0; h < 2; ++h) {
                        const f32x2_ w0h = {w0[n][2 * h], w0[n][2 * h + 1]}, w1h = {w1[n][2 * h], w1[n][2 * h + 1]}, w2h = {w2[n][2 * h], w2[n][2 * h + 1]}, bbh = {bb[n][2 * h], bb[n][2 * h + 1]};
                        const f32x2_ pvh = {pv[m][2 * h], pv[m][2 * h + 1]}, nvh = {nv[m][2 * h], nv[m][2 * h + 1]}, gh = {acc[ai][0][m][n][2 * h], acc[ai][0][m][n][2 * h + 1]}, uh = {acc[ai][1][m][n][2 * h], acc[ai][1][m][n][2 * h + 1]};
                        f32x2_ gc = __builtin_elementwise_fma(w1h, gh, bbh);
                        gc = __builtin_elementwise_fma(w0h * fm2, pvh, gc);
                        gc = __builtin_elementwise_fma(w2h * lm2, nvh, gc);
                        const f32x2_ tt = gc * (f32x2_){-1.4426950408889634f, -1.4426950408889634f};
                        const f32x2_ dd = (f32x2_){__builtin_amdgcn_exp2f(tt[0]), __builtin_amdgcn_exp2f(tt[1])} + (f32x2_){1.0f, 1.0f};
                        const f32x2_ a2 = (gc * (f32x2_){__builtin_amdgcn_rcpf(dd[0]), __builtin_amdgcn_rcpf(dd[1])}) * uh;
                        owp[m][2 * n + h] = cvt_pk_bf16(a2[0], a2[1]); } } }
#pragma unroll
            for (int m = 0; m < 4; ++m) { const int rho = 64 * g + 16 * m + fr, R = rbase + rho;
                if (rho >= 1 && rho <= 254 && R < nrows) *(u32x4*)(O + (size_t)R * ldc + c0) = (u32x4){owp[m][0], owp[m][1], owp[m][2], owp[m][3]}; }
        }
    }
    __device__ __forceinline__ void operator()(const f32x4 (&acc)[2][2][4][2], const Unit& u, int wr, int wc, int fr, int fq, int slot, PG8_LAS unsigned char* lds) const {
        const PG8_LAS float* P = (const PG8_LAS float*)(lds + 131072 + 4096 + 2048 * slot);
        if (act) { act_epilogue(acc, u, wr, wc, fr, fq, P); return; }
        const int row0 = u.pm * BM + wr * 64 + fr; const int col0 = u.pn * BM + wc * 32 + 8 * fq;
        f32x4 bv[2][2];
#pragma unroll
        for (int bj = 0; bj < 2; ++bj)
#pragma unroll
            for (int n = 0; n < 2; ++n) bv[bj][n] = (bias && u.split <= 0) ? *(const PG8_LAS f32x4*)(P + wc * 32 + 8 * fq + bj * HALF + 4 * n) : (f32x4){0.f, 0.f, 0.f, 0.f};
        const bool krp = kro != nullptr && u.pn == 4 && u.split < 0;
        bf16_t* sb = (bf16_t*)slab + ((size_t)(u.split < 0 ? 0 : u.split) * 1024 + (row0 - 64 * BM)) * 1024 + col0;
#pragma unroll
        for (int ai = 0; ai < 2; ++ai)
#pragma unroll
            for (int m = 0; m < 4; ++m) {
                const f32x4 v00 = acc[ai][0][m][0] + bv[0][0], v01 = acc[ai][0][m][1] + bv[0][1], v10 = acc[ai][1][m][0] + bv[1][0], v11 = acc[ai][1][m][1] + bv[1][1];
                if (u.split < 0) { bf16_t* rowp = O + (size_t)(row0 + ai * HALF + m * 16) * ldc + col0;
                    u32x4 w;
                    if (krp) {
                        const int r = row0 + ai * HALF + m * 16; const bool lat = r < 16384; const int t = lat ? (r & 4095) : ((r - 16384) & 255), bb_ = lat ? (r >> 12) : ((r - 16384) >> 8);
                        const int hh = wc >> 1, pos = (wc & 1) ? (t & 63) : (t >> 6);
                        const float* ct = kcs + (size_t)(pos * 16 + 4 * fq) * 2;
                        const f32x4 c01 = lat ? *(const f32x4*)ct : (f32x4){1.f, 0.f, 1.f, 0.f}, c23 = lat ? *(const f32x4*)(ct + 4) : (f32x4){1.f, 0.f, 1.f, 0.f};
                        bf16_t* kd = kro + ((size_t)bb_ * 4352 + (lat ? 256 + t : t)) * 128 + hh * 64 + (wc & 1) * 16 + 4 * fq;
#pragma unroll
                        for (int n = 0; n < 2; ++n) { const f32x4 a = n == 0 ? acc[ai][0][m][0] : acc[ai][0][m][1]; const f32x4 cs4 = n == 0 ? c01 : c23; const int ib = hh * 64 + (wc & 1) * 16 + 4 * fq + 2 * n;
                            const float x1a = a[0] + P[ib], x2a = a[1] + P[ib + 32], x1b = a[2] + P[ib + 1], x2b = a[3] + P[ib + 33];
                            *(unsigned*)(kd + 2 * n) = cvt_pk_bf16(x1a * cs4[0] - x2a * cs4[1], x1b * cs4[2] - x2b * cs4[3]);
                            *(unsigned*)(kd + 32 + 2 * n) = cvt_pk_bf16(x1a * cs4[1] + x2a * cs4[0], x1b * cs4[3] + x2b * cs4[2]); }
                    } else {
                    w.x = cvt_pk_bf16(v00[0], v00[1]); w.y = cvt_pk_bf16(v00[2], v00[3]); w.z = cvt_pk_bf16(v01[0], v01[1]); w.w = cvt_pk_bf16(v01[2], v01[3]);
                    *(u32x4*)rowp = w; }
                    w.x = cvt_pk_bf16(v10[0], v10[1]); w.y = cvt_pk_bf16(v10[2], v10[3]); w.z = cvt_pk_bf16(v11[0], v11[1]); w.w = cvt_pk_bf16(v11[2], v11[3]);
                    *(u32x4*)(rowp + HALF) = w;
                } else { bf16_t* rowp = sb + (size_t)(ai * HALF + m * 16) * 1024;
                    u32x4 w; w.x = cvt_pk_bf16(v00[0], v00[1]); w.y = cvt_pk_bf16(v00[2], v00[3]); w.z = cvt_pk_bf16(v01[0], v01[1]); w.w = cvt_pk_bf16(v01[2], v01[3]);
                    *(u32x4*)rowp = w;
                    w.x = cvt_pk_bf16(v10[0], v10[1]); w.y = cvt_pk_bf16(v10[2], v10[3]); w.z = cvt_pk_bf16(v11[0], v11[1]); w.w = cvt_pk_bf16(v11[2], v11[3]);
                    *(u32x4*)(rowp + HALF) = w; }
                asm volatile("" ::: "memory");
            }
    }
};

struct Order2 {
    int nM, nN, G, c, ntK, mode, SK, split_first;
    __host__ __device__ __forceinline__ void init(int M, int N, int G_, int c_, int K_, int SK_, int split_first_ = 0) { mode = SK_ > 0 || split_first_; SK = SK_; split_first = split_first_; nM = mode ? 64 : M / BM; nN = N / BM; G = G_; c = c_; ntK = K_ / BK; }
    __host__ __device__ __forceinline__ bool next(int i, Unit& u) const {
        const int L = i * G + c, nwg = nM * nN, ns = 16 * SK;
        int pm = 0, pn = 0, kt0 = 0, nt = ntK, split = -1; bool ok = true;
        int Lt = -1, xs = -1;
        if (mode && split_first) { if (i == 0) { if (c < ns) xs = c; else Lt = c; } else if (i == 1 && c < ns) Lt = c; else ok = false; }
        else if (L < nwg) Lt = L;
        else if (mode && L - nwg < ns) xs = L - nwg;
        else ok = false;
        if (Lt >= 0) {
            int wgid = Lt; { const int q = nwg / NXCD, r = nwg % NXCD, xcd = wgid % NXCD, off = wgid / NXCD; wgid = (xcd < r ? xcd * (q + 1) : r * (q + 1) + (xcd - r) * q) + off; }
            const int nig = WGM * nN, gid = wgid / nig, fm = gid * WGM, gsz = (nM - fm) < WGM ? (nM - fm) : WGM;
            pm = fm + ((wgid % nig) % gsz); pn = (wgid % nig) / gsz;
        } else if (xs >= 0) {
            const int tile = xs / SK, sp = xs % SK, pairs = ntK / 2, q = pairs / SK, r = pairs % SK;
            pm = 64 + (tile >> 2); pn = tile & 3; split = sp;
            if (sp < r) { kt0 = 2 * sp * (q + 1); nt = 2 * (q + 1); } else { kt0 = 2 * (r * (q + 1) + (sp - r) * q); nt = 2 * q; }
        }
#if defined(__HIP_DEVICE_COMPILE__)
        u.pm = __builtin_amdgcn_readfirstlane(pm); u.pn = __builtin_amdgcn_readfirstlane(pn); u.kt0 = __builtin_amdgcn_readfirstlane(kt0); u.nt = __builtin_amdgcn_readfirstlane(nt); u.split = __builtin_amdgcn_readfirstlane(split);
        return __builtin_amdgcn_readfirstlane((int)ok) != 0;
#else
        u.pm = pm; u.pn = pn; u.kt0 = kt0; u.nt = nt; u.split = split;
        return ok;
#endif
    }
    __device__ __forceinline__ void a_ready(const Unit&) const {}
    __device__ __forceinline__ void done(const Unit&) const {}
};

template <class Epi, class Sched, bool ALIGN_EPI = false, bool SP2 = false>
__device__ __forceinline__ void gemm_phase(PG8_LAS unsigned char* lds, const Gemm g, const Sched& S, const Epi& E, const int wid) {
    const int lane = fresh_lane(), tid = wid * 64 + lane, wr = wid >> 2, wc = wid & 3, fr = lane & 15, fq = lane >> 4;
    const int K = g.K;
    unsigned voffA[2], voffB[2];
#pragma unroll
    for (int i = 0; i < 2; ++i) { int R, C; stage_rc(tid * 16 + i * 8192, R, C); const int Rb = Epi::PERM ? ((R & ~31) + perm32(R & 31)) : R;
        voffA[i] = (unsigned)(R * g.lda + C) * 2u; voffB[i] = (unsigned)(Rb * K + C) * 2u; }
    const size_t kstep = (size_t)(BK * 2);
    const size_t hstepA = (size_t)HALF * g.lda * 2, hstepB = (size_t)HALF * K * 2;
    const size_t tstepA = (size_t)g.rowstep * g.lda * 2, tstepB = 2 * hstepB;
    const unsigned ldsw = (unsigned)wid * 1024u;
    const int aoff = lds_byte(wr * 64 + fr, fq * 8), boff = lds_byte(wc * 32 + fr, fq * 8);
#define PG8_SA(b, h) (((b) * 2 + (h)) * HTB)
#define PG8_SB(b, h) ((4 + (b) * 2 + (h)) * HTB)
#define PG8_STAGE(bufoff, gbase, voff) do { _Pragma("unroll") for (int _i = 0; _i < 2; ++_i) \
        __builtin_amdgcn_global_load_lds((const unsigned*)((const char*)(gbase) + (voff)[_i]), (PG8_LAS unsigned*)(lds + (bufoff) + ldsw + _i * 8192), 16, 0, 0); } while (0)
#define PG8_LDA(dst, b, h) do { _Pragma("unroll") for (int m = 0; m < 4; ++m) _Pragma("unroll") for (int k = 0; k < 2; ++k) dst[m][k] = *(const PG8_LAS bf16x8*)(lds + PG8_SA(b, h) + aoff + m * 2048 + k * 1024); } while (0)
#define PG8_LDB(dst, b, h) do { _Pragma("unroll") for (int n = 0; n < 2; ++n) _Pragma("unroll") for (int k = 0; k < 2; ++k) dst[n][k] = *(const PG8_LAS bf16x8*)(lds + PG8_SB(b, h) + boff + n * 2048 + k * 1024); } while (0)
#define PG8_MMA(ai, bj, At, Bt) do { __builtin_amdgcn_s_setprio(1); _Pragma("unroll") for (int m = 0; m < 4; ++m) _Pragma("unroll") for (int n = 0; n < 2; ++n) _Pragma("unroll") for (int k = 0; k < 2; ++k) \
        acc[ai][bj][m][n] = __builtin_amdgcn_mfma_f32_16x16x32_bf16(Bt[n][k], At[m][k], acc[ai][bj][m][n], 0, 0, 0); __builtin_amdgcn_s_setprio(0); } while (0)
#define PG8_WAIT_V(n) asm volatile("s_waitcnt vmcnt(" #n ")" ::: "memory")
#define PG8_WAIT_L(n) asm volatile("s_waitcnt lgkmcnt(" #n ")" ::: "memory")
#define PG8_BAR __builtin_amdgcn_s_barrier()
#define PG8_SCHED __builtin_amdgcn_sched_barrier(0)
    Unit cur, nxt; int ui = 0;
    if (!S.next(0, cur)) return;
    f32x4 acc[2][2][4][2];
#pragma unroll
    for (int a = 0; a < 2; ++a)
#pragma unroll
        for (int b = 0; b < 2; ++b)
#pragma unroll
            for (int m = 0; m < 4; ++m)
#pragma unroll
                for (int n = 0; n < 2; ++n) acc[a][b][m][n] = (f32x4){0.f, 0.f, 0.f, 0.f};
    bf16x8 At[4][2], B0[2][2], B1[2][2];
    const char* cA = (const char*)g.A + (size_t)cur.pm * tstepA + (size_t)cur.kt0 * kstep; const char* cB = (const char*)g.Bt + (size_t)cur.pn * tstepB + (size_t)cur.kt0 * kstep;
    S.a_ready(cur);
    E.prefetch(cur, 0, wid, lds);
    if constexpr (SP2) {
        PG8_STAGE(PG8_SB(0, 0), cB, voffB); PG8_STAGE(PG8_SB(0, 1), cB + hstepB, voffB); PG8_STAGE(PG8_SA(0, 0), cA, voffA); PG8_STAGE(PG8_SA(0, 1), cA + hstepA, voffA);
        if (wr == 1) PG8_BAR;
        PG8_WAIT_V(2); PG8_BAR;
        PG8_STAGE(PG8_SB(1, 0), cB + kstep, voffB); PG8_STAGE(PG8_SA(1, 0), cA + kstep, voffA); PG8_STAGE(PG8_SB(1, 1), cB + hstepB + kstep, voffB);
        PG8_WAIT_V(6); PG8_BAR;
    } else {
        PG8_STAGE(PG8_SB(0, 0), cB, voffB); PG8_STAGE(PG8_SA(0, 0), cA, voffA); PG8_STAGE(PG8_SB(0, 1), cB + hstepB, voffB); PG8_STAGE(PG8_SA(0, 1), cA + hstepA, voffA);
        if (wr == 1) PG8_BAR;
        PG8_WAIT_V(4); PG8_BAR;
        PG8_STAGE(PG8_SB(1, 0), cB + kstep, voffB); PG8_STAGE(PG8_SA(1, 0), cA + kstep, voffA); PG8_STAGE(PG8_SB(1, 1), cB + hstepB + kstep, voffB);
        PG8_WAIT_V(6); PG8_BAR;
    }
    for (;;) {
        const bool has_next = S.next(ui + 1, nxt);
        if (has_next) E.prefetch(nxt, (ui + 1) % 3, wid, lds);
        const char* nA = has_next ? (const char*)g.A + (size_t)nxt.pm * tstepA + (size_t)nxt.kt0 * kstep : cA; const char* nB = has_next ? (const char*)g.Bt + (size_t)nxt.pn * tstepB + (size_t)nxt.kt0 * kstep : cB;
        const int nt = cur.nt;
        for (int t = 0; t < nt; t += 2) {
            const bool last = (t == nt - 2);
            const char* a1 = cA + (size_t)(t + 1) * kstep;
            const char* a2 = last ? nA : cA + (size_t)(t + 2) * kstep; const char* b2 = last ? nB : cB + (size_t)(t + 2) * kstep;
            const char* a3 = a2 + kstep; const char* b3 = b2 + kstep;
            if (last && has_next) S.a_ready(nxt);
            if constexpr (SP2) {
            PG8_LDB(B0, 0, 0); PG8_LDB(B1, 0, 1); PG8_SCHED; PG8_LDA(At, 0, 0); PG8_STAGE(PG8_SA(1, 1), a1 + hstepA, voffA);
            PG8_WAIT_V(8); PG8_WAIT_L(0); PG8_BAR; PG8_MMA(0, 0, At, B0); PG8_MMA(0, 1, At, B1); PG8_BAR; PG8_SCHED;
            PG8_LDA(At, 0, 1); PG8_STAGE(PG8_SB(0, 0), b2, voffB); PG8_STAGE(PG8_SB(0, 1), b2 + hstepB, voffB); PG8_STAGE(PG8_SA(0, 0), a2, voffA);
            PG8_WAIT_V(8); PG8_WAIT_L(0); PG8_BAR; PG8_MMA(1, 0, At, B0); PG8_MMA(1, 1, At, B1); PG8_BAR; PG8_SCHED;
            PG8_LDB(B0, 1, 0); PG8_LDB(B1, 1, 1); PG8_SCHED; PG8_LDA(At, 1, 0); PG8_STAGE(PG8_SA(0, 1), a2 + hstepA, voffA);
            PG8_WAIT_V(8); PG8_WAIT_L(0); PG8_BAR; PG8_MMA(0, 0, At, B0); PG8_MMA(0, 1, At, B1); PG8_BAR; PG8_SCHED;
            PG8_LDA(At, 1, 1); PG8_STAGE(PG8_SB(1, 0), b3, voffB); PG8_STAGE(PG8_SB(1, 1), b3 + hstepB, voffB); PG8_STAGE(PG8_SA(1, 0), a3, voffA);
            PG8_WAIT_V(8); PG8_WAIT_L(0); PG8_BAR; PG8_MMA(1, 0, At, B0); PG8_MMA(1, 1, At, B1); PG8_BAR; PG8_SCHED;
            } else {
            PG8_LDB(B0, 0, 0); PG8_SCHED; PG8_LDA(At, 0, 0); PG8_STAGE(PG8_SA(1, 1), a1 + hstepA, voffA);
            PG8_WAIT_L(8); PG8_BAR; PG8_WAIT_L(0); PG8_MMA(0, 0, At, B0); PG8_BAR; PG8_SCHED;
            PG8_LDB(B1, 0, 1); PG8_STAGE(PG8_SB(0, 0), b2, voffB);
            PG8_BAR; PG8_WAIT_L(0); PG8_MMA(0, 1, At, B1); PG8_BAR;
            PG8_LDA(At, 0, 1); PG8_STAGE(PG8_SA(0, 0), a2, voffA);
            PG8_BAR; PG8_WAIT_L(0); PG8_MMA(1, 0, At, B0); PG8_BAR; PG8_SCHED;
            PG8_STAGE(PG8_SB(0, 1), b2 + hstepB, voffB);
            PG8_WAIT_V(6); PG8_BAR; PG8_MMA(1, 1, At, B1); PG8_BAR;
            PG8_LDB(B0, 1, 0); PG8_SCHED; PG8_LDA(At, 1, 0); PG8_STAGE(PG8_SA(0, 1), a2 + hstepA, voffA);
            PG8_WAIT_L(8); PG8_BAR; PG8_WAIT_L(0); PG8_MMA(0, 0, At, B0); PG8_BAR; PG8_SCHED;
            PG8_LDB(B1, 1, 1); PG8_STAGE(PG8_SB(1, 0), b3, voffB);
            PG8_BAR; PG8_WAIT_L(0); PG8_MMA(0, 1, At, B1); PG8_BAR;
            PG8_LDA(At, 1, 1); PG8_STAGE(PG8_SA(1, 0), a3, voffA);
            PG8_BAR; PG8_WAIT_L(0); PG8_MMA(1, 0, At, B0); PG8_BAR; PG8_SCHED;
            PG8_STAGE(PG8_SB(1, 1), b3 + hstepB, voffB);
            PG8_WAIT_V(6); PG8_BAR; PG8_MMA(1, 1, At, B1); PG8_BAR;
            }
        }
        if constexpr (ALIGN_EPI) { if (wr == 0) PG8_BAR; }
        if (!(E.fuse && !has_next)) { const int le = fresh_lane(); E(acc, cur, wr, wc, le & 15, le >> 4, ui % 3, lds); S.done(cur); }
        if (!has_next) break;
#pragma unroll
        for (int a = 0; a < 2; ++a)
#pragma unroll
            for (int b = 0; b < 2; ++b)
#pragma unroll
                for (int m = 0; m < 4; ++m)
#pragma unroll
                    for (int n = 0; n < 2; ++n) acc[a][b][m][n] = (f32x4){0.f, 0.f, 0.f, 0.f};
        cur = nxt; cA = nA; cB = nB; ++ui;
        if constexpr (ALIGN_EPI) { if (wr == 1) PG8_BAR; }
    }
    PG8_WAIT_V(0);
    if constexpr (!ALIGN_EPI) { if (wr == 0) PG8_BAR; }
    PG8_BAR;
    if (E.fuse) { const int le = fresh_lane(); E.fused(acc, cur, wr, wc, le & 15, le >> 4, lds, wid, le); S.done(cur); }
#undef PG8_SA
#undef PG8_SB
#undef PG8_STAGE
#undef PG8_LDA
#undef PG8_LDB
#undef PG8_MMA
#undef PG8_WAIT_V
#undef PG8_WAIT_L
#undef PG8_BAR
#undef PG8_SCHED
}
}

constexpr int NWAVES = 8, NTHREADS = 512;
constexpr int DM = 1024, BATCH = 4, SEQ = 4096, CTXL = 256, DEPTH = 4, DFF = 2816, NMOD = 6;
constexpr int MLAT = BATCH * SEQ, MCTX = BATCH * CTXL, MT = MLAT + MCTX;
constexpr int NKEY = CTXL + SEQ;
constexpr int A_HEADS = 8, A_KV = 2, A_DH = 128, A_COLS = (A_HEADS + 2 * A_KV) * A_DH;
constexpr int C_HEADS = 16, C_KV = 2, C_DH = 64, C_COLS = (C_HEADS + 2 * C_KV) * C_DH;
constexpr int WINDOW = 128, GRID_W = 64;
constexpr float EPS = 1e-6f;
constexpr int N_IN = 34;
enum { I_X = 0, I_C, I_CTX, I_CCTX, I_MODW, I_MODB, I_NORMG, I_WUP, I_FCW, I_FCB, I_WDOWN, I_AQKV, I_AQG, I_AKG, I_AOUT,
       I_BIN, I_BBIN, I_BCW, I_BCB, I_FW1, I_FB1, I_FW2, I_FB2, I_FW3, I_FB3, I_FW4, I_BSKIP, I_BOUT, I_BBOUT, I_CQKV, I_CBQKV, I_CSINK, I_COUT, I_CBOUT };

constexpr size_t MiB = 1u << 20;
constexpr size_t WS_CTL = 0, CTL_ZERO_BYTES = 1 * MiB;
constexpr size_t WS_W_AQKV = 1 * MiB, WS_W_AOUT = 7 * MiB, WS_W_BIN = 11 * MiB, WS_W_BOUT = 17 * MiB, WS_W_CQKV = 19 * MiB, WS_W_COUT = 22 * MiB;
constexpr size_t WS_W_UP = 24 * MiB, WS_W_DOWN = 68 * MiB;
constexpr size_t WS_MOD = 90 * MiB, WS_HCLAT = 91 * MiB, WS_HCCTX = 123 * MiB, WS_HCTX = 125 * MiB, WS_U = 130 * MiB, WS_R = 164 * MiB, WS_HB = 351 * MiB, WS_END = 383 * MiB;
constexpr size_t R_QKV = 0, R_QN = 102 * MiB, R_KB = 136 * MiB, R_VB = 145 * MiB, R_VPT = 102 * MiB, R_VPC = 166 * MiB, R_O = 0, R_G = 0;
static_assert(WS_W_AQKV + 2ull * A_COLS * DM * 2 <= WS_W_AOUT && WS_W_CQKV + (size_t)C_COLS * DM * 2 <= WS_W_COUT && WS_W_UP + 4ull * 2 * DFF * DM * 2 <= WS_W_DOWN && WS_W_DOWN + 4ull * DM * DFF * 2 <= WS_MOD, "weights map");
static_assert(WS_HCLAT + (size_t)(2 * SEQ - 1) * DM * 4 <= WS_HCCTX && WS_HCCTX + (size_t)(2 * CTXL - 1) * DM * 4 <= WS_HCTX && WS_U + (size_t)MT * DM * 2 <= WS_R && WS_R + (size_t)MT * 2 * DFF * 2 <= WS_HB && WS_HB + (size_t)MLAT * DM * 2 <= WS_END, "ws map");
static_assert(R_VB + (size_t)BATCH * NKEY * 256 * 2 <= 187 * MiB && R_VPT + (size_t)MLAT * DM * 4 <= R_VPC && R_VPC + (size_t)MCTX * DM * 4 <= 187 * MiB && (size_t)MT * 3 * DM * 2 <= R_QN, "R overlay");
constexpr size_t WS_CSA = WS_MOD + 512 * 1024, WS_CSC = WS_CSA + 64 * 32 * 8;
constexpr size_t WS_W4T = WS_MOD + 640 * 1024;
static_assert(WS_CSC + 64 * 16 * 8 <= WS_W4T && WS_W4T + 2048 * 64 * 2 <= WS_HCLAT, "mod page map");
constexpr size_t R_SLAB = 40 * MiB;
constexpr size_t R_SLAB2 = 100 * MiB;
constexpr int SK_OUT = 8, SK_DOWN = 11;
static_assert(R_SLAB >= (size_t)MLAT * DM * 2 && R_SLAB + (size_t)SK_OUT * MCTX * DM * 4 <= R_QN && R_SLAB2 >= (size_t)MT * DFF * 2 && R_SLAB2 + (size_t)SK_DOWN * MCTX * DM * 4 <= 187 * MiB, "slab map");
constexpr size_t R_XBUF = 100 * MiB;
constexpr int CW_SEAM = 16384;
constexpr int CW_BAR = 4096;

constexpr int LDS_BYTES = 147456;
constexpr int MISC_OFF = LDS_BYTES - 1024;
constexpr int INTAB_OFF = MISC_OFF + 256;

#define GAS __attribute__((address_space(1)))
#define LAS __attribute__((address_space(3)))
typedef unsigned short bf16;
typedef unsigned v4u __attribute__((ext_vector_type(4)));
typedef float f32x4 __attribute__((ext_vector_type(4)));
typedef short bf16x8 __attribute__((ext_vector_type(8)));
typedef GAS unsigned gu32;
typedef GAS unsigned long long gu64;
#define RLX_AGENT __ATOMIC_RELAXED, __HIP_MEMORY_SCOPE_AGENT
#define LDS_WAIT() asm volatile("s_waitcnt lgkmcnt(0)" ::: "memory")
#define VM_WAIT() asm volatile("s_waitcnt vmcnt(0)" ::: "memory")
__device__ __forceinline__ unsigned long long rt() { return __builtin_amdgcn_s_memrealtime(); }
__device__ __forceinline__ unsigned pk2(float lo, float hi) { unsigned r; asm("v_cvt_pk_bf16_f32 %0, %1, %2" : "=v"(r) : "v"(lo), "v"(hi)); return r; }
__device__ __forceinline__ unsigned f2bf(float f) { return pk2(f, 0.f) & 0xffffu; }

#define XB_TMO      128
#define XB_XCNT(j)  (256  + 64 * (j))
#define XB_XSUB(j)  (1280 + 64 * (j))
#define XB_XGEN(j)  (2304 + 64 * (j))
#define XB_TOP      3328
#define XB_TOPGEN   3392
#define XCD_BAR_WORDS 3456
#define XB_SPIN_CAP (1u << 18)

__device__ __forceinline__ unsigned xb_ld(unsigned* p)              { return __hip_atomic_load(p, __ATOMIC_RELAXED, __HIP_MEMORY_SCOPE_AGENT); }
__device__ __forceinline__ unsigned xb_add(unsigned* p, unsigned v) { return __hip_atomic_fetch_add(p, v, __ATOMIC_RELAXED, __HIP_MEMORY_SCOPE_AGENT); }
__device__ __forceinline__ unsigned xb_xcc_id() { return (unsigned)__builtin_amdgcn_s_getreg((3 << 11) | 20) & 0xFu; }
#define XB_SPIN(cond, bar) do { unsigned _sp = 0; while (cond) { __builtin_amdgcn_s_sleep(1); \
    if ((++_sp & 255u) == 0u) { if (xb_ld(&(bar)[XB_TMO])) break; if (_sp > XB_SPIN_CAP) { atomicAdd(&(bar)[XB_TMO], 1u); break; } } } } while (0)

struct XcdBarrier {
    unsigned* bar; unsigned x;
    volatile LAS unsigned* st;
};

__device__ __forceinline__ XcdBarrier xcd_barrier_post(unsigned* bar, volatile LAS unsigned* st, int tid) {
    XcdBarrier b; b.bar = bar; b.x = xb_xcc_id(); b.st = st;
    if (tid == 0) (void)xb_add(&bar[XB_XCNT(b.x)], 1u);
    return b;
}
__device__ __forceinline__ void xcd_barrier_complete(unsigned* bar, unsigned x, unsigned& nloc, unsigned& nx) {
    const unsigned G = gridDim.x * gridDim.y * gridDim.z;
    unsigned sum, cnt, mine, sp = 0u;
    for (;;) {
        sum = 0u; cnt = 0u; mine = 0u;
#pragma unroll
        for (unsigned j = 0; j < 16; ++j) { const unsigned c = xb_ld(&bar[XB_XCNT(j)]); sum += c; cnt += (c > 0u) ? 1u : 0u; mine = (j == x) ? c : mine; }
        if (sum == G) break;
        __builtin_amdgcn_s_sleep(1);
        if ((++sp & 255u) == 0u) { if (xb_ld(&bar[XB_TMO])) break; if (sp > XB_SPIN_CAP) { atomicAdd(&bar[XB_TMO], 1u); break; } }
    }
    nloc = mine > 0u ? mine : 1u; nx = cnt > 0u ? cnt : 1u;
}

__device__ __forceinline__ void xcd_barrier(const XcdBarrier& b, int tid) {
    asm volatile("s_waitcnt vmcnt(0)" ::: "memory");
    __syncthreads();
    if (tid == 0) {
        unsigned* bar = b.bar;
        __builtin_amdgcn_s_waitcnt(0);
        unsigned nloc = b.st[0], nx = b.st[1];
        if (nloc == 0u) { xcd_barrier_complete(bar, b.x, nloc, nx); b.st[0] = nloc; b.st[1] = nx; }
        const unsigned old = xb_add(&bar[XB_XSUB(b.x)], 1u);
        const unsigned gen = old / nloc;
        if (old + 1u == (gen + 1u) * nloc) {
            __builtin_amdgcn_fence(__ATOMIC_RELEASE, "agent");
            asm volatile("s_waitcnt vmcnt(0)" ::: "memory");
            const unsigned og = xb_add(&bar[XB_TOP], 1u);
            const unsigned tg = og / nx;
            if (og + 1u == (tg + 1u) * nx) xb_add(&bar[XB_TOPGEN], 1u);
            else XB_SPIN(xb_ld(&bar[XB_TOPGEN]) == tg, bar);
            __builtin_amdgcn_fence(__ATOMIC_ACQUIRE, "agent");
            asm volatile("s_waitcnt vmcnt(0)" ::: "memory");
        } else {
            XB_SPIN(xb_ld(&bar[XB_TOPGEN]) == gen, bar);
            __builtin_amdgcn_fence(__ATOMIC_ACQUIRE, "agent");
            asm volatile("s_waitcnt vmcnt(0)" ::: "memory");
        }
    }
    __syncthreads();
}
namespace aa {
typedef unsigned short bf16;
constexpr int D = 128, NW = 8, QBLK = 32, KVBLK = 64, SDEPTH = 1;
constexpr float SCALE = 0.088388347648318440f, THR = 8.f;
constexpr int LDQ = 1536, LDK = 256, LDV = 1536, LDO = 1024;
constexpr size_t SHM_V = KVBLK * D * 2, SHM_K = KVBLK * D * 2, SHM_ATTN = 3 * SHM_V + 2 * SHM_K + NW * 64 * 4;
using bf16x8 = __attribute__((ext_vector_type(8))) short;
using s16x4  = __attribute__((ext_vector_type(4))) short;
using f32x16 = __attribute__((ext_vector_type(16))) float;
using f32x8  = __attribute__((ext_vector_type(8))) float;
using u32x4  = __attribute__((ext_vector_type(4))) unsigned;
#define KSWZ(row, colB) ((row) * 256 + ((colB) ^ (((row) & 7) << 4)))
#define SBAR() __builtin_amdgcn_sched_barrier(0)
#define QK_PIPE() do { __builtin_amdgcn_sched_group_barrier(0x100, 2, 0);     \
    _Pragma("unroll") for (int s_ = 0; s_ < 8; ++s_) { if (s_ < 7) __builtin_amdgcn_sched_group_barrier(0x100, 2, 0); __builtin_amdgcn_sched_group_barrier(0x8, 2, 0); \
    __builtin_amdgcn_sched_group_barrier(0x400, 2, 0); __builtin_amdgcn_sched_group_barrier(0x2, 9, 0); } } while (0)
__device__ __forceinline__ int crow(int r, int hi) { return (r & 3) + 8 * (r >> 2) + 4 * hi; }
__device__ __forceinline__ unsigned cvtpk(float lo, float hi) {
  typedef __bf16 bf2_ __attribute__((ext_vector_type(2))); typedef float f2_ __attribute__((ext_vector_type(2)));
  const f2_ v = {lo, hi}; return __builtin_bit_cast(unsigned, __builtin_convertvector(v, bf2_));
}
struct St { using T = bf16x8; __device__ static __forceinline__ T ld8(const bf16* p) { return *reinterpret_cast<const bf16x8*>(p); } __device__ static __forceinline__ bf16x8 tobf(T x) { return x; } };
__device__ __forceinline__ void partialSM(f32x16& p0, f32x16& p1, float& m_reg, float& mn, float& alpha) {
  constexpr float C = SCALE * 1.4426950408889634f;
  float pmax = p0[0]; for (int r = 1; r < 16; ++r) pmax = fmaxf(pmax, p0[r]); for (int r = 0; r < 16; ++r) pmax = fmaxf(pmax, p1[r]);
  { auto rr = __builtin_amdgcn_permlane32_swap(__float_as_uint(pmax), __float_as_uint(pmax), false, false);
    pmax = fmaxf(__uint_as_float(rr[0]), __uint_as_float(rr[1])); }
  if (__builtin_expect(__all(pmax - m_reg <= THR / SCALE), 1)) { mn = m_reg; alpha = 1.f; }
  else { mn = fmaxf(m_reg, pmax); alpha = __builtin_amdgcn_exp2f((m_reg - mn) * C); m_reg = mn; }
  float mnC = -mn * C;
  for (int r = 0; r < 16; ++r) p0[r] = fmaf(p0[r], C, mnC); for (int r = 0; r < 16; ++r) p1[r] = fmaf(p1[r], C, mnC);
  for (int r = 0; r < 16; ++r) p0[r] = __builtin_amdgcn_exp2f(p0[r]);
}
__device__ __forceinline__ void finishSM(f32x16& p0, f32x16& p1, float alpha, float& l_reg, bf16x8& pa0, bf16x8& pa1, bf16x8& pa2, bf16x8& pa3) {
  for (int r = 0; r < 16; ++r) p1[r] = __builtin_amdgcn_exp2f(p1[r]);
  float ps = 0; for (int r = 0; r < 16; ++r) ps += p0[r]; for (int r = 0; r < 16; ++r) ps += p1[r];
  { auto rr = __builtin_amdgcn_permlane32_swap(__float_as_uint(ps), __float_as_uint(ps), false, false);
    ps = __uint_as_float(rr[0]) + __uint_as_float(rr[1]); }
  l_reg = l_reg * alpha + ps;
#define PK4(P, BASE, OUT) do { unsigned a0 = cvtpk(P[BASE + 0], P[BASE + 1]), a1 = cvtpk(P[BASE + 2], P[BASE + 3]);   \
    unsigned b0 = cvtpk(P[BASE + 4], P[BASE + 5]), b1 = cvtpk(P[BASE + 6], P[BASE + 7]);                              \
    auto r0 = __builtin_amdgcn_permlane32_swap(a0, b0, false, false); auto r1 = __builtin_amdgcn_permlane32_swap(a1, b1, false, false); \
    u32x4 w = {r0[0], r1[0], r0[1], r1[1]}; OUT = *reinterpret_cast<bf16x8*>(&w); } while (0)
  PK4(p0, 0, pa0); PK4(p0, 8, pa1); PK4(p1, 0, pa2); PK4(p1, 8, pa3);
#undef PK4
}
__device__ __forceinline__ void qkt(f32x16& p0, f32x16& p1, const bf16* Ks, const bf16x8* qr, int r32, int hi) {
  p0 = f32x16{}; p1 = f32x16{};
  for (int d0 = 0; d0 < 8; ++d0) { int cb = (d0 * 16 + hi * 8) * 2;
    bf16x8 b0 = *reinterpret_cast<const bf16x8*>((const char*)Ks + KSWZ(r32, cb));
    bf16x8 b1 = *reinterpret_cast<const bf16x8*>((const char*)Ks + KSWZ(32 + r32, cb));
    p0 = __builtin_amdgcn_mfma_f32_32x32x16_bf16(b0, qr[d0], p0, 0, 0, 0);
    p1 = __builtin_amdgcn_mfma_f32_32x32x16_bf16(b1, qr[d0], p1, 0, 0, 0); }
}
__device__ __forceinline__ int v_st(int k, int c) { const int kk = (k & ~0xC) | ((k & 4) << 1) | ((k & 8) >> 1); return ((kk >> 3) * 4 + (c >> 5)) * 512 + ((kk & 7) * 32 + (c & 31)) * 2; }
__device__ __forceinline__ int v_rd_base(int lane) { return ((lane & 3) << 3) | (((lane >> 2) & 3) << 6) | (((lane >> 4) & 1) << 5) | (((lane >> 5) & 1) << 8); }
constexpr int v_rd_off(int d0, int ks, int half) { return d0 * 512 + ks * 4096 + half * 2048; }
template <int OFF> __device__ __forceinline__ s16x4 tr_read(int vb) {
  s16x4 r; asm volatile("ds_read_b64_tr_b16 %0, %1 offset:%2" : "=&v"(r) : "v"(vb), "i"(OFF) : "memory"); return r;
}
template <int D0> __device__ __forceinline__ void pv_one(f32x16& od, int vb, bf16x8 pa0, bf16x8 pa1, bf16x8 pa2, bf16x8 pa3) {
  const s16x4 l0 = tr_read<v_rd_off(D0, 0, 0)>(vb), h0 = tr_read<v_rd_off(D0, 0, 1)>(vb), l1 = tr_read<v_rd_off(D0, 1, 0)>(vb), h1 = tr_read<v_rd_off(D0, 1, 1)>(vb);
  const s16x4 l2 = tr_read<v_rd_off(D0, 2, 0)>(vb), h2 = tr_read<v_rd_off(D0, 2, 1)>(vb), l3 = tr_read<v_rd_off(D0, 3, 0)>(vb), h3 = tr_read<v_rd_off(D0, 3, 1)>(vb);
  asm volatile("s_waitcnt lgkmcnt(0)" ::: "memory"); SBAR();
#define PK(L, H) (bf16x8){L[0], L[1], L[2], L[3], H[0], H[1], H[2], H[3]}
  od = __builtin_amdgcn_mfma_f32_32x32x16_bf16(pa0, PK(l0, h0), od, 0, 0, 0);
  od = __builtin_amdgcn_mfma_f32_32x32x16_bf16(pa1, PK(l1, h1), od, 0, 0, 0);
  od = __builtin_amdgcn_mfma_f32_32x32x16_bf16(pa2, PK(l2, h2), od, 0, 0, 0);
  od = __builtin_amdgcn_mfma_f32_32x32x16_bf16(pa3, PK(l3, h3), od, 0, 0, 0);
#undef PK
}
__device__ __forceinline__ void pv_d0(f32x16* o, int vb, bf16x8 pa0, bf16x8 pa1, bf16x8 pa2, bf16x8 pa3) {
  pv_one<0>(o[0], vb, pa0, pa1, pa2, pa3); pv_one<1>(o[1], vb, pa0, pa1, pa2, pa3); pv_one<2>(o[2], vb, pa0, pa1, pa2, pa3); pv_one<3>(o[3], vb, pa0, pa1, pa2, pa3);
}

__device__ __forceinline__ void pv_psm(f32x16* o, int vb, bf16x8 pa0, bf16x8 pa1, bf16x8 pa2, bf16x8 pa3, f32x16& p0, f32x16& p1, float& m_reg, float& mn, float& alpha) {
  constexpr float C = SCALE * 1.4426950408889634f;
  pv_one<0>(o[0], vb, pa0, pa1, pa2, pa3);
  float pmax = p0[0];
#pragma unroll
  for (int r = 1; r < 16; ++r) pmax = fmaxf(pmax, p0[r]);
#pragma unroll
  for (int r = 0; r < 16; ++r) pmax = fmaxf(pmax, p1[r]);
  pv_one<1>(o[1], vb, pa0, pa1, pa2, pa3);
  { auto rr = __builtin_amdgcn_permlane32_swap(__float_as_uint(pmax), __float_as_uint(pmax), false, false);
    pmax = fmaxf(__uint_as_float(rr[0]), __uint_as_float(rr[1])); }
  const bool keep = __all(pmax - m_reg <= THR / SCALE);
  mn = keep ? m_reg : fmaxf(m_reg, pmax); alpha = __builtin_amdgcn_exp2f((m_reg - mn) * C); m_reg = mn;
  const float mnC = -mn * C;
#pragma unroll
  for (int r = 0; r < 16; ++r) p0[r] = fmaf(p0[r], C, mnC);
  pv_one<2>(o[2], vb, pa0, pa1, pa2, pa3);
#pragma unroll
  for (int r = 0; r < 16; ++r) p1[r] = fmaf(p1[r], C, mnC);
#pragma unroll
  for (int r = 0; r < 8; ++r) p0[r] = __builtin_amdgcn_exp2f(p0[r]);
  pv_one<3>(o[3], vb, pa0, pa1, pa2, pa3);
#pragma unroll
  for (int r = 8; r < 16; ++r) p0[r] = __builtin_amdgcn_exp2f(p0[r]);
}

template <int OFF> __device__ __forceinline__ s16x4 tr_rd(int vb) { return __builtin_amdgcn_ds_read_tr16_b64_v4i16((__attribute__((address_space(3))) s16x4*)(unsigned)(vb + OFF)); }
#define PV_RD(I, D0, KS) const s16x4 l##I = tr_read<v_rd_off(D0, KS, 0)>(vb), h##I = tr_read<v_rd_off(D0, KS, 1)>(vb)
#define PV_WT(N) do { asm volatile("s_waitcnt lgkmcnt(" #N ")" ::: "memory"); SBAR(); } while (0)
#define PV_MM(I, D0, PA) o[D0] = __builtin_amdgcn_mfma_f32_32x32x16_bf16(PA, (bf16x8){l##I[0], l##I[1], l##I[2], l##I[3], h##I[0], h##I[1], h##I[2], h##I[3]}, o[D0], 0, 0, 0)
__device__ __forceinline__ void pv_psm2(f32x16* o, int vb, bf16x8 pa0, bf16x8 pa1, bf16x8 pa2, bf16x8 pa3, f32x16& p0, f32x16& p1, float& m_reg, float& mn, float& alpha) {
  constexpr float C = SCALE * 1.4426950408889634f;
  float pmax = p0[0];
#define MX4(P, B) do { pmax = fmaxf(fmaxf(pmax, P[B]), P[B + 1]); pmax = fmaxf(fmaxf(pmax, P[B + 2]), P[B + 3]); } while (0)
#define FM4(P, B) do { float t0_ = fmaf(P[B], C, mnC), t1_ = fmaf(P[B + 1], C, mnC), t2_ = fmaf(P[B + 2], C, mnC), t3_ = fmaf(P[B + 3], C, mnC); \
    asm volatile("" : "+v"(t0_), "+v"(t1_), "+v"(t2_), "+v"(t3_)); P[B] = t0_; P[B + 1] = t1_; P[B + 2] = t2_; P[B + 3] = t3_; } while (0)
  PV_RD(0, 0, 0); PV_RD(1, 1, 0); PV_RD(2, 2, 0);
  PV_RD(3, 3, 0);  PV_WT(6); PV_MM(0, 0, pa0);  MX4(p0, 0);
  PV_RD(4, 0, 1);  PV_WT(6); PV_MM(1, 1, pa0);  MX4(p0, 4);
  PV_RD(5, 1, 1);  PV_WT(6); PV_MM(2, 2, pa0);  MX4(p0, 8);
  PV_RD(6, 2, 1);  PV_WT(6); PV_MM(3, 3, pa0);  MX4(p0, 12);
  PV_RD(7, 3, 1);  PV_WT(6); PV_MM(4, 0, pa1);  MX4(p1, 0);
  PV_RD(8, 0, 2);  PV_WT(6); PV_MM(5, 1, pa1);  MX4(p1, 4);
  PV_RD(9, 1, 2);  PV_WT(6); PV_MM(6, 2, pa1);  MX4(p1, 8);
  PV_RD(10, 2, 2); PV_WT(6); PV_MM(7, 3, pa1);  MX4(p1, 12);
  { auto rr = __builtin_amdgcn_permlane32_swap(__float_as_uint(pmax), __float_as_uint(pmax), false, false);
    pmax = fmaxf(__uint_as_float(rr[0]), __uint_as_float(rr[1])); }
  const bool keep = __all(pmax - m_reg <= THR / SCALE);
  mn = keep ? m_reg : fmaxf(m_reg, pmax); alpha = __builtin_amdgcn_exp2f((m_reg - mn) * C); m_reg = mn;
  const float mnC = -mn * C;
  PV_RD(11, 3, 2); PV_WT(6); PV_MM(8, 0, pa2);  FM4(p0, 0);
  PV_RD(12, 0, 3); PV_WT(6); PV_MM(9, 1, pa2);  FM4(p0, 4);
  PV_RD(13, 1, 3); PV_WT(6); PV_MM(10, 2, pa2); FM4(p0, 8);
  PV_RD(14, 2, 3); PV_WT(6); PV_MM(11, 3, pa2); FM4(p0, 12);
  PV_RD(15, 3, 3); PV_WT(6); PV_MM(12, 0, pa3); FM4(p1, 0);
                   PV_WT(4); PV_MM(13, 1, pa3); FM4(p1, 4);
                   PV_WT(2); PV_MM(14, 2, pa3); FM4(p1, 8);
                   PV_WT(0); PV_MM(15, 3, pa3); FM4(p1, 12);
#undef MX4
#undef FM4
#pragma unroll
  for (int r = 0; r < 16; ++r) p0[r] = __builtin_amdgcn_exp2f(p0[r]);
}
#undef PV_RD
#undef PV_WT
#undef PV_MM

__device__ __forceinline__ void attn_dense_body(const bf16* __restrict__ Qb, const bf16* __restrict__ Kh, const bf16* __restrict__ Vb, int rc, int rl, bf16* __restrict__ Ob, int seq, char* lds, const int tid,
                                                const float* __restrict__ qgain, const float* __restrict__ cs, int t_first) {
  using SQ = St;
  const int wid = __builtin_amdgcn_readfirstlane(tid >> 6), lane = tid & 63, r32 = lane & 31, hi = lane >> 5;
  bf16* V_lds = (bf16*)lds; bf16* K_lds = (bf16*)(lds + 3 * SHM_V);
  float* ws = (float*)(lds + 3 * SHM_V + 2 * SHM_K) + wid * 64; float* li_l = ws; float* al_l = ws + 32;
  float m_reg = -1e30f, l_reg = 0; f32x16 o[4] = {}; bf16x8 qr[8];
  unsigned kofs[2], vofs[2];
#pragma unroll
  for (int i = 0; i < 2; ++i) { const int q = 2 * wid + i;
    { const int row = 4 * q + (lane >> 4), p = lane & 15, cch = p ^ (row & 7); kofs[i] = (unsigned)(row * LDK + cch * 8); }
    { const int S = 2 * q + (lane >> 5), e = lane & 31, kk = (S >> 2) * 8 + (e >> 2), k = (kk & ~0xC) | ((kk & 4) << 1) | ((kk & 8) >> 1), cc = (S & 3) * 32 + (e & 3) * 8;
      vofs[i] = (unsigned)(k * LDV + cc); } }
  typedef __attribute__((address_space(3))) char las_char; typedef __attribute__((address_space(3))) unsigned las_u32;
  las_char* ldsl = (las_char*)lds;
  const int vb0 = (int)(uintptr_t)V_lds + v_rd_base(lane);
#define DMA_K(t, kb) do { const bf16* g_ = Kh + (size_t)((t) * KVBLK) * LDK; \
    __builtin_amdgcn_global_load_lds((const unsigned*)(g_ + kofs[0]), (las_u32*)(ldsl + 3 * SHM_V + (kb) * SHM_K + (2 * wid) * 1024), 16, 0, 0); \
    __builtin_amdgcn_global_load_lds((const unsigned*)(g_ + kofs[1]), (las_u32*)(ldsl + 3 * SHM_V + (kb) * SHM_K + (2 * wid + 1) * 1024), 16, 0, 0); } while (0)
#define DMA_V(t, vs) do { const int k0_ = (t) * KVBLK; const bf16* g_ = Vb + (size_t)(k0_ < 256 ? rc + k0_ : rl + k0_ - 256) * LDV; \
    __builtin_amdgcn_global_load_lds((const unsigned*)(g_ + vofs[0]), (las_u32*)(ldsl + (vs) * SHM_V + (2 * wid) * 1024), 16, 0, 0); \
    __builtin_amdgcn_global_load_lds((const unsigned*)(g_ + vofs[1]), (las_u32*)(ldsl + (vs) * SHM_V + (2 * wid + 1) * 1024), 16, 0, 0); } while (0)
#define VSLOT(t) (vb0 + ((t) % 3) * (int)SHM_V)
#define RDV(t, kb) do { asm volatile("s_waitcnt vmcnt(0)" ::: "memory"); __syncthreads(); if ((t) + 2 < NT) DMA_K((t) + 2, kb); if ((t) + 1 < NT) DMA_V((t) + 1, ((t) + 1) % 3); } while (0)
  DMA_K(0, 0); DMA_V(0, 0); DMA_K(1, 1); DMA_V(1, 1);
  const bf16* Qw = Qb + (long)(wid * QBLK + r32) * LDQ + hi * 8;
#pragma unroll
  for (int d0 = 0; d0 < 8; ++d0) qr[d0] = SQ::tobf(SQ::ld8(Qw + d0 * 16));
  {
    float xf[8][8]; float ss = 0.f;
#pragma unroll
    for (int d0 = 0; d0 < 8; ++d0)
#pragma unroll
      for (int j = 0; j < 8; ++j) { xf[d0][j] = __uint_as_float(((unsigned)(unsigned short)qr[d0][j]) << 16); ss += xf[d0][j] * xf[d0][j]; }
    { auto rr = __builtin_amdgcn_permlane32_swap(__float_as_uint(ss), __float_as_uint(ss), false, false); ss = __uint_as_float(rr[0]) + __uint_as_float(rr[1]); }
    const float rs = __builtin_amdgcn_rsqf(ss * (1.0f / 128.0f) + 1e-6f);
#pragma unroll
    for (int d0 = 0; d0 < 8; ++d0) { const float4 g0 = *(const float4*)(qgain + d0 * 16 + hi * 8), g1 = *(const float4*)(qgain + d0 * 16 + hi * 8 + 4);
      xf[d0][0] *= rs * g0.x; xf[d0][1] *= rs * g0.y; xf[d0][2] *= rs * g0.z; xf[d0][3] *= rs * g0.w; xf[d0][4] *= rs * g1.x; xf[d0][5] *= rs * g1.y; xf[d0][6] *= rs * g1.z; xf[d0][7] *= rs * g1.w; }
    if (cs) { const int t = t_first + wid * QBLK + r32, prow = t >> 6, pcol = t & 63;
#pragma unroll
      for (int d0 = 0; d0 < 4; ++d0) { const float* c8 = cs + ((d0 < 2 ? prow : pcol) * 32 + ((d0 & 1) * 16 + hi * 8)) * 2;
#pragma unroll
        for (int j4 = 0; j4 < 4; ++j4) { const float4 v = *(const float4*)(c8 + 4 * j4);
          { const float y1 = xf[d0][2 * j4], y2 = xf[d0 + 4][2 * j4]; xf[d0][2 * j4] = y1 * v.x - y2 * v.y; xf[d0 + 4][2 * j4] = y1 * v.y + y2 * v.x; }
          { const float y1 = xf[d0][2 * j4 + 1], y2 = xf[d0 + 4][2 * j4 + 1]; xf[d0][2 * j4 + 1] = y1 * v.z - y2 * v.w; xf[d0 + 4][2 * j4 + 1] = y1 * v.w + y2 * v.z; } } } }
#pragma unroll
    for (int d0 = 0; d0 < 8; ++d0) { u32x4 w = {cvtpk(xf[d0][0], xf[d0][1]), cvtpk(xf[d0][2], xf[d0][3]), cvtpk(xf[d0][4], xf[d0][5]), cvtpk(xf[d0][6], xf[d0][7])}; qr[d0] = *reinterpret_cast<bf16x8*>(&w); }
  }
#define RESC(a) do { if (__any((a) < 1.f)) { if (hi == 0) al_l[r32] = (a); asm volatile("s_waitcnt lgkmcnt(0)" ::: "memory"); \
    for (int d = 0; d < 4; ++d) for (int r = 0; r < 16; ++r) o[d][r] *= al_l[crow(r, hi)]; } } while (0)
  f32x16 pA0, pA1, pB0, pB1; float mnA, mnB, alA, alB; bf16x8 pa0, pa1, pa2, pa3; const int NT = seq / KVBLK;
#ifndef ATTN_STAGGER
#define ATTN_STAGGER 0
#endif
  const bool grpB = ATTN_STAGGER && wid >= 4;
  asm volatile("s_waitcnt vmcnt(0)" ::: "memory"); __syncthreads();
  qkt(pA0, pA1, K_lds, qr, r32, hi); partialSM(pA0, pA1, m_reg, mnA, alA);
  asm volatile("s_waitcnt vmcnt(0)" ::: "memory"); __syncthreads(); DMA_K(2, 0);
  for (int j = 1; j + 1 < NT; j += 2) {
    SBAR(); qkt(pB0, pB1, (bf16*)((char*)K_lds + SHM_K), qr, r32, hi);
    finishSM(pA0, pA1, alA, l_reg, pa0, pa1, pa2, pa3); QK_PIPE(); SBAR();
    if (grpB) { RDV(j, 1); }
    SBAR(); pv_psm2(o, VSLOT(j - 1), pa0, pa1, pa2, pa3, pB0, pB1, m_reg, mnB, alB); SBAR();
    RESC(alB);
    if (!grpB) { RDV(j, 1); }
    SBAR(); qkt(pA0, pA1, K_lds, qr, r32, hi);
    finishSM(pB0, pB1, alB, l_reg, pa0, pa1, pa2, pa3); QK_PIPE(); SBAR();
    if (grpB) { RDV(j + 1, 0); }
    SBAR(); pv_psm2(o, VSLOT(j), pa0, pa1, pa2, pa3, pA0, pA1, m_reg, mnA, alA); SBAR();
    RESC(alA);
    if (!grpB) { RDV(j + 1, 0); }
  }
  SBAR(); qkt(pB0, pB1, (bf16*)((char*)K_lds + SHM_K), qr, r32, hi);
  finishSM(pA0, pA1, alA, l_reg, pa0, pa1, pa2, pa3); SBAR();
  if (grpB) { RDV(NT - 1, 1); }
  pv_psm(o, VSLOT(NT - 2), pa0, pa1, pa2, pa3, pB0, pB1, m_reg, mnB, alB);
  if (!grpB) { RDV(NT - 1, 1); }
  RESC(alB);
  finishSM(pB0, pB1, alB, l_reg, pa0, pa1, pa2, pa3); SBAR();
  pv_d0(o, VSLOT(NT - 1), pa0, pa1, pa2, pa3);
  if (hi == 0) li_l[r32] = l_reg; asm volatile("s_waitcnt lgkmcnt(0)" ::: "memory");
  float rli[16];
#pragma unroll
  for (int r = 0; r < 16; ++r) rli[r] = __builtin_amdgcn_rcpf(li_l[crow(r, hi)]);
  __syncthreads();
  int lane_e = lane; asm volatile("" : "+v"(lane_e));
  bf16* stg = (bf16*)lds + wid * (QBLK * D);
#pragma unroll
  for (int r = 0; r < 16; ++r) { const int orow = crow(r, hi);
#pragma unroll
    for (int d0 = 0; d0 < 4; ++d0) stg[orow * D + d0 * 32 + r32] = (bf16)(cvtpk(o[d0][r] * rli[r], 0.f) & 0xffffu); }
  asm volatile("s_waitcnt lgkmcnt(0)" ::: "memory");
  bf16* Ow = Ob + (long)(wid * QBLK) * LDO;
#pragma unroll
  for (int i = 0; i < 8; ++i) { const int row = i * 4 + (lane_e >> 4), ch = lane_e & 15; const u32x4 v = *(const u32x4*)(stg + row * D + ch * 8); *(u32x4*)(Ow + (long)row * LDO + ch * 8) = v; }
  __syncthreads();
#undef DMA_K
#undef DMA_V
#undef RDV
#undef RESC
#undef VSLOT
}
#undef KSWZ
#undef SBAR
}
namespace ac {
using aa::bf16; using aa::bf16x8; using aa::s16x4; using aa::f32x16; using aa::u32x4; using aa::crow; using aa::cvtpk; using aa::tr_read; using aa::v_rd_base;
constexpr int D = 64, KVBLK = 64, KVW = 128, LDQ = 1280;
constexpr float SCALE = 0.125f, THR = 8.f, NEG = -1e30f;
constexpr int SHM_K = KVBLK * D * 2, SHM_V = KVBLK * D * 2;
constexpr int LDS_K = 0, LDS_V = 2 * SHM_K, LDS_WS = 2 * SHM_K + 2 * SHM_V, LDS_OST = 0;
#define CSBAR() __builtin_amdgcn_sched_barrier(0)
__device__ __forceinline__ int kswz(int row, int chunk) { return row * 128 + ((chunk ^ ((row >> 1) & 7)) << 4); }
__device__ __forceinline__ int v_st64(int k, int c) { const int kk = (k & ~0xC) | ((k & 4) << 1) | ((k & 8) >> 1); return ((kk >> 3) * 2 + (c >> 5)) * 512 + ((kk & 7) * 32 + (c & 31)) * 2; }
constexpr int v_rd_off64(int d0, int ks, int half) { return d0 * 512 + ks * 2048 + half * 1024; }
__device__ __forceinline__ void partialSM(f32x16& p0, f32x16& p1, float& m_reg, float& alpha) {
  constexpr float C = SCALE * 1.4426950408889634f;
  float pmax = p0[0]; for (int r = 1; r < 16; ++r) pmax = fmaxf(pmax, p0[r]); for (int r = 0; r < 16; ++r) pmax = fmaxf(pmax, p1[r]);
  { auto rr = __builtin_amdgcn_permlane32_swap(__float_as_uint(pmax), __float_as_uint(pmax), false, false);
    pmax = fmaxf(__uint_as_float(rr[0]), __uint_as_float(rr[1])); }
  float mn;
  if (__builtin_expect(__all(pmax - m_reg <= THR / SCALE), 1)) { mn = m_reg; alpha = 1.f; }
  else { mn = fmaxf(m_reg, pmax); alpha = __builtin_amdgcn_exp2f((m_reg - mn) * C); m_reg = mn; }
  const float mnC = -mn * C;
  { typedef float f32x2_ __attribute__((ext_vector_type(2))); const f32x2_ C2 = {C, C}, M2 = {mnC, mnC};
#pragma unroll
    for (int r = 0; r < 16; r += 2) { const f32x2_ a = __builtin_elementwise_fma((f32x2_){p0[r], p0[r + 1]}, C2, M2), b = __builtin_elementwise_fma((f32x2_){p1[r], p1[r + 1]}, C2, M2);
      p0[r] = a[0]; p0[r + 1] = a[1]; p1[r] = b[0]; p1[r + 1] = b[1]; } }
  for (int r = 0; r < 16; ++r) p0[r] = __builtin_amdgcn_exp2f(p0[r]); for (int r = 0; r < 16; ++r) p1[r] = __builtin_amdgcn_exp2f(p1[r]);
}
__device__ __forceinline__ void finishSM(f32x16& p0, f32x16& p1, float alpha, float& l_reg, bf16x8& pa0, bf16x8& pa1, bf16x8& pa2, bf16x8& pa3) {
  typedef float f32x2_ __attribute__((ext_vector_type(2)));
  f32x2_ sa = {p0[0], p0[1]}, sb = {p1[0], p1[1]};
#pragma unroll
  for (int r = 2; r < 16; r += 2) { sa += (f32x2_){p0[r], p0[r + 1]}; sb += (f32x2_){p1[r], p1[r + 1]}; }
  sa += sb; float ps = sa[0] + sa[1];
  { auto rr = __builtin_amdgcn_permlane32_swap(__float_as_uint(ps), __float_as_uint(ps), false, false);
    ps = __uint_as_float(rr[0]) + __uint_as_float(rr[1]); }
  l_reg = l_reg * alpha + ps;
#define PK4(P, BASE, OUT) do { unsigned a0 = cvtpk(P[BASE + 0], P[BASE + 1]), a1 = cvtpk(P[BASE + 2], P[BASE + 3]);   \
    unsigned b0 = cvtpk(P[BASE + 4], P[BASE + 5]), b1 = cvtpk(P[BASE + 6], P[BASE + 7]);                              \
    auto r0 = __builtin_amdgcn_permlane32_swap(a0, b0, false, false); auto r1 = __builtin_amdgcn_permlane32_swap(a1, b1, false, false); \
    u32x4 w = {r0[0], r1[0], r0[1], r1[1]}; OUT = *reinterpret_cast<bf16x8*>(&w); } while (0)
  PK4(p0, 0, pa0); PK4(p0, 8, pa1); PK4(p1, 0, pa2); PK4(p1, 8, pa3);
#undef PK4
}
__device__ __forceinline__ void qkt(f32x16& p0, f32x16& p1, const char* Ks, const bf16x8* qr, int r32, int hi) {
  p0 = f32x16{}; p1 = f32x16{};
#pragma unroll
  for (int d0 = 0; d0 < 4; ++d0) { const int ch = d0 * 2 + hi;
    const bf16x8 b0 = *reinterpret_cast<const bf16x8*>(Ks + kswz(r32, ch));
    const bf16x8 b1 = *reinterpret_cast<const bf16x8*>(Ks + kswz(32 + r32, ch));
    p0 = __builtin_amdgcn_mfma_f32_32x32x16_bf16(b0, qr[d0], p0, 0, 0, 0);
    p1 = __builtin_amdgcn_mfma_f32_32x32x16_bf16(b1, qr[d0], p1, 0, 0, 0); }
}
template <int D0> __device__ __forceinline__ void pv_one(f32x16& od, int vb, bf16x8 pa0, bf16x8 pa1, bf16x8 pa2, bf16x8 pa3) {
  const s16x4 l0 = tr_read<v_rd_off64(D0, 0, 0)>(vb), h0 = tr_read<v_rd_off64(D0, 0, 1)>(vb), l1 = tr_read<v_rd_off64(D0, 1, 0)>(vb), h1 = tr_read<v_rd_off64(D0, 1, 1)>(vb);
  const s16x4 l2 = tr_read<v_rd_off64(D0, 2, 0)>(vb), h2 = tr_read<v_rd_off64(D0, 2, 1)>(vb), l3 = tr_read<v_rd_off64(D0, 3, 0)>(vb), h3 = tr_read<v_rd_off64(D0, 3, 1)>(vb);
  asm volatile("s_waitcnt lgkmcnt(0)" ::: "memory"); CSBAR();
#define PK(L, H) (bf16x8){L[0], L[1], L[2], L[3], H[0], H[1], H[2], H[3]}
  od = __builtin_amdgcn_mfma_f32_32x32x16_bf16(pa0, PK(l0, h0), od, 0, 0, 0);
  od = __builtin_amdgcn_mfma_f32_32x32x16_bf16(pa1, PK(l1, h1), od, 0, 0, 0);
  od = __builtin_amdgcn_mfma_f32_32x32x16_bf16(pa2, PK(l2, h2), od, 0, 0, 0);
  od = __builtin_amdgcn_mfma_f32_32x32x16_bf16(pa3, PK(l3, h3), od, 0, 0, 0);
#undef PK
}
__device__ __forceinline__ void unit(const bf16* __restrict__ Qh, const bf16* __restrict__ Kb, const bf16* __restrict__ Vb, int rc, int rl, bf16* __restrict__ Oh, int t0, float sink_l2, char* lds, const int tid, const float* __restrict__ cs) {
  const int wid = __builtin_amdgcn_readfirstlane(tid >> 6), lane = tid & 63, r32 = lane & 31, hi = lane >> 5;
  char* K_lds = lds + LDS_K; char* V_lds = lds + LDS_V;
  float* wsf = (float*)(lds + LDS_WS) + wid * 64; float* li_l = wsf; float* al_l = wsf + 32;
  float m_reg = -1e30f, l_reg = 0.f; f32x16 o[2] = {}; bf16x8 qr[4];
#pragma unroll
  for (int d0 = 0; d0 < 4; ++d0) qr[d0] = *reinterpret_cast<const bf16x8*>(Qh + (long)r32 * LDQ + d0 * 16 + hi * 8);
  if (t0 >= 0) {
    const int t = t0 + r32, prow = t >> 6, pcol = t & 63;
#pragma unroll
    for (int d0 = 0; d0 < 2; ++d0) { const float* c8 = cs + ((d0 == 0 ? prow : pcol) * 16 + hi * 8) * 2;
      float a[8], b[8];
#pragma unroll
      for (int j = 0; j < 8; ++j) { a[j] = __uint_as_float(((unsigned)(unsigned short)qr[d0][j]) << 16); b[j] = __uint_as_float(((unsigned)(unsigned short)qr[d0 + 2][j]) << 16); }
#pragma unroll
      for (int j4 = 0; j4 < 4; ++j4) { const float4 v = *(const float4*)(c8 + 4 * j4);
        { const float y1 = a[2 * j4], y2 = b[2 * j4]; a[2 * j4] = y1 * v.x - y2 * v.y; b[2 * j4] = y1 * v.y + y2 * v.x; }
        { const float y1 = a[2 * j4 + 1], y2 = b[2 * j4 + 1]; a[2 * j4 + 1] = y1 * v.z - y2 * v.w; b[2 * j4 + 1] = y1 * v.w + y2 * v.z; } }
      u32x4 wa = {cvtpk(a[0], a[1]), cvtpk(a[2], a[3]), cvtpk(a[4], a[5]), cvtpk(a[6], a[7])}, wb = {cvtpk(b[0], b[1]), cvtpk(b[2], b[3]), cvtpk(b[4], b[5]), cvtpk(b[6], b[7])};
      qr[d0] = *reinterpret_cast<bf16x8*>(&wa); qr[d0 + 2] = *reinterpret_cast<bf16x8*>(&wb); }
  }
  const int skey = tid >> 3, sch = tid & 7;
  const int kst = kswz(skey, sch), vst = v_st64(skey, sch * 8);
  const int vb0 = (int)(uintptr_t)V_lds + v_rd_base(lane);
  const int lo = t0 - WINDOW < 0 ? 0 : t0 - WINDOW, hiq = t0 + 31 + WINDOW > SEQ - 1 ? SEQ - 1 : t0 + 31 + WINDOW;
  const int NT = t0 < 0 ? 4 : 9;
#define TILE_S0(j) (t0 - WINDOW + 64 * ((j) - 4))
#define TILE_OK(j) ((j) < 4 || (TILE_S0(j) + 63 >= lo && TILE_S0(j) <= hiq))
#define KVROW(j) ((j) < 4 ? 64 * (j) + skey : CTXL + min(max(TILE_S0(j) + skey, 0), SEQ - 1))
  bf16x8 sk, sv, sk2, sv2;
#define SLOAD(j) do { const long row_ = KVROW(j); sk = *reinterpret_cast<const bf16x8*>(Kb + row_ * KVW + sch * 8); sv = *reinterpret_cast<const bf16x8*>(Vb + (row_ < CTXL ? rc + row_ : rl + row_ - CTXL) * LDQ + sch * 8); } while (0)
#define SLOAD2(j) do { const long row_ = KVROW(j); sk2 = *reinterpret_cast<const bf16x8*>(Kb + row_ * KVW + sch * 8); sv2 = *reinterpret_cast<const bf16x8*>(Vb + (row_ < CTXL ? rc + row_ : rl + row_ - CTXL) * LDQ + sch * 8); } while (0)
#define SWRITE(b) do { *(bf16x8*)(K_lds + (b) * SHM_K + kst) = sk; *(bf16x8*)(V_lds + (b) * SHM_V + vst) = sv; } while (0)
  SLOAD(0); SWRITE(0); __syncthreads();
  { int j1 = 1; while (j1 < NT && !TILE_OK(j1)) ++j1; if (j1 < NT) SLOAD(j1); }
  int buf = 0;
  for (int j = 0; j < NT; ++j) {
    if (!TILE_OK(j)) continue;
    int jn = j + 1; while (jn < NT && !TILE_OK(jn)) ++jn;
    int j2 = jn + 1; while (j2 < NT && !TILE_OK(j2)) ++j2;
    if (j2 < NT) SLOAD2(j2);
    f32x16 p0, p1; float alpha; bf16x8 pa0, pa1, pa2, pa3;
    qkt(p0, p1, K_lds + buf * SHM_K, qr, r32, hi);
    if (j >= 4 && (TILE_S0(j) < 0 || TILE_S0(j) + 63 >= SEQ || TILE_S0(j) < t0 + 31 - WINDOW || TILE_S0(j) + 63 > t0 + WINDOW)) {
      const int s0 = TILE_S0(j), t = t0 + r32;
#pragma unroll
      for (int r = 0; r < 16; ++r) { const int sA = s0 + crow(r, hi), sB = sA + 32;
        if (sA < 0 || sA >= SEQ || sA - t > WINDOW || t - sA > WINDOW) p0[r] = NEG;
        if (sB < 0 || sB >= SEQ || sB - t > WINDOW || t - sB > WINDOW) p1[r] = NEG; }
    }
    partialSM(p0, p1, m_reg, alpha);
    if (__any(alpha < 1.f)) { if (hi == 0) al_l[r32] = alpha; asm volatile("s_waitcnt lgkmcnt(0)" ::: "memory");
#pragma unroll
      for (int d = 0; d < 2; ++d)
#pragma unroll
        for (int r = 0; r < 16; ++r) o[d][r] *= al_l[crow(r, hi)]; }
    finishSM(p0, p1, alpha, l_reg, pa0, pa1, pa2, pa3); CSBAR();
    pv_one<0>(o[0], vb0 + buf * SHM_V, pa0, pa1, pa2, pa3); pv_one<1>(o[1], vb0 + buf * SHM_V, pa0, pa1, pa2, pa3);
    if (jn < NT) { SWRITE(buf ^ 1); }
    __syncthreads();
    sk = sk2; sv = sv2;
    buf ^= 1;
  }
  l_reg += __builtin_amdgcn_exp2f(sink_l2 - m_reg * (SCALE * 1.4426950408889634f));
  if (hi == 0) li_l[r32] = l_reg; asm volatile("s_waitcnt lgkmcnt(0)" ::: "memory");
  float rli[16];
#pragma unroll
  for (int r = 0; r < 16; ++r) rli[r] = __builtin_amdgcn_rcpf(li_l[crow(r, hi)]);
  bf16* stg = (bf16*)(lds + LDS_OST) + wid * (32 * D);
#pragma unroll
  for (int r = 0; r < 16; ++r) { const int orow = crow(r, hi);
#pragma unroll
    for (int d0 = 0; d0 < 2; ++d0) stg[orow * D + d0 * 32 + r32] = (bf16)(cvtpk(o[d0][r] * rli[r], 0.f) & 0xffffu); }
  asm volatile("s_waitcnt lgkmcnt(0)" ::: "memory");
#pragma unroll
  for (int i = 0; i < 4; ++i) { const int row = i * 8 + (lane >> 3), ch = lane & 7; const u32x4 v = *(const u32x4*)(stg + row * D + ch * 8); *(u32x4*)(Oh + (long)row * 1024 + ch * 8) = v; }
  __syncthreads();
#undef TILE_S0
#undef TILE_OK
#undef KVROW
#undef SLOAD
#undef SLOAD2
#undef SWRITE
}
#undef CSBAR
}

struct Args { const float* in[N_IN]; float* out; unsigned char* ws; int ph_lo, ph_hi, single, pad; };
struct Frame {
    LAS unsigned char* lds;
    unsigned char* ldsg;
    volatile LAS unsigned* MISC;
    gu32* ctl;
    int tid, lane, wave, vcu, G, bx;
    LAS unsigned long long* intab;
    float* out; unsigned char* ws;
    __device__ __forceinline__ const float* inp(int i) const { const unsigned long long v = intab[i];
        const unsigned lo = __builtin_amdgcn_readfirstlane((unsigned)v), hi = __builtin_amdgcn_readfirstlane((unsigned)(v >> 32));
        return (const float*)(GAS const float*)(((unsigned long long)hi << 32) | lo); }
};
__device__ __forceinline__ float bf2f(unsigned h) { return __uint_as_float(h << 16); }
#define SWZ_XOR(v, o) __int_as_float(__builtin_amdgcn_ds_swizzle(__float_as_int(v), ((o) << 10) | 0x1f))
#define DPP_F(v, ctrl) __int_as_float(__builtin_amdgcn_mov_dpp(__float_as_int(v), (ctrl), 0xf, 0xf, false))
__device__ __forceinline__ float wave_sum(float v) {
    v += DPP_F(v, 0xB1); v += DPP_F(v, 0x4E); v += DPP_F(v, 0x124); v += DPP_F(v, 0x128); v += SWZ_XOR(v, 16);
    const auto rr = __builtin_amdgcn_permlane32_swap(__float_as_uint(v), __float_as_uint(v), false, false);
    return __uint_as_float(rr[0]) + __uint_as_float(rr[1]);
}
__device__ __forceinline__ float wave_max(float v) {
    v = fmaxf(v, SWZ_XOR(v, 1)); v = fmaxf(v, SWZ_XOR(v, 2)); v = fmaxf(v, SWZ_XOR(v, 4)); v = fmaxf(v, SWZ_XOR(v, 8)); v = fmaxf(v, SWZ_XOR(v, 16));
    const auto rr = __builtin_amdgcn_permlane32_swap(__float_as_uint(v), __float_as_uint(v), false, false);
    return fmaxf(__uint_as_float(rr[0]), __uint_as_float(rr[1]));
}
typedef float f32x2 __attribute__((ext_vector_type(2)));
__device__ __forceinline__ float lane_bcast(float v, int k) { return __int_as_float(__builtin_amdgcn_readlane(__float_as_int(v), k)); }
__device__ __forceinline__ float silu_f(float x) { return x / (1.0f + expf(-x)); }
__device__ __forceinline__ float* hrow_ctx(const Frame& F, int r) { return (float*)(F.ws + WS_HCTX) + (size_t)(r - MLAT) * DM; }
__device__ __forceinline__ bf16* hrow_lat(const Frame& F, int r) { return (bf16*)(F.ws + WS_HB) + (size_t)r * DM; }
__device__ __forceinline__ const float* modvec(const Frame& F, int layer, int r) { const int idx = r < MLAT ? layer * 4 + r / SEQ : 16 + layer; return (const float*)(F.ws + WS_MOD) + (size_t)idx * (NMOD * DM); }

__device__ __forceinline__ void p0_transpose_item(const float* W, int K, int N, bf16* WT, LAS float* scr, int item, int lane, bool gate_up, bool kperm = false) {
    const int nblk = N / 64, kb = item / nblk, nb = item % nblk, k0 = 64 * kb, n0 = 64 * nb;
    const int n0d = gate_up ? (n0 < DFF ? (n0 / 128) * 256 + (n0 % 128) : ((n0 - DFF) / 128) * 256 + 128 + ((n0 - DFF) % 128)) : n0;
    const float* src = W + (size_t)k0 * N + n0 + lane;
    float ld_[64];
#pragma unroll
    for (int i = 0; i < 64; ++i) ld_[i] = __builtin_nontemporal_load(src + (size_t)i * N);
#pragma unroll
    for (int i = 0; i < 64; ++i) scr[i * 65 + lane] = ld_[i];
    LDS_WAIT(); asm volatile("" ::: "memory");
    const int c = lane & 7;
#pragma unroll
    for (int j = 0; j < 8; ++j) { const int n = (lane >> 3) + 8 * j; const LAS float* s = scr + (8 * c) * 65 + n;
        v4u o; o.x = pk2(s[0 * 65], s[1 * 65]); o.y = pk2(s[2 * 65], s[3 * 65]); o.z = pk2(s[4 * 65], s[5 * 65]); o.w = pk2(s[6 * 65], s[7 * 65]);
        const int np = (kperm && n0 >= 1024 && n0 < 1152) ? 2 * (n & 31) + (n >> 5) : n;
        *(GAS v4u*)(WT + (size_t)(n0d + np) * K + k0 + 8 * c) = o; }
    LDS_WAIT(); asm volatile("" ::: "memory");
}
__device__ __forceinline__ void p0_filters(Frame& F, int slot, int nslots) {
    LAS float* WB = (LAS float*)F.lds;
    const float* w1 = F.inp(I_FW1); const float* w2 = F.inp(I_FW2); const float* w3 = F.inp(I_FW3); const float* w4 = F.inp(I_FW4);
    const float bb1 = F.inp(I_FB1)[F.lane], bb2 = F.inp(I_FB2)[F.lane], bb3 = F.inp(I_FB3)[F.lane];
    const float r0 = -15.350567286626973f, r1 = -3.0701134573253945f;
    for (int it = slot; it < (SEQ + CTXL) / 32; it += nslots) {
        const int pos0 = it * 32 + F.wave * 4; const bool lat = pos0 < SEQ; const int L = lat ? SEQ : CTXL, t0 = lat ? pos0 : pos0 - SEQ;
        float* Hc = (float*)(F.ws + WS_HCCTX);
        f32x4 stg[8];
#define W4_LOAD(c_) do { _Pragma("unroll") for (int e_ = 0; e_ < 8; ++e_) { const int q_ = F.tid + e_ * NTHREADS, k_ = q_ >> 6, c4_ = q_ & 63; stg[e_] = *((const f32x4*)(w4 + (size_t)k_ * (2 * DM) + (c_) * 256) + c4_); } } while (0)
#define W4_STORE(buf_) do { _Pragma("unroll") for (int e_ = 0; e_ < 8; ++e_) *((LAS f32x4*)(WB + (buf_) * 16384) + F.tid + e_ * NTHREADS) = stg[e_]; } while (0)
        float f[4], tn[4], zv[4];
#pragma unroll
        for (int q = 0; q < 4; ++q) {
            const int t = t0 + q;
            tn[q] = (float)t / (float)(L - 1);
            const float omega = (6.283185307179586f / (float)L) * (float)t;
            zv[q] = 0.f;
            { const int k = F.lane;
              if (k == 0) zv[q] = tn[q];
              else if (k <= 32) { const int kb = (k - 1) & 15; const float band = 1e-4f + (float)kb * ((15.0f - 1e-4f) / 15.0f); const float ang = omega * band; zv[q] = (k <= 16) ? cosf(ang) : -sinf(ang); } }
        }
        {
            float wr_[16], a_[4];
#define MLP_PART(W_, k0_, n_, in_) do { GAS const float* wb_ = (GAS const float*)((W_) + (k0_) * 64); asm volatile("" : "+s"(wb_)); \
                _Pragma("unroll") for (int k = 0; k < (n_); ++k) wr_[k] = wb_[k * 64 + F.lane]; \
                _Pragma("unroll") for (int q = 0; q < 4; ++q) { _Pragma("unroll") for (int k = 0; k < (n_); ++k) a_[q] += lane_bcast((in_)[q], (k0_) + k) * wr_[k]; } } while (0)
#pragma unroll
            for (int q = 0; q < 4; ++q) a_[q] = bb1;
            MLP_PART(w1, 0, 16, zv); MLP_PART(w1, 16, 16, zv); MLP_PART(w1, 32, 1, zv);
#pragma unroll
            for (int q = 0; q < 4; ++q) { f[q] = sinf(a_[q]); a_[q] = bb2; }
            MLP_PART(w2, 0, 16, f); MLP_PART(w2, 16, 16, f); MLP_PART(w2, 32, 16, f); MLP_PART(w2, 48, 16, f);
#pragma unroll
            for (int q = 0; q < 4; ++q) { zv[q] = sinf(a_[q]); a_[q] = bb3; }
            MLP_PART(w3, 0, 16, zv); MLP_PART(w3, 16, 16, zv); MLP_PART(w3, 32, 16, zv); MLP_PART(w3, 48, 16, zv);
#pragma unroll
            for (int q = 0; q < 4; ++q) f[q] = sinf(a_[q]);
#undef MLP_PART
        }
        W4_LOAD(0);
        W4_STORE(0);
        __syncthreads();
        for (int c = 0; c < 8; ++c) {
            if (c + 1 < 8) W4_LOAD(c + 1);
            const LAS float* wb = WB + (c & 1) * 16384 + 4 * F.lane;
            f32x2 acc[4][2];
#pragma unroll
            for (int q = 0; q < 4; ++q) { acc[q][0] = (f32x2){0.f, 0.f}; acc[q][1] = (f32x2){0.f, 0.f}; }
#pragma unroll 4
            for (int k = 0; k < 64; ++k) { const f32x4 w = *(const LAS f32x4*)(wb + k * 256); const f32x2 wlo = {w[0], w[1]}, whi = {w[2], w[3]};
#pragma unroll
                for (int q = 0; q < 4; ++q) { const float fk = lane_bcast(f[q], k); const f32x2 f2 = {fk, fk}; acc[q][0] = __builtin_elementwise_fma(wlo, f2, acc[q][0]); acc[q][1] = __builtin_elementwise_fma(whi, f2, acc[q][1]); } }
            f32x4 val[4];
#pragma unroll
            for (int j = 0; j < 4; ++j) { const int d = (c * 256 + 4 * F.lane + j) & (DM - 1);
                const float rate = fabsf(r0 + (float)d * ((r1 - r0) / (float)(DM - 1)));
#pragma unroll
                for (int q = 0; q < 4; ++q) val[j][q] = acc[q][j >> 1][j & 1] * expf(-tn[q] * rate); }
            const bool fwd = c < 4;
            const int d0 = (c * 256 + 4 * F.lane) & (DM - 1);
            if (lat) {
#pragma unroll
                for (int j = 0; j < 4; ++j) { float* dst = (float*)(F.ws + WS_HCLAT) + (fwd ? (size_t)0 : (size_t)DM * SEQ) + (size_t)(d0 + j) * SEQ + t0; *(f32x4*)dst = val[j]; }
            } else {
#pragma unroll
                for (int q = 0; q < 4; ++q) { const int t = t0 + q; const f32x4 o = {val[0][q], val[1][q], val[2][q], val[3][q]};
                    if (fwd) *(f32x4*)(Hc + (size_t)(t + L - 1) * DM + d0) = o;
                    else if (t >= 1) *(f32x4*)(Hc + (size_t)(L - 1 - t) * DM + d0) = o; } }
            if (c + 1 < 8) W4_STORE((c + 1) & 1);
            __syncthreads();
        }
#undef W4_LOAD
#undef W4_STORE
    }
}

__device__ __forceinline__ void transpose_group(Frame& F, unsigned mask, int slot0, int nmine, int nslots) {
    LAS float* scr = (LAS float*)(F.lds + F.wave * (64 * 65 * 4));
    for (int s = 0; s < nmine; ++s)
    for (int gi = (slot0 + s) * NWAVES + F.wave;; gi += nslots * NWAVES) {
        int base = 0, mat = 0, items = 0; const float* src = nullptr; bf16* dst = nullptr; int K = DM, N = DM; bool found = false;
        for (; mat < 17; ++mat) {
            if (!((mask >> mat) & 1u)) continue;
            if (mat < 2)       { src = F.inp(I_AQKV) + (size_t)mat * DM * A_COLS; dst = (bf16*)(F.ws + WS_W_AQKV) + (size_t)mat * A_COLS * DM; K = DM; N = A_COLS; }
            else if (mat < 4)  { src = F.inp(I_AOUT) + (size_t)(mat - 2) * DM * DM; dst = (bf16*)(F.ws + WS_W_AOUT) + (size_t)(mat - 2) * DM * DM; K = DM; N = DM; }
            else if (mat == 4) { src = F.inp(I_BIN); dst = (bf16*)(F.ws + WS_W_BIN); K = DM; N = 3 * DM; }
            else if (mat == 5) { src = F.inp(I_BOUT); dst = (bf16*)(F.ws + WS_W_BOUT); K = DM; N = DM; }
            else if (mat == 6) { src = F.inp(I_CQKV); dst = (bf16*)(F.ws + WS_W_CQKV); K = DM; N = C_COLS; }
            else if (mat == 7) { src = F.inp(I_COUT); dst = (bf16*)(F.ws + WS_W_COUT); K = DM; N = DM; }
            else if (mat < 12) { src = F.inp(I_WUP) + (size_t)(mat - 8) * DM * 2 * DFF; dst = (bf16*)(F.ws + WS_W_UP) + (size_t)(mat - 8) * 2 * DFF * DM; K = DM; N = 2 * DFF; }
            else if (mat < 16) { src = F.inp(I_WDOWN) + (size_t)(mat - 12) * DFF * DM; dst = (bf16*)(F.ws + WS_W_DOWN) + (size_t)(mat - 12) * DM * DFF; K = DFF; N = DM; }
            else               { src = F.inp(I_FW4); dst = (bf16*)(F.ws + WS_W4T); K = 64; N = 2 * DM; }
            items = (K / 64) * (N / 64);
            if (gi < base + items) { found = true; break; }
            base += items;
        }
        if (!found) break;
        p0_transpose_item(src, K, N, dst, scr, gi - base, F.lane, mat >= 8 && mat < 12, mat == 6);
    }
}
constexpr unsigned TG_P0 = (1u << 0) | (1u << 4) | (1u << 16);
constexpr unsigned TG_L0 = (1u << 2) | (1u << 8) | (1u << 12);
constexpr unsigned TG_L1 = (1u << 5) | (1u << 9) | (1u << 13) | (1u << 6);
constexpr unsigned TG_L2 = (1u << 7) | (1u << 10) | (1u << 14) | (1u << 1);
constexpr unsigned TG_L3 = (1u << 3) | (1u << 11) | (1u << 15);
static_assert((TG_P0 | TG_L0 | TG_L1 | TG_L2 | TG_L3) == 0x1ffffu && (TG_P0 ^ TG_L0 ^ TG_L1 ^ TG_L2 ^ TG_L3) == 0x1ffffu, "every matrix exactly once");
__device__ __forceinline__ void filters_mfma(Frame& F, int slot, int nslots) {
    LAS unsigned short* FA = (LAS unsigned short*)F.lds;
    const float* w1 = F.inp(I_FW1); const float* w2 = F.inp(I_FW2); const float* w3 = F.inp(I_FW3);
    const bf16* W4T = (const bf16*)(F.ws + WS_W4T);
    const float bb1 = F.inp(I_FB1)[F.lane], bb2 = F.inp(I_FB2)[F.lane], bb3 = F.inp(I_FB3)[F.lane];
    const float r0 = -15.350567286626973f, r1 = -3.0701134573253945f;
    const int l15 = F.lane & 15, lg = F.lane >> 4;
    for (int it = slot; it < (SEQ + CTXL) / 32; it += nslots) {
        const int posb = it * 32; const bool lat = posb < SEQ; const int L = lat ? SEQ : CTXL, tb = lat ? posb : posb - SEQ, t0 = tb + F.wave * 4;
        float* Hc = (float*)(F.ws + WS_HCCTX);
        const float inv_lm1 = 1.0f / (float)(L - 1);
        float f[4], zv[4];
#pragma unroll
        for (int q = 0; q < 4; ++q) {
            const int t = t0 + q;
            const float tnq = (float)t / (float)(L - 1);
            const float omega = (6.283185307179586f / (float)L) * (float)t;
            zv[q] = 0.f;
            { const int k = F.lane;
              if (k == 0) zv[q] = tnq;
              else if (k <= 32) { const int kb = (k - 1) & 15; const float band = 1e-4f + (float)kb * ((15.0f - 1e-4f) / 15.0f); const float ang = omega * band; zv[q] = (k <= 16) ? cosf(ang) : -sinf(ang); } }
        }
        {
            float wr_[16], a_[4];
#define MLP_PART(W_, k0_, n_, in_) do { GAS const float* wb_ = (GAS const float*)((W_) + (k0_) * 64); asm volatile("" : "+s"(wb_)); \
                _Pragma("unroll") for (int k = 0; k < (n_); ++k) wr_[k] = wb_[k * 64 + F.lane]; \
                _Pragma("unroll") for (int q = 0; q < 4; ++q) { _Pragma("unroll") for (int k = 0; k < (n_); ++k) a_[q] += lane_bcast((in_)[q], (k0_) + k) * wr_[k]; } } while (0)
#pragma unroll
            for (int q = 0; q < 4; ++q) a_[q] = bb1;
            MLP_PART(w1, 0, 16, zv); MLP_PART(w1, 16, 16, zv); MLP_PART(w1, 32, 1, zv);
#pragma unroll
            for (int q = 0; q < 4; ++q) { f[q] = sinf(a_[q]); a_[q] = bb2; }
            MLP_PART(w2, 0, 16, f); MLP_PART(w2, 16, 16, f); MLP_PART(w2, 32, 16, f); MLP_PART(w2, 48, 16, f);
#pragma unroll
            for (int q = 0; q < 4; ++q) { zv[q] = sinf(a_[q]); a_[q] = bb3; }
            MLP_PART(w3, 0, 16, zv); MLP_PART(w3, 16, 16, zv); MLP_PART(w3, 32, 16, zv); MLP_PART(w3, 48, 16, zv);
#pragma unroll
            for (int q = 0; q < 4; ++q) f[q] = sinf(a_[q]);
#undef MLP_PART
        }
#pragma unroll
        for (int q = 0; q < 4; ++q) FA[(F.wave * 4 + q) * 64 + F.lane] = (unsigned short)f2bf(f[q]);
        __syncthreads();
        bf16x8 A[2][2];
#pragma unroll
        for (int mt = 0; mt < 2; ++mt)
#pragma unroll
            for (int ks = 0; ks < 2; ++ks) A[mt][ks] = *(const LAS bf16x8*)(FA + (mt * 16 + l15) * 64 + ks * 32 + lg * 8);
        const bool fwd = F.wave < 4;
        for (int nt = 0; nt < 16; ++nt) {
            const int n2 = F.wave * 256 + nt * 16 + l15, d = n2 & (DM - 1);
            const bf16x8 B0 = *(const GAS bf16x8*)(W4T + (size_t)n2 * 64 + lg * 8), B1 = *(const GAS bf16x8*)(W4T + (size_t)n2 * 64 + 32 + lg * 8);
            const float rate2 = fabsf(r0 + (float)d * ((r1 - r0) / (float)(DM - 1))) * 1.4426950408889634f;
#pragma unroll
            for (int mt = 0; mt < 2; ++mt) {
                f32x4 acc = {0.f, 0.f, 0.f, 0.f};
                acc = __builtin_amdgcn_mfma_f32_16x16x32_bf16(A[mt][0], B0, acc, 0, 0, 0);
                acc = __builtin_amdgcn_mfma_f32_16x16x32_bf16(A[mt][1], B1, acc, 0, 0, 0);
                const int tq = tb + mt * 16 + lg * 4;
                f32x4 val;
#pragma unroll
                for (int r = 0; r < 4; ++r) val[r] = acc[r] * __builtin_amdgcn_exp2f(-((float)(tq + r) * inv_lm1) * rate2);
                if (lat) { float* dst = (float*)(F.ws + WS_HCLAT) + (fwd ? (size_t)0 : (size_t)DM * SEQ) + (size_t)d * SEQ + tq; *(f32x4*)dst = val; }
                else {
#pragma unroll
                    for (int r = 0; r < 4; ++r) { const int t = tq + r;
                        if (fwd) Hc[(size_t)(t + L - 1) * DM + d] = val[r];
                        else if (t >= 1) Hc[(size_t)(L - 1 - t) * DM + d] = val[r]; } }
            }
        }
        __syncthreads();
    }
}
__device__ __forceinline__ void p0_gemv(Frame& F, int lo, int hi, int slot, int nslots) {
    LAS float* S = (LAS float*)F.lds;
    for (int e = F.tid; e < 5 * DM; e += NTHREADS) { const int v = e / DM, k = e % DM; const float x = v < 4 ? F.inp(I_C)[v * DM + k] : F.inp(I_CCTX)[k]; S[e] = silu_f(x); }
    __syncthreads();
    LAS float* RED4 = (LAS float*)(F.lds + 32768);
    const int hl = F.lane >> 5, c4 = F.lane & 31;
    for (int it = lo + slot; it < hi; it += nslots) {
        const int layer = it / 48, cb = it % 48;
        const f32x4* W = (const f32x4*)(F.inp(I_MODW) + (size_t)layer * DM * (NMOD * DM) + cb * 128) + c4;
        f32x4 a0 = {0.f, 0.f, 0.f, 0.f}, a1 = a0, a2 = a0, a3 = a0, a4 = a0;
        const int k0 = F.wave * 128 + hl;
        for (int kb = k0; kb < k0 + 128; kb += 32) {
            f32x4 wv[16];
#pragma unroll
            for (int i = 0; i < 16; ++i) wv[i] = __builtin_nontemporal_load(W + (size_t)(kb + 2 * i) * (NMOD * DM / 4));
#pragma unroll
            for (int i = 0; i < 16; ++i) asm volatile("" : "+v"(wv[i]));
#pragma unroll
            for (int i = 0; i < 16; ++i) { const int k = kb + 2 * i; const f32x4 w = wv[i]; a0 += w * S[k]; a1 += w * S[DM + k]; a2 += w * S[2 * DM + k]; a3 += w * S[3 * DM + k]; a4 += w * S[4 * DM + k]; }
        }
        LAS f32x4* R4 = (LAS f32x4*)RED4 + (F.wave * 5) * 64 + F.lane;
        R4[0] = a0; R4[64] = a1; R4[128] = a2; R4[192] = a3; R4[256] = a4;
        __syncthreads();
        for (int e = F.tid; e < 5 * 128; e += NTHREADS) { const int v = e >> 7, l = e & 127; float s = 0.f;
#pragma unroll
            for (int w = 0; w < 8; ++w) s += RED4[(w * 5 + v) * 256 + l] + RED4[(w * 5 + v) * 256 + 128 + l];
            s += F.inp(I_MODB)[layer * (NMOD * DM) + cb * 128 + l];
            const int idx = v < 4 ? layer * 4 + v : 16 + layer;
            ((float*)(F.ws + WS_MOD))[(size_t)idx * (NMOD * DM) + cb * 128 + l] = s; }
        __syncthreads();
    }
    __syncthreads();
}
__device__ __forceinline__ void p0_prologue(Frame& F) {
    const int gw = F.vcu * NWAVES + F.wave, NGW = F.G * NWAVES;
#ifndef P0_TREP
#define P0_TREP 1
#endif
    if (F.G == 256) {
        if (F.bx < 192) p0_gemv(F, 0, DEPTH * 48, F.bx, 192);
        else for (int rep_ = 0; rep_ < P0_TREP; ++rep_) transpose_group(F, TG_P0, F.bx - 192, 1, 64);
    } else {
        p0_gemv(F, 0, DEPTH * 48, F.bx, F.G);
        p0_filters(F, F.bx, F.G); __syncthreads();
        transpose_group(F, 0x1ffffu, F.bx, 1, F.G);
    }
    for (int e = gw * 64 + F.lane; e < 64 * 32 + 64 * 16; e += NGW * 64) {
        if (e < 64 * 32) { const int pos = e >> 5, k = e & 31; const float ang = (float)pos * expf(-(float)(2 * k) * (9.210340371976184f / 64.0f)); ((float2*)(F.ws + WS_CSA))[e] = make_float2(cosf(ang), sinf(ang)); }
        else { const int e2 = e - 64 * 32, pos = e2 >> 4, k = e2 & 15; const float ang = (float)pos * expf(-(float)(2 * k) * (9.210340371976184f / 32.0f)); ((float2*)(F.ws + WS_CSC))[e2] = make_float2(cosf(ang), sinf(ang)); }
    }
}
#ifndef TAIL_GREP
#define TAIL_GREP 1
#endif
#ifndef TAIL_TREP
#define TAIL_TREP 1
#endif
#ifndef TAIL_FREP
#define TAIL_FREP 1
#endif
__device__ __forceinline__ void tail_work(Frame& F, int layer, int first_idle) {
    if (layer == 1) { if (F.bx >= 120) { for (int r_ = 0; r_ < TAIL_FREP; ++r_) filters_mfma(F, 255 - F.bx, 136); } }
    for (int r_ = 0; r_ < TAIL_TREP; ++r_) transpose_group(F, layer == 0 ? TG_L0 : layer == 1 ? TG_L1 : layer == 2 ? TG_L2 : TG_L3, F.bx - first_idle, 1, 256 - first_idle);
}
static_assert(((MT / 256) * (A_COLS / 256)) % 256 == 152 && ((MT / 256) * (3 * DM / 256)) % 256 == 48, "tail_work's workgroup ranges");
__device__ __forceinline__ void row_phase(Frame& F, int r_begin, int nrows, const bf16* src, int l_res, int g_res, int gate_idx, bool do_norm, int l_n, int g_n, int shift_idx, int scale_idx, const float* slab = nullptr, int nsplit = 0, bool h_in = false, bool out_f32 = false) {
    const int gw = F.vcu * NWAVES + F.wave, NGW = F.G * NWAVES;
    const float* NG = F.inp(I_NORMG); const float* xin = F.inp(I_X); const float* cin = F.inp(I_CTX);
    bf16* U = (bf16*)(F.ws + WS_U);
    const int nlat = r_begin == 0 ? (nrows < MLAT ? nrows : MLAT) : 0, RPW = (nlat + NGW - 1) / NGW;
    const bool skew = nsplit > 0 && nlat == MLAT && NGW == 2048 && nrows == MT;
    const bool cwv = F.wave < 4;
    const int l0 = skew ? F.vcu * 64 + (cwv ? 7 * F.wave : 28 + 9 * (F.wave - 4)) : gw * RPW, rpw = skew ? (cwv ? 7 : 9) : RPW;
    const int nl = l0 >= nlat ? 0 : (nlat - l0 < rpw ? nlat - l0 : rpw);
    const int nctx = nrows > MLAT ? nrows - MLAT : 0, c0 = skew ? F.vcu * 4 + F.wave : gw;
    const int nc = skew ? (cwv ? 1 : 0) : (gw < nctx ? (nctx - gw + NGW - 1) / NGW : 0);
    const int nseq = nl + nc;
#define RP_ROW(i_) ((i_) < nl ? l0 + (i_) : MLAT + c0 + ((i_) - nl) * NGW)
    f32x4 vn[4]; uint2 wn[4], hn[4];
#pragma unroll
    for (int j = 0; j < 4; ++j) { vn[j] = (f32x4){0.f, 0.f, 0.f, 0.f}; wn[j] = make_uint2(0u, 0u); hn[j] = wn[j]; }
#define RP_LOAD(r_) do { if (h_in || (r_) >= MLAT) { const float* hs_ = h_in ? ((r_) < MLAT ? xin + (size_t)(r_) * DM : cin + (size_t)((r_) - MLAT) * DM) : hrow_ctx(F, (r_)); \
            _Pragma("unroll") for (int j = 0; j < 4; ++j) vn[j] = *((const f32x4*)hs_ + F.lane + 64 * j); } \
        else { const bf16* hb_ = hrow_lat(F, (r_)); _Pragma("unroll") for (int j = 0; j < 4; ++j) hn[j] = *((const uint2*)hb_ + F.lane + 64 * j); } \
        if (src && !((r_) >= MLAT && nsplit > 0)) { _Pragma("unroll") for (int j = 0; j < 4; ++j) wn[j] = *((const uint2*)(src + (size_t)(r_) * DM) + F.lane + 64 * j); } } while (0)
#define RP_CVT(w_) ((f32x4){bf2f((w_).x & 0xffffu), bf2f((w_).x >> 16), bf2f((w_).y & 0xffffu), bf2f((w_).y >> 16)})
    f32x4 Pgm[4], Pgn[4], Psh[4]; int bcur = -1;
#pragma unroll
    for (int j = 0; j < 4; ++j) { Pgm[j] = (f32x4){0.f, 0.f, 0.f, 0.f}; Pgn[j] = Pgm[j]; Psh[j] = Pgm[j]; }
#define RP_PARAMS(rp_) do { const int b_ = (rp_) < MLAT ? (rp_) / SEQ : BATCH;     \
        if (b_ != bcur) { bcur = b_; \
            if (src) { const float* mv = modvec(F, l_res, (rp_)) + gate_idx * DM; const float* g = NG + (size_t)(l_res * 4 + g_res) * DM; \
                _Pragma("unroll") for (int j = 0; j < 4; ++j) Pgm[j] = *((const f32x4*)g + F.lane + 64 * j) * *((const f32x4*)mv + F.lane + 64 * j); } \
            if (do_norm) { const float* mv = modvec(F, l_n, (rp_)); const float* g = NG + (size_t)(l_n * 4 + g_n) * DM; \
                _Pragma("unroll") for (int j = 0; j < 4; ++j) { Pgn[j] = *((const f32x4*)g + F.lane + 64 * j) * (*((const f32x4*)(mv + scale_idx * DM) + F.lane + 64 * j) + 1.0f); Psh[j] = *((const f32x4*)(mv + shift_idx * DM) + F.lane + 64 * j); } } \
        } } while (0)
    if (nseq > 0) { const int r_ = RP_ROW(0); RP_LOAD(r_); }
    for (int i = 0; i < nseq; ++i) {
        const int r = RP_ROW(i);
        const bool hf32 = h_in || r >= MLAT;
        f32x4 v[4]; uint2 w[4];
#pragma unroll
        for (int j = 0; j < 4; ++j) { v[j] = hf32 ? vn[j] : RP_CVT(hn[j]); w[j] = wn[j]; }
        if (i + 1 < nseq) { const int r_ = RP_ROW(i + 1); RP_LOAD(r_); }
        RP_PARAMS(r);
        if (src) {
            f32x4 o[4]; float ss = 0.f;
            if (r >= MLAT && nsplit > 0) {
#pragma unroll
                for (int j = 0; j < 4; ++j) o[j] = (f32x4){0.f, 0.f, 0.f, 0.f};
                const uint2* sl0 = (const uint2*)((const bf16*)slab + (size_t)(r - MLAT) * DM) + F.lane;
#pragma unroll
                for (int sp0 = 0; sp0 < 12; sp0 += 6) {
                    uint2 t[6][4]; float wg[6];
#pragma unroll
                    for (int s = 0; s < 6; ++s) { const int sp = sp0 + s < nsplit ? sp0 + s : nsplit - 1; wg[s] = sp0 + s < nsplit ? 1.f : 0.f;
                        const uint2* sl = sl0 + (size_t)sp * (MCTX * DM / 4);
#pragma unroll
                        for (int j = 0; j < 4; ++j) t[s][j] = sl[64 * j]; }
#pragma unroll
                    for (int s = 0; s < 6; ++s)
#pragma unroll
                        for (int j = 0; j < 4; ++j) o[j] += RP_CVT(t[s][j]) * wg[s];
                }
            } else {
#pragma unroll
                for (int j = 0; j < 4; ++j) o[j] = RP_CVT(w[j]);
            }
#pragma unroll
            for (int j = 0; j < 4; ++j) ss += (o[j].x * o[j].x + o[j].y * o[j].y) + (o[j].z * o[j].z + o[j].w * o[j].w);
            const float rs = __builtin_amdgcn_rsqf(wave_sum(ss) * (1.0f / DM) + EPS);
#pragma unroll
            for (int j = 0; j < 4; ++j) v[j] = v[j] + (o[j] * rs) * Pgm[j];
            if (r >= MLAT) { float* h = hrow_ctx(F, r);
#pragma unroll
                for (int j = 0; j < 4; ++j) *((f32x4*)h + F.lane + 64 * j) = v[j];
            } else if (out_f32) { float* ho = F.out + (size_t)r * DM;
#pragma unroll
                for (int j = 0; j < 4; ++j) *((f32x4*)ho + F.lane + 64 * j) = v[j];
            } else { bf16* hb = hrow_lat(F, r);
#pragma unroll
                for (int j = 0; j < 4; ++j) { uint2 ww; ww.x = pk2(v[j].x, v[j].y); ww.y = pk2(v[j].z, v[j].w); *((uint2*)hb + F.lane + 64 * j) = ww;
                    v[j] = RP_CVT(ww); }
            }
        }
        if (do_norm) {
            float ss = 0.f;
#pragma unroll
            for (int j = 0; j < 4; ++j) ss += (v[j].x * v[j].x + v[j].y * v[j].y) + (v[j].z * v[j].z + v[j].w * v[j].w);
            const float rs = __builtin_amdgcn_rsqf(wave_sum(ss) * (1.0f / DM) + EPS);
#pragma unroll
            for (int j = 0; j < 4; ++j) { const f32x4 y = (v[j] * rs) * Pgn[j] + Psh[j];
                uint2 ww; ww.x = pk2(y.x, y.y); ww.y = pk2(y.z, y.w);
                *((uint2*)(U + (size_t)r * DM) + F.lane + 64 * j) = ww; }
        }
    }
#undef RP_PARAMS
#undef RP_LOAD
#undef RP_ROW
}
#undef RP_CVT

__device__ __forceinline__ void prep_a(Frame& F, int j) {
    const int gw = F.vcu * NWAVES + F.wave, NGW = F.G * NWAVES, lane = F.lane;
    const bf16* QKV = (const bf16*)(F.ws + WS_R + R_QKV);
    bf16* KB = (bf16*)(F.ws + WS_R + R_KB);
    const float* kg = F.inp(I_AKG) + j * A_DH; const float* CSA = (const float*)(F.ws + WS_CSA);
    const float g1 = kg[lane], g2 = kg[64 + lane];
    for (int r0 = gw; r0 < MT; r0 += 9 * NGW) {
        bf16 n[9][4]; float2 cv[9];
#pragma unroll
        for (int i = 0; i < 9; ++i) { const int rr = r0 + i * NGW, r = rr < MT ? rr : MT - 1;
            const bf16* s_ = QKV + (size_t)r * A_COLS + A_HEADS * A_DH; n[i][0] = s_[lane]; n[i][1] = s_[64 + lane]; n[i][2] = s_[A_DH + lane]; n[i][3] = s_[A_DH + 64 + lane];
            const int t = r % SEQ; const float2 tv = *(const float2*)(CSA + ((lane < 32 ? t / GRID_W : t % GRID_W) * 32 + (lane & 31)) * 2); cv[i] = r < MLAT ? tv : make_float2(1.f, 0.f); }
#pragma unroll
        for (int i = 0; i < 9; ++i) { const int r = r0 + i * NGW;
            if (r < MT) {
                const bool lat = r < MLAT; const int b = lat ? r / SEQ : (r - MLAT) / CTXL, t = lat ? r % SEQ : (r - MLAT) % CTXL, key = lat ? CTXL + t : t;
                const float cs = cv[i].x, sn = cv[i].y;
                const float a1 = bf2f(n[i][0]), a2 = bf2f(n[i][1]), b1 = bf2f(n[i][2]), b2 = bf2f(n[i][3]);
                const float ra = __builtin_amdgcn_rsqf(wave_sum(a1 * a1 + a2 * a2) * (1.0f / A_DH) + EPS), rb = __builtin_amdgcn_rsqf(wave_sum(b1 * b1 + b2 * b2) * (1.0f / A_DH) + EPS);
                const float ya1 = a1 * ra * g1, ya2 = a2 * ra * g2, yb1 = b1 * rb * g1, yb2 = b2 * rb * g2;
                bf16* d = KB + ((size_t)b * NKEY + key) * 256;
                d[lane] = (bf16)f2bf(ya1 * cs - ya2 * sn); d[64 + lane] = (bf16)f2bf(ya1 * sn + ya2 * cs);
                d[A_DH + lane] = (bf16)f2bf(yb1 * cs - yb2 * sn); d[A_DH + 64 + lane] = (bf16)f2bf(yb1 * sn + yb2 * cs);
            } }
    }
}
__device__ __forceinline__ void prep_c(Frame& F) {
    const int gw = F.vcu * NWAVES + F.wave, NGW = F.G * NWAVES, lane = F.lane;
    const bf16* QKV = (const bf16*)(F.ws + WS_R + R_QKV);
    bf16* KB = (bf16*)(F.ws + WS_R + R_KB);
    const float* CSC = (const float*)(F.ws + WS_CSC);
    const int i = lane & 31, hsel = lane >> 5;
    for (int r0 = gw; r0 < MT; r0 += 9 * NGW) {
        bf16 n[9][2]; float2 cv[9];
#pragma unroll
        for (int k = 0; k < 9; ++k) { const int rr = r0 + k * NGW, r = rr < MT ? rr : MT - 1;
            const bf16* s_ = QKV + (size_t)r * C_COLS + C_HEADS * C_DH + hsel * C_DH; n[k][0] = s_[i]; n[k][1] = s_[32 + i];
            const int t = r % SEQ; const float2 tv = *(const float2*)(CSC + ((i < 16 ? t / GRID_W : t % GRID_W) * 16 + (i & 15)) * 2); cv[k] = r < MLAT ? tv : make_float2(1.f, 0.f); }
#pragma unroll
        for (int k = 0; k < 9; ++k) { const int r = r0 + k * NGW;
            if (r < MT) {
                const bool lat = r < MLAT; const int b = lat ? r / SEQ : (r - MLAT) / CTXL, t = lat ? r % SEQ : (r - MLAT) % CTXL, key = lat ? CTXL + t : t;
                const float cs = cv[k].x, sn = cv[k].y;
                const float x1 = bf2f(n[k][0]), x2 = bf2f(n[k][1]);
                bf16* d = KB + ((size_t)b * NKEY + key) * 128 + hsel * C_DH;
                d[i] = (bf16)f2bf(x1 * cs - x2 * sn); d[32 + i] = (bf16)f2bf(x1 * sn + x2 * cs);
            } }
    }
}

__device__ __forceinline__ void attn_a_phase(Frame& F, bool with_ctx, int j) {
    const bf16* QKV = (const bf16*)(F.ws + WS_R + R_QKV); const bf16* KB = (const bf16*)(F.ws + WS_R + R_KB);
    bf16* OP = (bf16*)(F.ws + WS_U);
    const float* qg = F.inp(I_AQG) + j * A_DH; const float* CSA = (const float*)(F.ws + WS_CSA);
    const int ntotal = 512 + (with_ctx ? 32 : 0);
    const bool g256 = F.G == 256;
    for (int i = 0;; ++i) {
        int U;
        if (g256) { if (i >= 3) break; U = i < 2 ? 2 * F.vcu + i : 512 + F.vcu; if (U >= ntotal) break; }
        else { U = F.vcu + i * F.G; if (U >= ntotal) break; }
        int tid_u = F.tid; asm volatile("" : "+v"(tid_u));
        int b, kvh, seq, h, qrow, t_first; const float* cs;
        if (U < 512) { const int pair = U >> 6, g = (U & 63) >> 4, qb = U & 15; b = pair >> 1; kvh = pair & 1; h = kvh * 4 + g; qrow = b * SEQ + qb * 256; seq = NKEY; cs = CSA; t_first = qb * 256; }
        else { const int c = U - 512; b = c >> 3; h = c & 7; kvh = h >> 2; qrow = MLAT + b * CTXL; seq = CTXL; cs = nullptr; t_first = 0; }
        aa::attn_dense_body(QKV + (size_t)qrow * A_COLS + h * A_DH, KB + (size_t)b * NKEY * 256 + kvh * A_DH, QKV + (A_HEADS + A_KV) * A_DH + kvh * A_DH, MLAT + b * CTXL, b * SEQ, OP + (size_t)qrow * DM + h * A_DH, seq, (char*)F.ldsg, tid_u, qg, cs, t_first);
    }
}

__device__ __forceinline__ void attn_c_phase(Frame& F, bool with_ctx) {
    const bf16* QKV = (const bf16*)(F.ws + WS_R + R_QKV); const bf16* KB = (const bf16*)(F.ws + WS_R + R_KB);
    bf16* OP = (bf16*)(F.ws + WS_U);
    const float* sink = F.inp(I_CSINK); const float* CSC = (const float*)(F.ws + WS_CSC);
    const int ntotal = 1024 + (with_ctx ? 64 : 0);
    for (int U = F.vcu; U < ntotal; U += F.G) {
        int b, kvh, t0, qrow;
        if (U < 1024) { b = U >> 8; kvh = (U >> 7) & 1; const int qb = U & 127; t0 = qb * 32; qrow = b * SEQ + t0; }
        else { const int c = U - 1024; b = c >> 4; kvh = (c >> 3) & 1; const int qb = c & 7; t0 = -1; qrow = MLAT + b * CTXL + qb * 32; }
        const int h = kvh * 8 + F.wave;
        ac::unit(QKV + (size_t)qrow * C_COLS + h * C_DH, KB + (size_t)b * NKEY * 128 + kvh * C_DH, QKV + (C_HEADS + C_KV) * C_DH + kvh * C_DH, MLAT + b * CTXL, b * SEQ,
                 OP + (size_t)qrow * DM + h * C_DH, t0, sink[h] * 1.4426950408889634f, (char*)F.ldsg, F.tid, CSC);
    }
}

__device__ __forceinline__ float hy_dwconv(const bf16* u3, int r, int col, bool has_prev, bool has_next, const float* cw, const float* cb) {
    float a = cb[col] + cw[3 * DM + col] * bf2f(u3[(size_t)r * (3 * DM) + col]);
    if (has_prev) a += cw[col] * bf2f(u3[(size_t)(r - 1) * (3 * DM) + col]);
    if (has_next) a += cw[2 * 3 * DM + col] * bf2f(u3[(size_t)(r + 1) * (3 * DM) + col]);
    return a;
}
__device__ __forceinline__ void hy1t(Frame& F) {
    const int gw = F.vcu * NWAVES + F.wave, NGW = F.G * NWAVES, lane = F.lane;
    const bf16* u3 = (const bf16*)(F.ws + WS_R + R_QKV); bf16* VPT = (bf16*)(F.ws + WS_R + R_VPT);
    const float* cw = F.inp(I_BCW); const float* cb = F.inp(I_BCB);
    LAS float* tile = (LAS float*)(F.lds + F.wave * (64 * 65 * 4));
    constexpr int NA = BATCH * (SEQ / 64) * (DM / 64);
    const int hl = lane >> 5, c2 = lane & 31;
    for (int it = gw; it < NA; it += NGW) {
        const int dt = it % (DM / 64), tt = (it / (DM / 64)) % (SEQ / 64), b = it / ((DM / 64) * (SEQ / 64));
        const int d = dt * 64 + 2 * c2, ts = tt * 64 + 32 * hl, rs = b * SEQ + ts;
        const int c1 = DM + d, cv = 2 * DM + d;
        const float2 b1 = *(const float2*)(cb + c1), b2 = *(const float2*)(cb + cv);
        const float2 w10 = *(const float2*)(cw + c1), w11 = *(const float2*)(cw + 3 * DM + c1), w12 = *(const float2*)(cw + 6 * DM + c1);
        const float2 w20 = *(const float2*)(cw + cv), w21 = *(const float2*)(cw + 3 * DM + cv), w22 = *(const float2*)(cw + 6 * DM + cv);
        unsigned xr[34], vr[34];
#pragma unroll
        for (int i = 0; i < 34; ++i) { const int tq = ts - 1 + i; const bool ok = tq >= 0 && tq < SEQ; const size_t ro = (size_t)(ok ? rs - 1 + i : rs) * (3 * DM);
            xr[i] = *(const unsigned*)(u3 + ro + c1); vr[i] = *(const unsigned*)(u3 + ro + cv); }
#pragma unroll
        for (int i = 0; i < 34; ++i) asm volatile("" : "+v"(xr[i]), "+v"(vr[i]));
        if (ts == 0) { xr[0] = 0u; vr[0] = 0u; }
        if (ts + 32 >= SEQ) { xr[33] = 0u; vr[33] = 0u; }
#pragma unroll
        for (int i = 0; i < 32; ++i) {
            const unsigned p1 = xr[i], q1 = xr[i + 1], n1 = xr[i + 2], p2 = vr[i], q2 = vr[i + 1], n2 = vr[i + 2];
            const float xa = b1.x + w10.x * bf2f(p1 & 0xffffu) + w11.x * bf2f(q1 & 0xffffu) + w12.x * bf2f(n1 & 0xffffu), xb = b1.y + w10.y * bf2f(p1 >> 16) + w11.y * bf2f(q1 >> 16) + w12.y * bf2f(n1 >> 16);
            const float va = b2.x + w20.x * bf2f(p2 & 0xffffu) + w21.x * bf2f(q2 & 0xffffu) + w22.x * bf2f(n2 & 0xffffu), vb = b2.y + w20.y * bf2f(p2 >> 16) + w21.y * bf2f(q2 >> 16) + w22.y * bf2f(n2 >> 16);
            tile[(32 * hl + i) * 65 + 2 * c2] = xa * va; tile[(32 * hl + i) * 65 + 2 * c2 + 1] = xb * vb;
        }
        LDS_WAIT(); asm volatile("" ::: "memory");
        bf16* dst = VPT + ((size_t)(b * DM + dt * 64)) * SEQ + tt * 64 + 2 * c2;
#pragma unroll 8
        for (int j2 = 0; j2 < 32; ++j2) { const int j = 2 * j2 + hl; *(unsigned*)(dst + (size_t)j * SEQ) = pk2(tile[(2 * c2) * 65 + j], tile[(2 * c2 + 1) * 65 + j]); }
        LDS_WAIT(); asm volatile("" ::: "memory");
    }
    float* VPC = (float*)(F.ws + WS_R + R_VPC);
    for (int q = F.vcu * NTHREADS + F.tid; q < (MCTX / 4) * (DM / 2); q += F.G * NTHREADS) {
        const int cp = q % (DM / 2), rc0 = (q / (DM / 2)) * 4, t0 = rc0 % CTXL, d = 2 * cp, r0 = MLAT + rc0;
        const int c1 = DM + d, cv = 2 * DM + d;
        unsigned xr[6], vr[6];
#pragma unroll
        for (int i = 0; i < 6; ++i) { const int tq = t0 - 1 + i; const bool ok = tq >= 0 && tq < CTXL; const size_t ro = (size_t)(ok ? r0 - 1 + i : r0) * (3 * DM);
            xr[i] = *(const unsigned*)(u3 + ro + c1); vr[i] = *(const unsigned*)(u3 + ro + cv); }
#pragma unroll
        for (int i = 0; i < 6; ++i) asm volatile("" : "+v"(xr[i]), "+v"(vr[i]));
        if (t0 == 0) { xr[0] = 0u; vr[0] = 0u; }
        if (t0 + 4 >= CTXL) { xr[5] = 0u; vr[5] = 0u; }
        const float2 b1 = *(const float2*)(cb + c1), b2 = *(const float2*)(cb + cv);
        const float2 w10 = *(const float2*)(cw + c1), w11 = *(const float2*)(cw + 3 * DM + c1), w12 = *(const float2*)(cw + 6 * DM + c1);
        const float2 w20 = *(const float2*)(cw + cv), w21 = *(const float2*)(cw + 3 * DM + cv), w22 = *(const float2*)(cw + 6 * DM + cv);
#pragma unroll
        for (int k = 0; k < 4; ++k) {
            const unsigned p1 = xr[k], q1 = xr[k + 1], n1 = xr[k + 2], p2 = vr[k], q2 = vr[k + 1], n2 = vr[k + 2];
            const float xa = b1.x + w10.x * bf2f(p1 & 0xffffu) + w11.x * bf2f(q1 & 0xffffu) + w12.x * bf2f(n1 & 0xffffu), xb = b1.y + w10.y * bf2f(p1 >> 16) + w11.y * bf2f(q1 >> 16) + w12.y * bf2f(n1 >> 16);
            const float va = b2.x + w20.x * bf2f(p2 & 0xffffu) + w21.x * bf2f(q2 & 0xffffu) + w22.x * bf2f(n2 & 0xffffu), vb = b2.y + w20.y * bf2f(p2 >> 16) + w21.y * bf2f(q2 >> 16) + w22.y * bf2f(n2 >> 16);
            *(float2*)(VPC + (size_t)(rc0 + k) * DM + d) = make_float2(xa * va, xb * vb);
        }
    }
}
__device__ __forceinline__ void hyconv_ctx(Frame& F) {
    const bf16* u3 = (const bf16*)(F.ws + WS_R + R_QKV); const float* VPC = (const float*)(F.ws + WS_R + R_VPC);
    bf16* OP = (bf16*)(F.ws + WS_U);
    const float* cw = F.inp(I_BCW); const float* cb = F.inp(I_BCB); const float* skip = F.inp(I_BSKIP);
    constexpr int L = CTXL, n_ctx = BATCH * (CTXL / 8) * DM;
    for (int q = F.vcu * NTHREADS + F.tid; q < n_ctx; q += F.G * NTHREADS) {
        const int d = q % DM, tb = (q / DM) % (L / 8), b = q / (DM * (L / 8));
        const int rbase = b * CTXL, t0 = tb * 8;
        const float* Hc = (const float*)(F.ws + WS_HCCTX) + d;
        const float* vp = VPC + (size_t)rbase * DM + d;
        unsigned x0r[10]; float vsk[8];
#pragma unroll
        for (int i = 0; i < 10; ++i) { const int tq = t0 - 1 + i; const bool ok = tq >= 0 && tq < L; x0r[i] = u3[(size_t)(MLAT + rbase + (ok ? tq : t0)) * (3 * DM) + d]; }
#pragma unroll
        for (int k = 0; k < 8; ++k) vsk[k] = vp[(size_t)(t0 + k) * DM];
#pragma unroll
        for (int i = 0; i < 10; ++i) asm volatile("" : "+v"(x0r[i]));
#pragma unroll
        for (int k = 0; k < 8; ++k) asm volatile("" : "+v"(vsk[k]));
        float y[8];
#pragma unroll
        for (int k = 0; k < 8; ++k) y[k] = 0.f;
#pragma unroll 4
        for (int s0 = 0; s0 < L; s0 += 8) {
            const int base = t0 - s0 + L - 1 - 7;
            float f[15];
#pragma unroll
            for (int i = 0; i < 15; ++i) { const int idx = base + i; f[i] = (idx >= 0 && idx <= 2 * L - 2) ? Hc[(size_t)idx * DM] : 0.f; }
#pragma unroll
            for (int j = 0; j < 8; ++j) { const float v = vp[(size_t)(s0 + j) * DM];
#pragma unroll
                for (int k = 0; k < 8; ++k) y[k] += f[k - j + 7] * v; }
        }
        const float sk = skip[d], cb0 = cb[d], cwp = cw[d], cwc = cw[3 * DM + d], cwn = cw[2 * 3 * DM + d];
#pragma unroll
        for (int k = 0; k < 8; ++k) { const int t = t0 + k, r = MLAT + rbase + t;
            float x0 = cb0 + cwc * bf2f(x0r[k + 1]);
            if (t > 0) x0 += cwp * bf2f(x0r[k]);
            if (t < L - 1) x0 += cwn * bf2f(x0r[k + 2]);
            OP[(size_t)r * DM + d] = (bf16)f2bf((y[k] + sk * vsk[k]) * x0); }
    }
}
__device__ __forceinline__ void hy3(Frame& F) {
    const int gw = F.vcu * NWAVES + F.wave, NGW = F.G * NWAVES, lane = F.lane;
    const bf16* u3 = (const bf16*)(F.ws + WS_R + R_QKV); const bf16* YT = (const bf16*)(F.ws + WS_R + R_VPT);
    bf16* OP = (bf16*)(F.ws + WS_U);
    const float* cw = F.inp(I_BCW); const float* cb = F.inp(I_BCB);
    LAS float* tile = (LAS float*)(F.lds + F.wave * (64 * 65 * 4));
    constexpr int NA = BATCH * (SEQ / 64) * (DM / 64);
    for (int it = gw; it < NA; it += NGW) {
        const int dt = it % (DM / 64), tt = (it / (DM / 64)) % (SEQ / 64), b = it / ((DM / 64) * (SEQ / 64));
        const int d = dt * 64 + lane, t0 = tt * 64, r0 = b * SEQ + t0;
        const bf16* src = YT + ((size_t)(b * DM + dt * 64)) * SEQ + t0 + lane;
        bf16 yv[64]; bf16 xr[66];
#pragma unroll
        for (int j = 0; j < 64; ++j) yv[j] = src[(size_t)j * SEQ];
#pragma unroll
        for (int i = 0; i < 66; ++i) { const int tq = t0 - 1 + i; const bool ok = tq >= 0 && tq < SEQ; xr[i] = u3[(size_t)(ok ? r0 - 1 + i : r0) * (3 * DM) + d]; }
        { unsigned p_[66], q_[64];
#pragma unroll
          for (int i = 0; i < 66; ++i) { p_[i] = xr[i]; asm volatile("" : "+v"(p_[i])); xr[i] = (bf16)p_[i]; }
#pragma unroll
          for (int j = 0; j < 64; ++j) { q_[j] = yv[j]; asm volatile("" : "+v"(q_[j])); yv[j] = (bf16)q_[j]; } }
        if (t0 == 0) xr[0] = (bf16)0;
        if (t0 + 64 >= SEQ) xr[65] = (bf16)0;
#pragma unroll
        for (int j = 0; j < 64; ++j) tile[j * 65 + lane] = bf2f(yv[j]);
        LDS_WAIT(); asm volatile("" ::: "memory");
        const float b0 = cb[d], w0 = cw[d], w1 = cw[3 * DM + d], w2 = cw[6 * DM + d];
#pragma unroll
        for (int i = 0; i < 64; ++i) {
            const float x0 = b0 + w0 * bf2f(xr[i]) + w1 * bf2f(xr[i + 1]) + w2 * bf2f(xr[i + 2]);
            OP[(size_t)(r0 + i) * DM + d] = (bf16)f2bf(tile[lane * 65 + i] * x0);
        }
        LDS_WAIT(); asm volatile("" ::: "memory");
    }
}

namespace hf {
typedef float cf __attribute__((ext_vector_type(2)));
__device__ __forceinline__ cf cmul(cf a, cf w) { return {a.x * w.x - a.y * w.y, a.x * w.y + a.y * w.x}; }
__device__ __forceinline__ cf cmulc(cf a, cf w) { return {a.x * w.x + a.y * w.y, a.y * w.x - a.x * w.y}; }
constexpr int PAD = 272;
__device__ __forceinline__ int lidx(int k1, int a, int b) { return k1 * PAD + a * 16 + ((b + a) & 15); }
template <int S> __device__ __forceinline__ void dft4(cf& a, cf& b, cf& c, cf& d) {
    const cf s0 = a + c, s1 = a - c, s2 = b + d, s3 = b - d;
    const cf j3 = S > 0 ? cf{-s3.y, s3.x} : cf{s3.y, -s3.x};
    a = s0 + s2; c = s0 - s2; b = s1 + j3; d = s1 - j3;
}
template <int S> __device__ __forceinline__ void dft16(cf (&x)[16]) {
#pragma unroll
    for (int nb = 0; nb < 4; ++nb) dft4<S>(x[nb], x[4 + nb], x[8 + nb], x[12 + nb]);
    const float c1 = 0.92387953251128674f, s1 = 0.38268343236508977f, r2 = 0.70710678118654752f, sg = (float)S;
    x[4 + 1] = cmul(x[4 + 1], cf{c1, sg * s1});  x[4 + 2] = cmul(x[4 + 2], cf{r2, sg * r2});   x[4 + 3] = cmul(x[4 + 3], cf{s1, sg * c1});
    x[8 + 1] = cmul(x[8 + 1], cf{r2, sg * r2});  x[8 + 2] = cmul(x[8 + 2], cf{0.f, sg});       x[8 + 3] = cmul(x[8 + 3], cf{-r2, sg * r2});
    x[12 + 1] = cmul(x[12 + 1], cf{s1, sg * c1}); x[12 + 2] = cmul(x[12 + 2], cf{-r2, sg * r2}); x[12 + 3] = cmul(x[12 + 3], cf{-c1, -sg * s1});
#pragma unroll
    for (int ka = 0; ka < 4; ++ka) dft4<S>(x[4 * ka], x[4 * ka + 1], x[4 * ka + 2], x[4 * ka + 3]);
}
#define HF_OUT(x, k) x[4 * ((k) & 3) + ((k) >> 2)]
__device__ __forceinline__ void fft_fwd(cf (&x)[16], LAS cf* D, const LAS cf* TW, int u) {
    asm volatile("" : "+v"(u));
    int hi4 = u >> 4, lo4 = u & 15;
    dft16<-1>(x);
#pragma unroll
    for (int k1 = 0; k1 < 16; ++k1) D[lidx(k1, hi4, lo4)] = cmul(HF_OUT(x, k1), TW[(16 * hi4 * k1) & 4095]);
    __syncthreads();
    asm volatile("" : "+v"(hi4), "+v"(lo4));
#pragma unroll
    for (int n2 = 0; n2 < 16; ++n2) x[n2] = D[lidx(hi4, n2, lo4)];
    dft16<-1>(x);
#pragma unroll
    for (int k2 = 0; k2 < 16; ++k2) D[lidx(hi4, k2, lo4)] = cmul(HF_OUT(x, k2), TW[lo4 * (hi4 + 16 * k2)]);
    __syncthreads();
    asm volatile("" : "+v"(hi4), "+v"(lo4));
#pragma unroll
    for (int n3 = 0; n3 < 16; ++n3) x[n3] = D[lidx(hi4, lo4, n3)];
    dft16<-1>(x);
}
__device__ __forceinline__ void fft_inv(cf (&x)[16], LAS cf* D, const LAS cf* TW, int u) {
    asm volatile("" : "+v"(u));
    int hi4 = u >> 4, lo4 = u & 15;
    dft16<1>(x);
#pragma unroll
    for (int n3 = 0; n3 < 16; ++n3) D[lidx(hi4, lo4, n3)] = cmulc(HF_OUT(x, n3), TW[n3 * (hi4 + 16 * lo4)]);
    __syncthreads();
    asm volatile("" : "+v"(hi4), "+v"(lo4));
#pragma unroll
    for (int k2 = 0; k2 < 16; ++k2) x[k2] = D[lidx(hi4, k2, lo4)];
    dft16<1>(x);
#pragma unroll
    for (int n2 = 0; n2 < 16; ++n2) D[lidx(hi4, n2, lo4)] = cmulc(HF_OUT(x, n2), TW[(16 * n2 * hi4) & 4095]);
    __syncthreads();
    asm volatile("" : "+v"(hi4), "+v"(lo4));
#pragma unroll
    for (int k1 = 0; k1 < 16; ++k1) x[k1] = D[lidx(k1, hi4, lo4)];
    dft16<1>(x);
}
}
__device__ __forceinline__ void hyfft(Frame& F) {
    using namespace hf;
    const int tid = F.tid, half = F.wave >> 2, u_ = tid & 255;
    LAS cf* D = (LAS cf*)F.lds + half * (16 * PAD);
    LAS cf* TW = (LAS cf*)(F.lds + 2 * 16 * PAD * 8);
    LAS cf* COMB = (LAS cf*)(F.lds + 2 * 16 * PAD * 8 + 32768);
    for (int m = tid; m < 4096; m += NTHREADS) { const float a = (float)m * (1.0f / 2048.0f); TW[m] = cf{cospif(a), -sinpif(a)}; }
    cf w8u; { const float a = (float)u_ * (1.0f / 4096.0f); w8u = cf{cospif(a), -sinpif(a)}; }
    __syncthreads();
    const float* HF = (const float*)(F.ws + WS_HCLAT); bf16* VPT = (bf16*)(F.ws + WS_R + R_VPT);
    const float* skip = F.inp(I_BSKIP);
    float pb[32];
#define HF_LOAD_FILT(ch_) do { const float* hf_ = HF + (size_t)(ch_) * SEQ; const float* hb_ = HF + (size_t)DM * SEQ + (size_t)(ch_) * SEQ;     \
        _Pragma("unroll") for (int n1 = 0; n1 < 16; ++n1) { const int n = 256 * n1 + u_; pb[n1] = hf_[n]; pb[16 + n1] = hb_[n == 0 ? 0 : SEQ - n]; } } while (0)
#define HF_LOAD_PAIR(ch_, pr_) do { const bf16* a0_ = VPT + ((size_t)((2 * (pr_)) * DM + (ch_))) * SEQ; const bf16* a1_ = VPT + ((size_t)((2 * (pr_) + 1) * DM + (ch_))) * SEQ;     \
        _Pragma("unroll") for (int n1 = 0; n1 < 16; ++n1) { const int n = 256 * n1 + u_; pb[2 * n1] = __uint_as_float((unsigned)a0_[n]); pb[2 * n1 + 1] = __uint_as_float((unsigned)a1_[n]); } } while (0)
    if (F.vcu < DM) HF_LOAD_FILT(F.vcu);
    for (int ch = F.vcu; ch < DM; ch += F.G) {
        int u = u_; asm volatile("" : "+v"(u));
        cf Fs[16];
        {
            cf x[16];
            const float sk = skip[ch];
#pragma unroll
            for (int n1 = 0; n1 < 16; ++n1) { const int n = 256 * n1 + u;
                float fa = pb[n1]; if (n == 0) fa += sk;
                const float fb = n == 0 ? 0.f : pb[16 + n1];
                if (half == 0) x[n1] = cf{fa + fb, 0.f};
                else { const cf w = cmul(w8u, TW[128 * n1]); const float dd = fa - fb; x[n1] = cf{dd * w.x, dd * w.y}; } }
            HF_LOAD_PAIR(ch, 0);
            fft_fwd(x, D, TW, u);
#pragma unroll
            for (int k3 = 0; k3 < 16; ++k3) { const cf v = HF_OUT(x, k3); Fs[k3] = cf{v.x * (1.0f / 8192.0f), v.y * (1.0f / 8192.0f)}; }
        }
#pragma unroll
        for (int pr = 0; pr < 2; ++pr) {
            __syncthreads();
            asm volatile("" : "+v"(u));
            bf16* v0 = VPT + ((size_t)((2 * pr) * DM + ch)) * SEQ; bf16* v1 = VPT + ((size_t)((2 * pr + 1) * DM + ch)) * SEQ;
            cf x[16];
#pragma unroll
            for (int n1 = 0; n1 < 16; ++n1) { const cf z = cf{bf2f(__float_as_uint(pb[2 * n1])), bf2f(__float_as_uint(pb[2 * n1 + 1]))};
                x[n1] = half == 0 ? z : cmul(z, cmul(w8u, TW[128 * n1])); }
            if (pr == 0) HF_LOAD_PAIR(ch, 1);
            else if (ch + F.G < DM) HF_LOAD_FILT(ch + F.G);
            fft_fwd(x, D, TW, u);
            cf w[16];
#pragma unroll
            for (int k3 = 0; k3 < 16; ++k3) w[k3] = cmul(HF_OUT(x, k3), Fs[k3]);
            fft_inv(w, D, TW, u);
            if (half == 1) {
#pragma unroll
                for (int n1 = 0; n1 < 16; ++n1) COMB[256 * n1 + u] = cmulc(HF_OUT(w, n1), cmul(w8u, TW[128 * n1]));
            }
            __syncthreads();
            if (half == 0) {
#pragma unroll
                for (int n1 = 0; n1 < 16; ++n1) { const int n = 256 * n1 + u; const cf y = HF_OUT(w, n1) + COMB[n]; const unsigned yp = pk2(y.x, y.y); v0[n] = (bf16)(yp & 0xffffu); v1[n] = (bf16)(yp >> 16); }
            }
        }
        __syncthreads();
    }
#undef HF_LOAD_FILT
#undef HF_LOAD_PAIR
}

constexpr int N_PHASES = 2 + 8 * DEPTH + 1;
__global__ void __launch_bounds__(NTHREADS, 2) fwd_kernel(Args args) {
    extern __shared__ __attribute__((aligned(16))) unsigned char lds[];
    Frame F;
    F.lds = (LAS unsigned char*)lds; F.ldsg = lds;
    F.MISC = (volatile LAS unsigned*)(F.lds + MISC_OFF);
    int wave_s = __builtin_amdgcn_readfirstlane(threadIdx.x >> 6);
    F.tid = threadIdx.x; F.lane = F.tid & 63; F.wave = wave_s;
    F.G = gridDim.x; { const int bx = blockIdx.x; F.vcu = (F.G % 8 == 0) ? (bx % 8) * (F.G / 8) + bx / 8 : bx; }
    F.out = args.out; F.ws = args.ws; F.ctl = (gu32*)(args.ws + WS_CTL);
    F.intab = (LAS unsigned long long*)(F.lds + INTAB_OFF);
    for (int u = F.tid; u < 64; u += NTHREADS) ((LAS unsigned*)(F.lds + MISC_OFF))[u] = 0u;
    if (F.tid < N_IN) F.intab[F.tid] = (unsigned long long)args.in[F.tid];
    __syncthreads();
    XcdBarrier bar; bar.bar = (unsigned*)(F.ctl + CW_BAR); bar.x = 0; bar.st = nullptr;
    if (args.single) bar = xcd_barrier_post((unsigned*)(F.ctl + CW_BAR), F.MISC + 8, F.tid);

#ifndef DUP_STAGE
#define DUP_STAGE -1
#endif
#ifndef FUSE_RES
#define FUSE_RES 0
#endif
#define FUSE_SETUP(GRES, GATE, DONORM, LN, GN, SH, SC, HIN, BANK) do { if (FUSE_RES && F.G == 256) { const float* NG_ = F.inp(I_NORMG); const float* MOD_ = (const float*)(F.ws + WS_MOD); \
        E.fuse = 1; split_first = 1; E.do_norm = (DONORM); E.h_in = (HIN); E.h_out = F.out; E.Uo = (bf16*)(F.ws + WS_U); \
        E.g_res = NG_ + (size_t)(layer * 4 + (GRES)) * DM; E.mod_res = MOD_ + (size_t)(layer * 4) * (NMOD * DM); E.gate_idx = (GATE); \
        E.g_n = NG_ + (size_t)(((LN) < DEPTH ? (LN) : 0) * 4 + (GN)) * DM; E.mod_n = MOD_ + (size_t)(((LN) < DEPTH ? (LN) : 0) * 4) * (NMOD * DM); E.shift_idx = (SH); E.scale_idx = (SC); \
        const int bank_ = layer * 4 + (BANK); unsigned* ctlw_ = (unsigned*)(F.ws + WS_CTL); \
        E.st1.xbuf = (unsigned*)(F.ws + WS_R + R_XBUF + (size_t)bank_ * 524288); E.st1.cnt = ctlw_ + CW_SEAM + bank_ * 4096; E.st1.tmo = ctlw_; E.st1.eps = EPS; \
        E.st2.xbuf = (unsigned*)(F.ws + WS_R + R_XBUF + (size_t)(bank_ + 1) * 524288); E.st2.cnt = ctlw_ + CW_SEAM + (bank_ + 1) * 4096; E.st2.tmo = ctlw_; E.st2.eps = EPS; } } while (0)
    for (int pp = args.ph_lo * 2; pp < args.ph_hi * 2; ++pp) {
        const int p = pp >> 1;
        if (pp & 1) {
            if (DUP_STAGE < 0) continue;
            int s_ = -1; if (p == 0) s_ = 100; else if (p >= 2) { int i; if (p < 10) i = p - 2; else if (p < 19) { i = p - 10; if (i == 2) i = -100; else if (i == 3) i = 90; else if (i > 3) i -= 1; } else if (p < 27) i = p - 19; else i = p - 27;
                if (i == 90) s_ = 9; else if (i >= 0) s_ = i < 6 ? i : i + 1; }
#ifndef DUP_LAYER
#define DUP_LAYER -1
#endif
            if (s_ != DUP_STAGE) continue;
            if (DUP_LAYER >= 0 && (p < 10 ? 0 : p < 19 ? 1 : p < 27 ? 2 : 3) != DUP_LAYER) continue;
        }
        if (p == 20) continue;
#ifndef BAR_REP
#define BAR_REP 1
#endif
        if (pp != args.ph_lo * 2) { for (int br_ = 0; br_ < BAR_REP; ++br_) { asm volatile("" : "+s"(bar.bar), "+s"(bar.x)); xcd_barrier(bar, wave_s * 64 + pg8::fresh_lane()); } }
        { GAS unsigned char* ws_ = (GAS unsigned char*)args.ws; GAS float* out_ = (GAS float*)args.out; asm volatile("" : "+s"(ws_), "+s"(out_)); F.ws = (unsigned char*)ws_; F.out = (float*)out_;
          int G_ = gridDim.x, bx_ = blockIdx.x; asm volatile("" : "+s"(wave_s), "+s"(G_), "+s"(bx_));
          LAS unsigned char* l_ = (LAS unsigned char*)lds; asm volatile("" : "+s"(l_)); F.lds = l_; F.ldsg = (unsigned char*)l_;
          F.MISC = (volatile LAS unsigned*)(l_ + MISC_OFF); F.intab = (LAS unsigned long long*)(l_ + INTAB_OFF);
          F.wave = wave_s; F.G = G_; F.bx = bx_; F.vcu = (G_ % 8 == 0) ? (bx_ % 8) * (G_ / 8) + bx_ / 8 : bx_; }
#define SET_TID() do { F.lane = pg8::fresh_lane(); __builtin_assume(F.lane >= 0 && F.lane < 64); __builtin_assume(F.wave >= 0 && F.wave < NWAVES); F.tid = F.wave * 64 + F.lane; } while (0)
        if (p == 0) { SET_TID(); p0_prologue(F); }
        else if (p == 1) { SET_TID(); row_phase(F, 0, MT, nullptr, 0, 0, 0, true, 0, 0, 0, 1, nullptr, 0, true); }
        else {
            int layer, s;
            if (p < 10) { layer = 0; const int i = p - 2; s = i < 6 ? i : i + 1; }
            else if (p < 19) { layer = 1; const int i = p - 10; if (i < 3) s = i; else if (i == 3) s = 9; else { const int jj = i - 1; s = jj < 6 ? jj : jj + 1; } }
            else if (p < 27) { layer = 2; const int i = p - 19; s = i < 6 ? i : i + 1; }
            else { layer = 3; const int i = p - 27; s = i < 6 ? i : i + 1; }
            const int kind = layer % 3, j = layer / 3;
            const bool need_ctx = layer < DEPTH - 1;
            const int nrows = need_ctx ? MT : MLAT;
            if (s == 0 || s == 3 || s == 5 || s == 7) {
                pg8::Gemm g; pg8::EpiBf16Slab E; E.kro = nullptr; E.kcs = nullptr; E.slab = nullptr; int SK = 0; g.rowstep = 256; E.act = 0; E.cw = nullptr; E.cb = nullptr; E.ex = (LAS float*)(F.lds + 131072); E.nrows = nrows; E.fuse = 0; int split_first = 0;
                if (s == 0) {
                    g.A = (const bf16*)(F.ws + WS_U); g.lda = DM; g.K = DM; g.M = MT;
                    E.O = (bf16*)(F.ws + WS_R + R_QKV);
                    if (kind == 0)      { g.Bt = (const bf16*)(F.ws + WS_W_AQKV) + (size_t)j * A_COLS * DM; g.N = A_COLS; E.bias = nullptr; }
                    else if (kind == 1) { g.Bt = (const bf16*)(F.ws + WS_W_BIN); g.N = 3 * DM; E.bias = F.inp(I_BBIN); if (!need_ctx) g.M = MLAT; }
                    else                { g.Bt = (const bf16*)(F.ws + WS_W_CQKV); g.N = C_COLS; E.bias = F.inp(I_CBQKV); E.kro = (bf16*)(F.ws + WS_R + R_KB); E.kcs = (const float*)(F.ws + WS_CSC); }
                    E.ldc = g.N;
                } else if (s == 3) {
                    g.A = (const bf16*)(F.ws + WS_U); g.lda = DM; g.K = DM; g.M = nrows; g.N = DM;
                    if (kind == 0)      { g.Bt = (const bf16*)(F.ws + WS_W_AOUT) + (size_t)j * DM * DM; E.bias = nullptr; }
                    else if (kind == 1) { g.Bt = (const bf16*)(F.ws + WS_W_BOUT); E.bias = F.inp(I_BBOUT); }
                    else                { g.Bt = (const bf16*)(F.ws + WS_W_COUT); E.bias = F.inp(I_CBOUT); }
                    E.O = (bf16*)(F.ws + WS_R + R_O); E.ldc = DM; if (need_ctx) { SK = SK_OUT; E.slab = (float*)(F.ws + WS_R + R_SLAB); }
                    FUSE_SETUP(1, 2, 1, layer, 2, 3, 4, layer == 0 ? F.inp(I_X) : (const float*)F.out, 0);
                } else if (s == 5) {
                    g.A = (const bf16*)(F.ws + WS_U) - DM; g.lda = DM; g.K = DM; g.rowstep = 254; g.M = ((nrows + 253) / 254) * 256; g.N = 2 * DFF;
                    g.Bt = (const bf16*)(F.ws + WS_W_UP) + (size_t)layer * 2 * DFF * DM; E.bias = nullptr;
                    E.O = (bf16*)(F.ws + WS_R + R_G); E.ldc = DFF; E.act = 1; E.cw = F.inp(I_FCW) + (size_t)layer * 3 * DFF; E.cb = F.inp(I_FCB) + (size_t)layer * DFF;
                } else {
                    g.A = (const bf16*)(F.ws + WS_R + R_G); g.lda = DFF; g.K = DFF; g.M = nrows; g.N = DM;
                    g.Bt = (const bf16*)(F.ws + WS_W_DOWN) + (size_t)layer * DM * DFF; E.bias = nullptr;
                    E.O = (bf16*)(F.ws + WS_U); E.ldc = DM; if (need_ctx) { SK = SK_DOWN; E.slab = (float*)(F.ws + WS_R + R_SLAB2); }
                    FUSE_SETUP(3, 5, layer + 1 < DEPTH, layer + 1, 0, 0, 1, (const float*)F.out, 2);
                }
                pg8::Order2 S; S.init(g.M, g.N, F.G, F.bx, g.K, SK, split_first);
                pg8::gemm_phase<pg8::EpiBf16Slab, pg8::Order2, true, true>(F.lds, g, S, E, F.wave);
                if (s == 0 && F.G == 256) {
                    const int nwg = (g.M / 256) * (g.N / 256), first_idle = nwg % 256;
                    if (F.bx >= first_idle) { SET_TID(); tail_work(F, layer, first_idle); }
                }
            } else if (s == 1) {
                SET_TID();
                if (kind == 0) prep_a(F, j); else if (kind == 1) hy1t(F); else prep_c(F);
            } else if (s == 2) {
                SET_TID();
                if (kind == 0) attn_a_phase(F, need_ctx, j); else if (kind == 1) { hyfft(F); hyconv_ctx(F); } else attn_c_phase(F, need_ctx);
            } else if (s == 9) {
                SET_TID(); hy3(F);
            } else if (s == 4) {
                SET_TID();
                row_phase(F, 0, nrows, (const bf16*)(F.ws + WS_R + R_O), layer, 1, 2, true, layer, 2, 3, 4, (const float*)(F.ws + WS_R + R_SLAB), need_ctx ? SK_OUT : 0, layer == 0);
            } else {
                SET_TID();
                const bool more = layer + 1 < DEPTH;
                row_phase(F, 0, nrows, (const bf16*)(F.ws + WS_U), layer, 3, 5, more, layer + 1, 0, 0, 1, (const float*)(F.ws + WS_R + R_SLAB2), need_ctx ? SK_DOWN : 0, false, !more);
            }
        }
    }
}

#ifndef SINGLE_LAUNCH
#define SINGLE_LAUNCH 1
#endif
extern "C" void kernel_launch(void* const* d_in, const int* in_sizes, int n_in, void* d_out, int out_size, void* d_ws, size_t ws_size, hipStream_t stream) {
    static int grid = 0;
    if (grid == 0) {
        if (n_in != N_IN || out_size != MLAT * DM || ws_size < WS_END) { fprintf(stderr, "kernel_launch: unexpected shapes: n_in %d out %d ws %zu (need %zu)\n", n_in, out_size, ws_size, (size_t)WS_END); grid = -1; return; }
        int dev = 0, cus = 0;
        if (hipGetDevice(&dev) != hipSuccess || hipDeviceGetAttribute(&cus, hipDeviceAttributeMultiprocessorCount, dev) != hipSuccess) { grid = -1; return; }
        if (hipFuncSetAttribute((const void*)fwd_kernel, hipFuncAttributeMaxDynamicSharedMemorySize, LDS_BYTES) != hipSuccess) { fprintf(stderr, "kernel_launch: hipFuncSetAttribute failed\n"); grid = -1; return; }
        int per_cu = 0;
        if (hipOccupancyMaxActiveBlocksPerMultiprocessor(&per_cu, (const void*)fwd_kernel, NTHREADS, LDS_BYTES) != hipSuccess || per_cu < 1) fprintf(stderr, "kernel_launch: occupancy query reports %d\n", per_cu);
        (void)hipGetLastError();
        grid = cus;
    }
    if (grid < 0) return;
    if (hipMemsetAsync((char*)d_ws + WS_CTL, 0, CTL_ZERO_BYTES, stream) != hipSuccess) return;
    Args a{};
    for (int i = 0; i < N_IN; ++i) a.in[i] = (const float*)d_in[i];
    a.out = (float*)d_out; a.ws = (unsigned char*)d_ws;
#if SINGLE_LAUNCH
    a.ph_lo = 0; a.ph_hi = N_PHASES; a.single = 1;
    hipLaunchKernelGGL(fwd_kernel, dim3(grid), dim3(NTHREADS), LDS_BYTES, stream, a);
#else
    for (int p = 0; p < N_PHASES; ++p) { a.ph_lo = p; a.ph_hi = p + 1; a.single = 0;
        hipLaunchKernelGGL(fwd_kernel, dim3(grid), dim3(NTHREADS), LDS_BYTES, stream, a); }
#endif
    const hipError_t le = hipPeekAtLastError();
    if (le != hipSuccess) fprintf(stderr, "kernel_launch: launch failed: %s\n", hipGetErrorName(le));
}
```
